# Optimizing an MI355X kernel written in HIP

```python
import math
import jax, jax.numpy as jnp
from jax import lax
import numpy as np

D_MODEL = 1024
BATCH = 8
SEQ = 4096
DEPTH = 1

D_DN = 512
DN_HEADS = 4
DN_HEAD_DIM = 128
CONV_WIDTH = 4
CHUNK = 64
D_ATT = 512
ATT_HEADS = 8
ATT_HEAD_DIM = 64
DILATED_PATTERNS = ((128, 1), (512, 4), (2048, 16))
N_BUCKETS = 32
MAX_DISTANCE = 2048
D_MIX = D_DN + D_ATT
D_IN = 4 * D_DN + 2 * DN_HEADS + 4 * D_ATT
EPS = 1e-6

kernel_name = "hybrid_deltanet_dilated_attention_layer"


def rms_norm(x, w):
    xf = x.astype(jnp.float32)
    return xf * lax.rsqrt(jnp.mean(xf * xf, axis=-1, keepdims=True) + EPS) * w.astype(jnp.float32)


def l2_norm(x):
    return x * lax.rsqrt(jnp.sum(x * x, axis=-1, keepdims=True) + EPS)


def split_heads(t, n_heads):
    b, s, _ = t.shape
    return t.reshape(b, s, n_heads, -1).transpose(0, 2, 1, 3)


def causal_depthwise_conv(u, w):
    k_width = w.shape[0]
    s = u.shape[1]
    up = jnp.pad(u, ((0, 0), (k_width - 1, 0), (0, 0)))
    y = up[:, 0:s] * w[0]
    for i in range(1, k_width):
        y = y + up[:, i:i + s] * w[i]
    return y


def gated_delta_rule(q, k, v, g, beta):
    b, h, s, dk = q.shape
    dv = v.shape[-1]
    n = s // CHUNK
    q = q * (dk ** -0.5)
    qc = q.reshape(b, h, n, CHUNK, dk)
    kc = k.reshape(b, h, n, CHUNK, dk)
    vc = v.reshape(b, h, n, CHUNK, dv)
    bc = beta.reshape(b, h, n, CHUNK)
    gc = jnp.cumsum(g.reshape(b, h, n, CHUNK), axis=-1)
    tril_incl = np.tril(np.ones((CHUNK, CHUNK), dtype=bool))
    tril_strict = np.tril(np.ones((CHUNK, CHUNK), dtype=bool), -1)
    diff = gc[..., :, None] - gc[..., None, :]
    decay = jnp.exp(jnp.where(tril_incl, diff, -jnp.inf))
    kb = kc * bc[..., None]
    a_mat = jnp.where(tril_strict, jnp.einsum('bhnid,bhnjd->bhnij', kb, kc) * decay, 0.0)
    l_mat = a_mat + jnp.eye(CHUNK, dtype=a_mat.dtype)
    u = lax.linalg.triangular_solve(l_mat, vc * bc[..., None], left_side=True, lower=True, unit_diagonal=True)
    w = lax.linalg.triangular_solve(l_mat, kb * jnp.exp(gc)[..., None], left_side=True, lower=True, unit_diagonal=True)
    attn_intra = jnp.einsum('bhnid,bhnjd->bhnij', qc, kc) * decay
    q_dec = qc * jnp.exp(gc)[..., None]
    k_tail = kc * jnp.exp(gc[..., -1:] - gc)[..., None]
    g_last = jnp.exp(gc[..., -1])
    xs = tuple(jnp.moveaxis(t, 2, 0) for t in (attn_intra, q_dec, k_tail, u, w, g_last))

    def step(state, inp):
        a_i, qd_i, kt_i, u_i, w_i, gl_i = inp
        v_new = u_i - jnp.einsum('bhck,bhkv->bhcv', w_i, state)
        o_i = jnp.einsum('bhck,bhkv->bhcv', qd_i, state) + jnp.einsum('bhij,bhjv->bhiv', a_i, v_new)
        state = state * gl_i[..., None, None] + jnp.einsum('bhck,bhcv->bhkv', kt_i, v_new)
        return state, o_i

    s0 = jnp.zeros((b, h, dk, dv), jnp.float32)
    _, o = lax.scan(step, s0, xs)
    return jnp.moveaxis(o, 0, 2).reshape(b, h, s, dv)


def t5_bucket(dist):
    max_exact = N_BUCKETS // 2
    d = np.maximum(dist, 1).astype(np.float64)
    large = max_exact + (np.log(d / max_exact) / math.log(MAX_DISTANCE / max_exact)
                         * (N_BUCKETS - max_exact)).astype(np.int32)
    large = np.minimum(large, N_BUCKETS - 1)
    return np.where(dist < max_exact, dist, large).astype(np.int32)


def dilated_pattern(q, k, v, rel_bias, window, dilation):
    b, h, s, hd = q.shape
    r = dilation
    l_sub = s // r
    w_steps = window // r
    blk = w_steps
    n_blk = -(-l_sub // blk)
    l_pad = n_blk * blk

    def to_blocks(t):
        t = t.reshape(b, h, l_sub, r, hd).transpose(0, 1, 3, 2, 4)
        t = jnp.pad(t, ((0, 0), (0, 0), (0, 0), (0, l_pad - l_sub), (0, 0)))
        return t.reshape(b, h, r, n_blk, blk, hd)

    def with_prev(t):
        prev = jnp.pad(t, ((0, 0), (0, 0), (0, 0), (1, 0), (0, 0), (0, 0)))[:, :, :, :-1]
        return jnp.concatenate([prev, t], axis=4)

    qb = to_blocks(q)
    kw = with_prev(to_blocks(k))
    vw = with_prev(to_blocks(v))
    qi = np.arange(blk)[:, None]
    kj = np.arange(2 * blk)[None, :]
    step = qi - kj + blk
    band = (step >= 0) & (step <= w_steps)
    key_idx = np.arange(n_blk)[:, None, None] * blk + kj[None] - blk
    mask = band[None] & (key_idx >= 0)
    buckets = t5_bucket(np.clip(step, 0, None) * r)
    bias = rel_bias.astype(jnp.float32)[:, buckets]
    scores = jnp.einsum('bhrnqd,bhrnkd->bhrnqk', qb, kw).astype(jnp.float32) + bias[:, None, None]
    scores = jnp.where(mask, scores, -jnp.inf)
    lse = jax.nn.logsumexp(scores, axis=-1)
    p = jnp.exp(scores - lse[..., None])
    o = jnp.einsum('bhrnqk,bhrnkd->bhrnqd', p, vw.astype(jnp.float32))
    o = o.reshape(b, h, r, l_pad, hd)[:, :, :, :l_sub].transpose(0, 1, 3, 2, 4).reshape(b, h, s, hd)
    lse = lse.reshape(b, h, r, l_pad)[:, :, :, :l_sub].transpose(0, 1, 3, 2).reshape(b, h, s)
    return o, lse


def deltanet_branch(qkv, z, b_proj, a_proj, conv_w, a_log, dt_bias, dn_norm_w):
    bsz, s, _ = qkv.shape
    qkv = jax.nn.silu(causal_depthwise_conv(qkv.astype(jnp.float32), conv_w.astype(jnp.float32)))
    q, k, v = jnp.split(qkv, 3, axis=-1)
    q = l2_norm(split_heads(q, DN_HEADS))
    k = l2_norm(split_heads(k, DN_HEADS))
    v = split_heads(v, DN_HEADS)
    beta = jax.nn.sigmoid(b_proj.astype(jnp.float32)).transpose(0, 2, 1)
    g = -jnp.exp(a_log.astype(jnp.float32)) * jax.nn.softplus(a_proj.astype(jnp.float32) + dt_bias.astype(jnp.float32))
    g = g.transpose(0, 2, 1)
    o = gated_delta_rule(q, k, v, g, beta)
    o = rms_norm(o, dn_norm_w).transpose(0, 2, 1, 3).reshape(bsz, s, D_DN)
    return o * jax.nn.silu(z.astype(jnp.float32))


def dilated_attention_branch(qkv, gate, q_norm_w, k_norm_w, rel_bias):
    bsz, s, _ = qkv.shape
    q, k, v = jnp.split(qkv, 3, axis=-1)
    q = rms_norm(split_heads(q, ATT_HEADS), q_norm_w) * (ATT_HEAD_DIM ** -0.5)
    k = rms_norm(split_heads(k, ATT_HEADS), k_norm_w)
    v = split_heads(v, ATT_HEADS).astype(jnp.float32)
    outs, lses = [], []
    for window, dilation in DILATED_PATTERNS:
        o_p, lse_p = dilated_pattern(q, k, v, rel_bias, window, dilation)
        outs.append(o_p)
        lses.append(lse_p)
    wts = jax.nn.softmax(jnp.stack(lses), axis=0)
    o = jnp.sum(wts[..., None] * jnp.stack(outs), axis=0)
    o = o.transpose(0, 2, 1, 3).reshape(bsz, s, D_ATT)
    return o * jax.nn.silu(gate.astype(jnp.float32))


def hybrid_layer(x, norm_w, w_in, conv_w, a_log, dt_bias, dn_norm_w, q_norm_w, k_norm_w, rel_bias, w_out):
    h = rms_norm(x, norm_w).astype(x.dtype)
    proj = h @ w_in
    cuts = [3 * D_DN, 4 * D_DN, 4 * D_DN + DN_HEADS, 4 * D_DN + 2 * DN_HEADS,
            4 * D_DN + 2 * DN_HEADS + 3 * D_ATT]
    qkv_dn, z_dn, b_dn, a_dn, qkv_att, gate_att = jnp.split(proj, cuts, axis=-1)
    y_dn = deltanet_branch(qkv_dn, z_dn, b_dn, a_dn, conv_w, a_log, dt_bias, dn_norm_w)
    y_att = dilated_attention_branch(qkv_att, gate_att, q_norm_w, k_norm_w, rel_bias)
    mixed = jnp.concatenate([y_dn, y_att], axis=-1).astype(x.dtype)
    return x + mixed @ w_out


def setup_inputs(seed: int = 0) -> dict:
    key = jax.random.key(seed)
    ks = jax.random.split(key, 11)
    x = jax.random.normal(ks[0], (BATCH, SEQ, D_MODEL), jnp.float32)
    norm_w = 1.0 + 0.1 * jax.random.normal(ks[1], (DEPTH, D_MODEL), jnp.float32)
    w_in = jax.random.normal(ks[2], (DEPTH, D_MODEL, D_IN), jnp.float32) * (D_MODEL ** -0.5)
    conv_w = jax.random.normal(ks[3], (DEPTH, CONV_WIDTH, 3 * D_DN), jnp.float32) * (CONV_WIDTH ** -0.5)
    a_log = jnp.log(jax.random.uniform(ks[4], (DEPTH, DN_HEADS), jnp.float32, minval=1.0, maxval=16.0))
    dt = jnp.exp(jax.random.uniform(ks[5], (DEPTH, DN_HEADS), jnp.float32,
                                    minval=math.log(1e-3), maxval=math.log(1e-1)))
    dt_bias = dt + jnp.log(-jnp.expm1(-dt))
    dn_norm_w = 1.0 + 0.1 * jax.random.normal(ks[6], (DEPTH, DN_HEAD_DIM), jnp.float32)
    q_norm_w = 1.0 + 0.1 * jax.random.normal(ks[7], (DEPTH, ATT_HEAD_DIM), jnp.float32)
    k_norm_w = 1.0 + 0.1 * jax.random.normal(ks[8], (DEPTH, ATT_HEAD_DIM), jnp.float32)
    rel_bias = 0.5 * jax.random.normal(ks[9], (ATT_HEADS, N_BUCKETS), jnp.float32)
    w_out = jax.random.normal(ks[10], (DEPTH, D_MIX, D_MODEL), jnp.float32) * (D_MIX ** -0.5)
    return {"x": x, "norm_w": norm_w, "w_in": w_in, "conv_w": conv_w, "a_log": a_log,
            "dt_bias": dt_bias, "dn_norm_w": dn_norm_w, "q_norm_w": q_norm_w,
            "k_norm_w": k_norm_w, "rel_bias": rel_bias, "w_out": w_out}


def reference(x, norm_w, w_in, conv_w, a_log, dt_bias, dn_norm_w, q_norm_w, k_norm_w, rel_bias, w_out):
    for layer in range(DEPTH):
        x = hybrid_layer(x, norm_w[layer], w_in[layer], conv_w[layer], a_log[layer], dt_bias[layer],
                         dn_norm_w[layer], q_norm_w[layer], k_norm_w[layer], rel_bias, w_out[layer])
    return x
```

```cpp
#include <hip/hip_runtime.h>
#include <cstdint>
#include <cstdio>

typedef unsigned short bf16_t;
typedef short bf16x8 __attribute__((ext_vector_type(8)));
typedef float f32x4 __attribute__((ext_vector_type(4)));

constexpr int NB = 8, SEQ = 4096, DM = 1024, MROWS = NB * SEQ;
constexpr int DIN = 4104, NPK = 4096;
constexpr int DNH = 4, DNHD = 128, ATH = 8, ATHD = 64;
constexpr float EPS = 1e-6f;

constexpr int PC_DNQ = 0, PC_DNK = 512, PC_DNV = 1024, PC_Z = 1536, PC_AQ = 2048, PC_AK = 2560, PC_AV = 3072, PC_GATE = 3584;

constexpr size_t OFF_XN = 0;
constexpr size_t OFF_WTIN = OFF_XN + (size_t)MROWS * DM * 2;
constexpr size_t OFF_WTOUT = OFF_WTIN + (size_t)NPK * DM * 2;
constexpr size_t OFF_BETA = OFF_WTOUT + (size_t)DM * DM * 2;
constexpr size_t OFF_G = OFF_BETA + (size_t)MROWS * 4 * 4;
constexpr size_t OFF_PROJ = OFF_G + (size_t)MROWS * 4 * 4;
constexpr size_t OFF_DNQ = OFF_PROJ + (size_t)MROWS * NPK * 2;
constexpr size_t OFF_DNK = OFF_DNQ + (size_t)MROWS * 512 * 2;
constexpr size_t OFF_DNV = OFF_DNK + (size_t)MROWS * 512 * 2;
constexpr size_t OFF_MIXED = OFF_DNV + (size_t)MROWS * 512 * 2;
constexpr size_t WS_NEED = OFF_MIXED + (size_t)MROWS * DM * 2;

__device__ __forceinline__ bf16_t f2bf(float f) { unsigned u = __float_as_uint(f); u += 0x7FFFu + ((u >> 16) & 1u); return (bf16_t)(u >> 16); }
__device__ __forceinline__ float bf2f(bf16_t b) { return __uint_as_float(((unsigned)b) << 16); }
__device__ __forceinline__ float wave_sum(float v) {
#pragma unroll
    for (int o = 32; o >= 1; o >>= 1) v += __shfl_xor(v, o);
    return v;
}
__device__ __forceinline__ float wave_max(float v) {
#pragma unroll
    for (int o = 32; o >= 1; o >>= 1) v = fmaxf(v, __shfl_xor(v, o));
    return v;
}
__device__ __forceinline__ float silu_f(float y) { return y / (1.0f + __expf(-y)); }

struct Params {
    const float* x; const float* norm_w; const float* w_in; const float* conv_w; const float* a_log; const float* dt_bias;
    const float* dn_norm_w; const float* q_norm_w; const float* k_norm_w; const float* rel_bias; const float* w_out;
    float* out; unsigned char* ws;
};

__device__ void phase_weights(const Params& p) {
    bf16_t* wt_in = (bf16_t*)(p.ws + OFF_WTIN); bf16_t* wt_out = (bf16_t*)(p.ws + OFF_WTOUT);
    const size_t gt = (size_t)blockIdx.x * blockDim.x + threadIdx.x, gn = (size_t)gridDim.x * blockDim.x;
    for (size_t i = gt; i < (size_t)DM * NPK; i += gn) { const int k = (int)(i / NPK), n = (int)(i % NPK); const int col = n < 2048 ? n : n + 8;
        wt_in[(size_t)n * DM + k] = f2bf(p.w_in[(size_t)k * DIN + col]); }
    for (size_t i = gt; i < (size_t)DM * DM; i += gn) { const int k = (int)(i / DM), n = (int)(i % DM);
        wt_out[(size_t)n * DM + k] = f2bf(p.w_out[(size_t)k * DM + n]); }
}

__device__ void phase_norm(const Params& p, float* lds_w8  ) {
    bf16_t* xn = (bf16_t*)(p.ws + OFF_XN); float* beta = (float*)(p.ws + OFF_BETA); float* gdec = (float*)(p.ws + OFF_G);
    for (int i = threadIdx.x; i < 1024 * 8; i += blockDim.x) { const int k = i >> 3, j = i & 7; lds_w8[i] = p.w_in[(size_t)k * DIN + 2048 + j]; }
    __syncthreads();
    const int lane = threadIdx.x & 63, wpb = blockDim.x >> 6, gw = blockIdx.x * wpb + (threadIdx.x >> 6), nw = gridDim.x * wpb;
    f32x4 nw4[4];
#pragma unroll
    for (int i = 0; i < 4; ++i) nw4[i] = *(const f32x4*)(p.norm_w + i * 256 + lane * 4);
    for (int row = gw; row < MROWS; row += nw) {
        f32x4 xv[4]; float ss = 0.f;
#pragma unroll
        for (int i = 0; i < 4; ++i) { xv[i] = *(const f32x4*)(p.x + (size_t)row * DM + i * 256 + lane * 4); ss += xv[i][0] * xv[i][0] + xv[i][1] * xv[i][1] + xv[i][2] * xv[i][2] + xv[i][3] * xv[i][3]; }
        ss = wave_sum(ss);
        const float rstd = rsqrtf(ss * (1.0f / DM) + EPS);
        float acc[8];
#pragma unroll
        for (int j = 0; j < 8; ++j) acc[j] = 0.f;
#pragma unroll
        for (int i = 0; i < 4; ++i) {
            f32x4 h = xv[i] * rstd * nw4[i];
            uint2 pk; pk.x = (unsigned)f2bf(h[0]) | ((unsigned)f2bf(h[1]) << 16); pk.y = (unsigned)f2bf(h[2]) | ((unsigned)f2bf(h[3]) << 16);
            *(uint2*)(xn + (size_t)row * DM + i * 256 + lane * 4) = pk;
#pragma unroll
            for (int e = 0; e < 4; ++e) { const float* w8 = lds_w8 + (i * 256 + lane * 4 + e) * 8;
#pragma unroll
                for (int j = 0; j < 8; ++j) acc[j] += h[e] * w8[j]; }
        }
#pragma unroll
        for (int j = 0; j < 8; ++j) acc[j] = wave_sum(acc[j]);
        const int b = row / SEQ, s = row % SEQ;
        if (lane == 0) {
#pragma unroll
            for (int j = 0; j < 4; ++j) {
                beta[((size_t)b * 4 + j) * SEQ + s] = 1.0f / (1.0f + expf(-acc[j]));
                const float xx = acc[4 + j] + p.dt_bias[j]; const float sp = xx > 20.f ? xx : log1pf(expf(xx));
                gdec[((size_t)b * 4 + j) * SEQ + s] = -expf(p.a_log[j]) * sp;
            }
        }
    }
}

template <class Epi>
__device__ void phase_gemm_simple(const bf16_t* A, const bf16_t* Bt, int M, int N, int K, const Epi& epi) {
    const int lane = threadIdx.x & 63, wid = threadIdx.x >> 6, wr = wid >> 1, wc = wid & 1, fr = lane & 15, fq = lane >> 4;
    const int ntn = N / 128, ntiles = (M / 128) * ntn;
    for (int tile = blockIdx.x; tile < ntiles; tile += gridDim.x) {
        const int m0 = (tile / ntn) * 128 + wr * 64, n0 = (tile % ntn) * 128 + wc * 64;
        f32x4 acc[4][4];
#pragma unroll
        for (int i = 0; i < 4; ++i)
#pragma unroll
            for (int j = 0; j < 4; ++j) acc[i][j] = (f32x4){0.f, 0.f, 0.f, 0.f};
        const bf16_t* ap = A + (size_t)(m0 + fr) * K + fq * 8; const bf16_t* bp = Bt + (size_t)(n0 + fr) * K + fq * 8;
        for (int k0 = 0; k0 < K; k0 += 32) {
            bf16x8 a[4], b[4];
#pragma unroll
            for (int i = 0; i < 4; ++i) { a[i] = *(const bf16x8*)(ap + (size_t)i * 16 * K + k0); b[i] = *(const bf16x8*)(bp + (size_t)i * 16 * K + k0); }
#pragma unroll
            for (int i = 0; i < 4; ++i)
#pragma unroll
                for (int j = 0; j < 4; ++j) acc[i][j] = __builtin_amdgcn_mfma_f32_16x16x32_bf16(a[i], b[j], acc[i][j], 0, 0, 0);
        }
#pragma unroll
        for (int i = 0; i < 4; ++i)
#pragma unroll
            for (int j = 0; j < 4; ++j)
#pragma unroll
                for (int r = 0; r < 4; ++r) epi(m0 + i * 16 + fq * 4 + r, n0 + j * 16 + fr, acc[i][j][r]);
    }
}
struct EpiProj { bf16_t* proj; __device__ __forceinline__ void operator()(int m, int n, float v) const { proj[(size_t)m * NPK + n] = f2bf(v); } };
struct EpiOut { const float* x; float* out; __device__ __forceinline__ void operator()(int m, int n, float v) const { out[(size_t)m * DM + n] = x[(size_t)m * DM + n] + v; } };

__device__ void phase_dn_conv(const Params& p) {
    const bf16_t* proj = (const bf16_t*)(p.ws + OFF_PROJ);
    bf16_t* dnq = (bf16_t*)(p.ws + OFF_DNQ); bf16_t* dnk = (bf16_t*)(p.ws + OFF_DNK); bf16_t* dnv = (bf16_t*)(p.ws + OFF_DNV);
    const int lane = threadIdx.x & 63, wpb = blockDim.x >> 6, gw = blockIdx.x * wpb + (threadIdx.x >> 6), nw = gridDim.x * wpb;
    for (int item = gw; item < MROWS * 4; item += nw) {
        const int row = item >> 2, h = item & 3, b = row / SEQ, t = row % SEQ;
        float y[3][2];
#pragma unroll
        for (int g = 0; g < 3; ++g)
#pragma unroll
            for (int e = 0; e < 2; ++e) {
                const int c = g * 512 + h * 128 + e * 64 + lane; float a = 0.f;
#pragma unroll
                for (int i = 0; i < 4; ++i) { const int tt = t - 3 + i; if (tt >= 0) a += p.conv_w[i * 1536 + c] * bf2f(proj[(size_t)(b * SEQ + tt) * NPK + c]); }
                y[g][e] = silu_f(a);
            }
        const float sq = wave_sum(y[0][0] * y[0][0] + y[0][1] * y[0][1]), sk = wave_sum(y[1][0] * y[1][0] + y[1][1] * y[1][1]);
        const float rq = rsqrtf(sq + EPS) * 0.08838834764831845f, rk = rsqrtf(sk + EPS);
        const size_t o = ((size_t)(b * 4 + h) * SEQ + t) * 128;
#pragma unroll
        for (int e = 0; e < 2; ++e) { dnq[o + e * 64 + lane] = f2bf(y[0][e] * rq); dnk[o + e * 64 + lane] = f2bf(y[1][e] * rk); dnv[o + e * 64 + lane] = f2bf(y[2][e]); }
    }
}

__device__ void phase_dn_scan_simple(const Params& p, float* lds  ) {
    const bf16_t* dnq = (const bf16_t*)(p.ws + OFF_DNQ); const bf16_t* dnk = (const bf16_t*)(p.ws + OFF_DNK); const bf16_t* dnv = (const bf16_t*)(p.ws + OFF_DNV);
    const float* beta = (const float*)(p.ws + OFF_BETA); const float* gdec = (const float*)(p.ws + OFF_G);
    float* odn = (float*)(p.ws + OFF_XN);
    const int gpb = blockDim.x >> 7, grp = threadIdx.x >> 7, j = threadIdx.x & 127;
    float* sq = lds + grp * (3 * 16 * 128 + 32); float* sk = sq + 16 * 128; float* sv = sk + 16 * 128; float* sg = sv + 16 * 128; float* sb = sg + 16;
    for (int u0 = blockIdx.x * gpb; u0 < NB * 4; u0 += gridDim.x * gpb) {
        const int unit = u0 + grp;
        float S[128];
#pragma unroll
        for (int i = 0; i < 128; ++i) S[i] = 0.f;
        const size_t base = (size_t)unit * SEQ;
        for (int t0 = 0; t0 < SEQ; t0 += 16) {
            __syncthreads();
#pragma unroll
            for (int tt = 0; tt < 16; ++tt) { const size_t o = (base + t0 + tt) * 128 + j; sq[tt * 128 + j] = bf2f(dnq[o]); sk[tt * 128 + j] = bf2f(dnk[o]); sv[tt * 128 + j] = bf2f(dnv[o]); }
            if (j < 16) { sg[j] = __expf(gdec[base + t0 + j]); sb[j] = beta[base + t0 + j]; }
            __syncthreads();
            for (int tt = 0; tt < 16; ++tt) {
                const float eg = sg[tt], bt = sb[tt]; const float* kk = sk + tt * 128; const float* qq = sq + tt * 128;
                float r = 0.f;
#pragma unroll
                for (int i = 0; i < 128; i += 4) { const f32x4 k4 = *(const f32x4*)(kk + i); r += k4[0] * S[i] + k4[1] * S[i + 1] + k4[2] * S[i + 2] + k4[3] * S[i + 3]; }
                const float d = bt * (sv[tt * 128 + j] - eg * r);
                float o = 0.f;
#pragma unroll
                for (int i = 0; i < 128; i += 4) { const f32x4 k4 = *(const f32x4*)(kk + i); const f32x4 q4 = *(const f32x4*)(qq + i);
#pragma unroll
                    for (int e = 0; e < 4; ++e) { S[i + e] = eg * S[i + e] + k4[e] * d; o += q4[e] * S[i + e]; } }
                odn[(base + t0 + tt) * 128 + j] = o;
            }
        }
    }
}

__device__ void phase_dn_out(const Params& p) {
    const float* odn = (const float*)(p.ws + OFF_XN); const bf16_t* proj = (const bf16_t*)(p.ws + OFF_PROJ); bf16_t* mixed = (bf16_t*)(p.ws + OFF_MIXED);
    const int lane = threadIdx.x & 63, wpb = blockDim.x >> 6, gw = blockIdx.x * wpb + (threadIdx.x >> 6), nw = gridDim.x * wpb;
    for (int item = gw; item < MROWS * 4; item += nw) {
        const int row = item >> 2, h = item & 3, b = row / SEQ, t = row % SEQ;
        const size_t o = ((size_t)(b * 4 + h) * SEQ + t) * 128;
        const float v0 = odn[o + lane], v1 = odn[o + 64 + lane];
        const float rstd = rsqrtf(wave_sum(v0 * v0 + v1 * v1) * (1.0f / 128.f) + EPS);
        const float z0 = bf2f(proj[(size_t)row * NPK + PC_Z + h * 128 + lane]), z1 = bf2f(proj[(size_t)row * NPK + PC_Z + h * 128 + 64 + lane]);
        mixed[(size_t)row * DM + h * 128 + lane] = f2bf(v0 * rstd * p.dn_norm_w[lane] * silu_f(z0));
        mixed[(size_t)row * DM + h * 128 + 64 + lane] = f2bf(v1 * rstd * p.dn_norm_w[64 + lane] * silu_f(z1));
    }
}

__device__ __forceinline__ int t5_bucket_dev(int d) {
    if (d < 16) return d;
    int bkt = 16;
    const int bnd[15] = {22, 30, 40, 54, 73, 99, 134, 182, 246, 332, 450, 609, 825, 1117, 1513};
#pragma unroll
    for (int i = 0; i < 15; ++i) bkt += (d >= bnd[i]) ? 1 : 0;
    return bkt;
}
__device__ void phase_attn_simple(const Params& p, float* lds  ) {
    const bf16_t* proj = (const bf16_t*)(p.ws + OFF_PROJ); bf16_t* mixed = (bf16_t*)(p.ws + OFF_MIXED);
    const int lane = threadIdx.x & 63, wib = threadIdx.x >> 6, wpb = blockDim.x >> 6, gw = blockIdx.x * wpb + wib, nw = gridDim.x * wpb;
    float* wq = lds + wib * 64;
    for (int item = gw; item < NB * ATH * SEQ; item += nw) {
        const int t = item % SEQ, h = (item / SEQ) % ATH, b = item / (SEQ * ATH);
        const size_t row = (size_t)b * SEQ + t;
        const float qraw = bf2f(proj[row * NPK + PC_AQ + h * 64 + lane]);
        const float qrstd = rsqrtf(wave_sum(qraw * qraw) * (1.0f / 64.f) + EPS);
        wq[lane] = qraw * qrstd * p.q_norm_w[lane] * 0.125f * p.k_norm_w[lane];
        float qk[64];
#pragma unroll
        for (int d = 0; d < 64; d += 4) { const f32x4 v = *(const f32x4*)(wq + d); qk[d] = v[0]; qk[d + 1] = v[1]; qk[d + 2] = v[2]; qk[d + 3] = v[3]; }
        float sc[7]; float mx = -INFINITY;
#pragma unroll
        for (int i = 0; i < 7; ++i) {
            const int s = lane + 64 * i; const int pt = s / 129, jj = s - pt * 129; const int r = pt == 0 ? 1 : (pt == 1 ? 4 : 16);
            const int kt = t - jj * r; const bool valid = (s < 387) && (kt >= 0);
            float v = -INFINITY;
            if (valid) {
                const bf16_t* kp = proj + ((size_t)b * SEQ + kt) * NPK + PC_AK + h * 64;
                float dot = 0.f, ssq = 0.f;
#pragma unroll
                for (int c = 0; c < 8; ++c) { const bf16x8 kv = *(const bf16x8*)(kp + c * 8);
#pragma unroll
                    for (int e = 0; e < 8; ++e) { const float kf = bf2f((bf16_t)kv[e]); dot += qk[c * 8 + e] * kf; ssq += kf * kf; } }
                v = dot * rsqrtf(ssq * (1.0f / 64.f) + EPS) + p.rel_bias[h * 32 + t5_bucket_dev(jj * r)];
            }
            sc[i] = v; mx = fmaxf(mx, v);
        }
        mx = wave_max(mx);
        float sum = 0.f;
#pragma unroll
        for (int i = 0; i < 7; ++i) { sc[i] = (sc[i] == -INFINITY) ? 0.f : __expf(sc[i] - mx); sum += sc[i]; }
        sum = wave_sum(sum);
        float o = 0.f;
#pragma unroll
        for (int i = 0; i < 7; ++i) {
            for (int l = 0; l < 64; ++l) {
                const int s = l + 64 * i; if (s >= 387) break;
                const int pt = s / 129, jj = s - pt * 129; const int r = pt == 0 ? 1 : (pt == 1 ? 4 : 16);
                const int kt = t - jj * r;
                const float e = __shfl(sc[i], l);
                if (kt >= 0) o += e * bf2f(proj[((size_t)b * SEQ + kt) * NPK + PC_AV + h * 64 + lane]);
            }
        }
        o /= sum;
        const float gt = bf2f(proj[row * NPK + PC_GATE + h * 64 + lane]);
        mixed[row * DM + 512 + h * 64 + lane] = f2bf(o * silu_f(gt));
    }
}

__global__ void __launch_bounds__(256) k_weights(Params p) { phase_weights(p); }
__global__ void __launch_bounds__(256) k_norm(Params p) { __shared__ float w8[1024 * 8]; phase_norm(p, w8); }
__global__ void __launch_bounds__(256) k_gemm1(Params p) { EpiProj e{(bf16_t*)(p.ws + OFF_PROJ)}; phase_gemm_simple((const bf16_t*)(p.ws + OFF_XN), (const bf16_t*)(p.ws + OFF_WTIN), MROWS, NPK, DM, e); }
__global__ void __launch_bounds__(256) k_dn_conv(Params p) { phase_dn_conv(p); }
__global__ void __launch_bounds__(256) k_dn_scan(Params p) { __shared__ float sm[2 * (3 * 16 * 128 + 32)]; phase_dn_scan_simple(p, sm); }
__global__ void __launch_bounds__(256) k_dn_out(Params p) { phase_dn_out(p); }
__global__ void __launch_bounds__(256) k_attn(Params p) { __shared__ float sm[4 * 64]; phase_attn_simple(p, sm); }
__global__ void __launch_bounds__(256) k_gemm2(Params p) { EpiOut e{p.x, p.out}; phase_gemm_simple((const bf16_t*)(p.ws + OFF_MIXED), (const bf16_t*)(p.ws + OFF_WTOUT), MROWS, DM, DM, e); }

extern "C" void kernel_launch(void* const* d_in, const int* in_sizes, int n_in, void* d_out, int out_size, void* d_ws, size_t ws_size, hipStream_t stream) {
    (void)in_sizes; (void)n_in; (void)out_size;
    if (ws_size < WS_NEED) { fprintf(stderr, "workspace too small: %zu < %zu\n", ws_size, (size_t)WS_NEED); return; }
    Params p{};
    p.x = (const float*)d_in[0]; p.norm_w = (const float*)d_in[1]; p.w_in = (const float*)d_in[2]; p.conv_w = (const float*)d_in[3]; p.a_log = (const float*)d_in[4];
    p.dt_bias = (const float*)d_in[5]; p.dn_norm_w = (const float*)d_in[6]; p.q_norm_w = (const float*)d_in[7]; p.k_norm_w = (const float*)d_in[8]; p.rel_bias = (const float*)d_in[9];
    p.w_out = (const float*)d_in[10]; p.out = (float*)d_out; p.ws = (unsigned char*)d_ws;
    k_weights<<<1024, 256, 0, stream>>>(p);
    k_norm<<<1024, 256, 0, stream>>>(p);
    k_gemm1<<<2048, 256, 0, stream>>>(p);
    k_dn_conv<<<2048, 256, 0, stream>>>(p);
    k_dn_scan<<<16, 256, 0, stream>>>(p);
    k_dn_out<<<2048, 256, 0, stream>>>(p);
    k_attn<<<4096, 256, 0, stream>>>(p);
    k_gemm2<<<2048, 256, 0, stream>>>(p);
}
```

```cpp
#include <hip/hip_runtime.h>
#include <hip/hip_cooperative_groups.h>
namespace cg = cooperative_groups;
#include <cstdint>
#include <cstdio>

typedef unsigned short bf16_t;
typedef short bf16x8 __attribute__((ext_vector_type(8)));
typedef float f32x4 __attribute__((ext_vector_type(4)));

constexpr int NB = 8, SEQ = 4096, DM = 1024, MROWS = NB * SEQ;
constexpr int DIN = 4104, NPK = 4096;
constexpr int DNH = 4, DNHD = 128, ATH = 8, ATHD = 64;
constexpr float EPS = 1e-6f;

constexpr int PC_DNQ = 0, PC_DNK = 512, PC_DNV = 1024, PC_Z = 1536, PC_AQ = 2048, PC_AK = 2560, PC_AV = 3072, PC_GATE = 3584;

constexpr size_t OFF_XN = 0;
constexpr size_t OFF_WTIN = OFF_XN + (size_t)MROWS * DM * 2;
constexpr size_t OFF_WTOUT = OFF_WTIN + (size_t)NPK * DM * 2;
constexpr size_t OFF_BETA = OFF_WTOUT + (size_t)DM * DM * 2;
constexpr size_t OFF_G = OFF_BETA + (size_t)MROWS * 4 * 4;
constexpr size_t OFF_PROJ = OFF_G + (size_t)MROWS * 4 * 4;
constexpr size_t OFF_DNQ = OFF_PROJ + (size_t)MROWS * NPK * 2;
constexpr size_t OFF_DNK = OFF_DNQ + (size_t)MROWS * 512 * 2;
constexpr size_t OFF_DNV = OFF_DNK + (size_t)MROWS * 512 * 2;
constexpr size_t OFF_MIXED = OFF_DNV + (size_t)MROWS * 512 * 2;
constexpr size_t WS_NEED = OFF_MIXED + (size_t)MROWS * DM * 2;

__device__ __forceinline__ bf16_t f2bf(float f) { unsigned u = __float_as_uint(f); u += 0x7FFFu + ((u >> 16) & 1u); return (bf16_t)(u >> 16); }
__device__ __forceinline__ float bf2f(bf16_t b) { return __uint_as_float(((unsigned)b) << 16); }
__device__ __forceinline__ float wave_sum(float v) {
#pragma unroll
    for (int o = 32; o >= 1; o >>= 1) v += __shfl_xor(v, o);
    return v;
}
__device__ __forceinline__ float wave_max(float v) {
#pragma unroll
    for (int o = 32; o >= 1; o >>= 1) v = fmaxf(v, __shfl_xor(v, o));
    return v;
}
__device__ __forceinline__ float silu_f(float y) { return y / (1.0f + __expf(-y)); }

struct Params {
    const float* x; const float* norm_w; const float* w_in; const float* conv_w; const float* a_log; const float* dt_bias;
    const float* dn_norm_w; const float* q_norm_w; const float* k_norm_w; const float* rel_bias; const float* w_out;
    float* out; unsigned char* ws;
};

__device__ void phase_weights(const Params& p) {
    bf16_t* wt_in = (bf16_t*)(p.ws + OFF_WTIN); bf16_t* wt_out = (bf16_t*)(p.ws + OFF_WTOUT);
    const size_t gt = (size_t)blockIdx.x * blockDim.x + threadIdx.x, gn = (size_t)gridDim.x * blockDim.x;
    for (size_t i = gt; i < (size_t)DM * NPK; i += gn) { const int k = (int)(i / NPK), n = (int)(i % NPK); const int col = n < 2048 ? n : n + 8;
        wt_in[(size_t)n * DM + k] = f2bf(p.w_in[(size_t)k * DIN + col]); }
    for (size_t i = gt; i < (size_t)DM * DM; i += gn) { const int k = (int)(i / DM), n = (int)(i % DM);
        wt_out[(size_t)n * DM + k] = f2bf(p.w_out[(size_t)k * DM + n]); }
}

__device__ void phase_norm(const Params& p, float* lds_w8  ) {
    bf16_t* xn = (bf16_t*)(p.ws + OFF_XN); float* beta = (float*)(p.ws + OFF_BETA); float* gdec = (float*)(p.ws + OFF_G);
    for (int i = threadIdx.x; i < 1024 * 8; i += blockDim.x) { const int k = i >> 3, j = i & 7; lds_w8[i] = p.w_in[(size_t)k * DIN + 2048 + j]; }
    __syncthreads();
    const int lane = threadIdx.x & 63, wpb = blockDim.x >> 6, gw = blockIdx.x * wpb + (threadIdx.x >> 6), nw = gridDim.x * wpb;
    f32x4 nw4[4];
#pragma unroll
    for (int i = 0; i < 4; ++i) nw4[i] = *(const f32x4*)(p.norm_w + i * 256 + lane * 4);
    for (int row = gw; row < MROWS; row += nw) {
        f32x4 xv[4]; float ss = 0.f;
#pragma unroll
        for (int i = 0; i < 4; ++i) { xv[i] = *(const f32x4*)(p.x + (size_t)row * DM + i * 256 + lane * 4); ss += xv[i][0] * xv[i][0] + xv[i][1] * xv[i][1] + xv[i][2] * xv[i][2] + xv[i][3] * xv[i][3]; }
        ss = wave_sum(ss);
        const float rstd = rsqrtf(ss * (1.0f / DM) + EPS);
        float acc[8];
#pragma unroll
        for (int j = 0; j < 8; ++j) acc[j] = 0.f;
#pragma unroll
        for (int i = 0; i < 4; ++i) {
            f32x4 h = xv[i] * rstd * nw4[i];
            uint2 pk; pk.x = (unsigned)f2bf(h[0]) | ((unsigned)f2bf(h[1]) << 16); pk.y = (unsigned)f2bf(h[2]) | ((unsigned)f2bf(h[3]) << 16);
            *(uint2*)(xn + (size_t)row * DM + i * 256 + lane * 4) = pk;
#pragma unroll
            for (int e = 0; e < 4; ++e) { const float* w8 = lds_w8 + (i * 256 + lane * 4 + e) * 8;
#pragma unroll
                for (int j = 0; j < 8; ++j) acc[j] += h[e] * w8[j]; }
        }
#pragma unroll
        for (int j = 0; j < 8; ++j) acc[j] = wave_sum(acc[j]);
        const int b = row / SEQ, s = row % SEQ;
        if (lane == 0) {
#pragma unroll
            for (int j = 0; j < 4; ++j) {
                beta[((size_t)b * 4 + j) * SEQ + s] = 1.0f / (1.0f + expf(-acc[j]));
                const float xx = acc[4 + j] + p.dt_bias[j]; const float sp = xx > 20.f ? xx : log1pf(expf(xx));
                gdec[((size_t)b * 4 + j) * SEQ + s] = -expf(p.a_log[j]) * sp;
            }
        }
    }
}

template <class Epi>
__device__ void phase_gemm_simple(const bf16_t* A, const bf16_t* Bt, int M, int N, int K, const Epi& epi) {
    const int lane = threadIdx.x & 63, wid = threadIdx.x >> 6, wr = wid >> 2, wc = wid & 3, fr = lane & 15, fq = lane >> 4;
    const int ntn = N / 256, ntiles = (M / 128) * ntn;
    for (int tile = blockIdx.x; tile < ntiles; tile += gridDim.x) {
        const int m0 = (tile / ntn) * 128 + wr * 64, n0 = (tile % ntn) * 256 + wc * 64;
        f32x4 acc[4][4];
#pragma unroll
        for (int i = 0; i < 4; ++i)
#pragma unroll
            for (int j = 0; j < 4; ++j) acc[i][j] = (f32x4){0.f, 0.f, 0.f, 0.f};
        const bf16_t* ap = A + (size_t)(m0 + fr) * K + fq * 8; const bf16_t* bp = Bt + (size_t)(n0 + fr) * K + fq * 8;
        for (int k0 = 0; k0 < K; k0 += 32) {
            bf16x8 a[4], b[4];
#pragma unroll
            for (int i = 0; i < 4; ++i) { a[i] = *(const bf16x8*)(ap + (size_t)i * 16 * K + k0); b[i] = *(const bf16x8*)(bp + (size_t)i * 16 * K + k0); }
#pragma unroll
            for (int i = 0; i < 4; ++i)
#pragma unroll
                for (int j = 0; j < 4; ++j) acc[i][j] = __builtin_amdgcn_mfma_f32_16x16x32_bf16(a[i], b[j], acc[i][j], 0, 0, 0);
        }
#pragma unroll
        for (int i = 0; i < 4; ++i)
#pragma unroll
            for (int j = 0; j < 4; ++j)
#pragma unroll
                for (int r = 0; r < 4; ++r) epi(m0 + i * 16 + fq * 4 + r, n0 + j * 16 + fr, acc[i][j][r]);
    }
}
struct EpiProj { bf16_t* proj; __device__ __forceinline__ void operator()(int m, int n, float v) const { proj[(size_t)m * NPK + n] = f2bf(v); } };
struct EpiOut { const float* x; float* out; __device__ __forceinline__ void operator()(int m, int n, float v) const { out[(size_t)m * DM + n] = x[(size_t)m * DM + n] + v; } };

__device__ void phase_dn_conv(const Params& p) {
    const bf16_t* proj = (const bf16_t*)(p.ws + OFF_PROJ);
    bf16_t* dnq = (bf16_t*)(p.ws + OFF_DNQ); bf16_t* dnk = (bf16_t*)(p.ws + OFF_DNK); bf16_t* dnv = (bf16_t*)(p.ws + OFF_DNV);
    const int lane = threadIdx.x & 63, wpb = blockDim.x >> 6, gw = blockIdx.x * wpb + (threadIdx.x >> 6), nw = gridDim.x * wpb;
    for (int item = gw; item < MROWS * 4; item += nw) {
        const int row = item >> 2, h = item & 3, b = row / SEQ, t = row % SEQ;
        float y[3][2];
#pragma unroll
        for (int g = 0; g < 3; ++g)
#pragma unroll
            for (int e = 0; e < 2; ++e) {
                const int c = g * 512 + h * 128 + e * 64 + lane; float a = 0.f;
#pragma unroll
                for (int i = 0; i < 4; ++i) { const int tt = t - 3 + i; if (tt >= 0) a += p.conv_w[i * 1536 + c] * bf2f(proj[(size_t)(b * SEQ + tt) * NPK + c]); }
                y[g][e] = silu_f(a);
            }
        const float sq = wave_sum(y[0][0] * y[0][0] + y[0][1] * y[0][1]), sk = wave_sum(y[1][0] * y[1][0] + y[1][1] * y[1][1]);
        const float rq = rsqrtf(sq + EPS) * 0.08838834764831845f, rk = rsqrtf(sk + EPS);
        const size_t o = ((size_t)(b * 4 + h) * SEQ + t) * 128;
#pragma unroll
        for (int e = 0; e < 2; ++e) { dnq[o + e * 64 + lane] = f2bf(y[0][e] * rq); dnk[o + e * 64 + lane] = f2bf(y[1][e] * rk); dnv[o + e * 64 + lane] = f2bf(y[2][e]); }
    }
}

__device__ void phase_dn_scan_simple(const Params& p, float* lds  , int vb, int vg) {
    const bf16_t* dnq = (const bf16_t*)(p.ws + OFF_DNQ); const bf16_t* dnk = (const bf16_t*)(p.ws + OFF_DNK); const bf16_t* dnv = (const bf16_t*)(p.ws + OFF_DNV);
    const float* beta = (const float*)(p.ws + OFF_BETA); const float* gdec = (const float*)(p.ws + OFF_G);
    float* odn = (float*)(p.ws + OFF_XN);
    const int gpb = blockDim.x >> 8, grp = threadIdx.x >> 8, u = threadIdx.x & 255, lane = u & 63, j = (u >> 6) * 32 + (lane & 31), hf = lane >> 5;
    float* sq = lds + grp * (3 * 16 * 128 + 32); float* sk = sq + 16 * 128; float* sv = sk + 16 * 128; float* sg = sv + 16 * 128; float* sb = sg + 16;
    for (int u0 = vb * gpb; u0 < NB * 4; u0 += vg * gpb) {
        const int unit = u0 + grp;
        float S[64];
#pragma unroll
        for (int i = 0; i < 64; ++i) S[i] = 0.f;
        const size_t base = (size_t)unit * SEQ;
        for (int t0 = 0; t0 < SEQ; t0 += 16) {
            __syncthreads();
#pragma unroll
            for (int tt = 0; tt < 8; ++tt) { const int e = tt * 256 + u; const size_t o = (base + t0) * 128 + e; sq[e] = bf2f(dnq[o]); sk[e] = bf2f(dnk[o]); sv[e] = bf2f(dnv[o]); }
            if (u < 16) { sg[u] = __expf(gdec[base + t0 + u]); sb[u] = beta[base + t0 + u]; }
            __syncthreads();
            for (int tt = 0; tt < 16; ++tt) {
                const float eg = sg[tt], bt = sb[tt]; const float* kk = sk + tt * 128 + hf * 64; const float* qq = sq + tt * 128 + hf * 64;
                float r = 0.f;
#pragma unroll
                for (int i = 0; i < 64; i += 4) { const f32x4 k4 = *(const f32x4*)(kk + i); r += k4[0] * S[i] + k4[1] * S[i + 1] + k4[2] * S[i + 2] + k4[3] * S[i + 3]; }
                r += __shfl_xor(r, 32);
                const float d = bt * (sv[tt * 128 + j] - eg * r);
                float o = 0.f;
#pragma unroll
                for (int i = 0; i < 64; i += 4) { const f32x4 k4 = *(const f32x4*)(kk + i); const f32x4 q4 = *(const f32x4*)(qq + i);
#pragma unroll
                    for (int e = 0; e < 4; ++e) { S[i + e] = eg * S[i + e] + k4[e] * d; o += q4[e] * S[i + e]; } }
                o += __shfl_xor(o, 32);
                if (hf == 0) odn[(base + t0 + tt) * 128 + j] = o;
            }
        }
    }
}

__device__ void phase_dn_out(const Params& p) {
    const float* odn = (const float*)(p.ws + OFF_XN); const bf16_t* proj = (const bf16_t*)(p.ws + OFF_PROJ); bf16_t* mixed = (bf16_t*)(p.ws + OFF_MIXED);
    const int lane = threadIdx.x & 63, wpb = blockDim.x >> 6, gw = blockIdx.x * wpb + (threadIdx.x >> 6), nw = gridDim.x * wpb;
    for (int item = gw; item < MROWS * 4; item += nw) {
        const int row = item >> 2, h = item & 3, b = row / SEQ, t = row % SEQ;
        const size_t o = ((size_t)(b * 4 + h) * SEQ + t) * 128;
        const float v0 = odn[o + lane], v1 = odn[o + 64 + lane];
        const float rstd = rsqrtf(wave_sum(v0 * v0 + v1 * v1) * (1.0f / 128.f) + EPS);
        const float z0 = bf2f(proj[(size_t)row * NPK + PC_Z + h * 128 + lane]), z1 = bf2f(proj[(size_t)row * NPK + PC_Z + h * 128 + 64 + lane]);
        mixed[(size_t)row * DM + h * 128 + lane] = f2bf(v0 * rstd * p.dn_norm_w[lane] * silu_f(z0));
        mixed[(size_t)row * DM + h * 128 + 64 + lane] = f2bf(v1 * rstd * p.dn_norm_w[64 + lane] * silu_f(z1));
    }
}

__device__ __forceinline__ int t5_bucket_dev(int d) {
    if (d < 16) return d;
    int bkt = 16;
    const int bnd[15] = {22, 30, 40, 54, 73, 99, 134, 182, 246, 332, 450, 609, 825, 1117, 1513};
#pragma unroll
    for (int i = 0; i < 15; ++i) bkt += (d >= bnd[i]) ? 1 : 0;
    return bkt;
}
__device__ void phase_attn_simple(const Params& p, float* lds  , int vb, int vg) {
    const bf16_t* proj = (const bf16_t*)(p.ws + OFF_PROJ); bf16_t* mixed = (bf16_t*)(p.ws + OFF_MIXED);
    const int lane = threadIdx.x & 63, wib = threadIdx.x >> 6, wpb = blockDim.x >> 6, gw = vb * wpb + wib, nw = vg * wpb;
    float* wq = lds + wib * 64;
    for (int item = gw; item < NB * ATH * SEQ; item += nw) {
        const int t = item % SEQ, h = (item / SEQ) % ATH, b = item / (SEQ * ATH);
        const size_t row = (size_t)b * SEQ + t;
        const float qraw = bf2f(proj[row * NPK + PC_AQ + h * 64 + lane]);
        const float qrstd = rsqrtf(wave_sum(qraw * qraw) * (1.0f / 64.f) + EPS);
        wq[lane] = qraw * qrstd * p.q_norm_w[lane] * 0.125f * p.k_norm_w[lane];
        float qk[64];
#pragma unroll
        for (int d = 0; d < 64; d += 4) { const f32x4 v = *(const f32x4*)(wq + d); qk[d] = v[0]; qk[d + 1] = v[1]; qk[d + 2] = v[2]; qk[d + 3] = v[3]; }
        float sc[7]; float mx = -INFINITY;
#pragma unroll
        for (int i = 0; i < 7; ++i) {
            const int s = lane + 64 * i; const int pt = s / 129, jj = s - pt * 129; const int r = pt == 0 ? 1 : (pt == 1 ? 4 : 16);
            const int kt = t - jj * r; const bool valid = (s < 387) && (kt >= 0);
            float v = -INFINITY;
            if (valid) {
                const bf16_t* kp = proj + ((size_t)b * SEQ + kt) * NPK + PC_AK + h * 64;
                float dot = 0.f, ssq = 0.f;
#pragma unroll
                for (int c = 0; c < 8; ++c) { const bf16x8 kv = *(const bf16x8*)(kp + c * 8);
#pragma unroll
                    for (int e = 0; e < 8; ++e) { const float kf = bf2f((bf16_t)kv[e]); dot += qk[c * 8 + e] * kf; ssq += kf * kf; } }
                v = dot * rsqrtf(ssq * (1.0f / 64.f) + EPS) + p.rel_bias[h * 32 + t5_bucket_dev(jj * r)];
            }
            sc[i] = v; mx = fmaxf(mx, v);
        }
        mx = wave_max(mx);
        float sum = 0.f;
#pragma unroll
        for (int i = 0; i < 7; ++i) { sc[i] = (sc[i] == -INFINITY) ? 0.f : __expf(sc[i] - mx); sum += sc[i]; }
        sum = wave_sum(sum);
        float o = 0.f;
#pragma unroll
        for (int i = 0; i < 7; ++i) {
            for (int l = 0; l < 64; ++l) {
                const int s = l + 64 * i; if (s >= 387) break;
                const int pt = s / 129, jj = s - pt * 129; const int r = pt == 0 ? 1 : (pt == 1 ? 4 : 16);
                const int kt = t - jj * r;
                const float e = __shfl(sc[i], l);
                if (kt >= 0) o += e * bf2f(proj[((size_t)b * SEQ + kt) * NPK + PC_AV + h * 64 + lane]);
            }
        }
        o /= sum;
        const float gt = bf2f(proj[row * NPK + PC_GATE + h * 64 + lane]);
        mixed[row * DM + 512 + h * 64 + lane] = f2bf(o * silu_f(gt));
    }
}

constexpr int NTHREADS = 512;
constexpr size_t DYN_LDS = 65536;
constexpr int SCAN_BLOCKS = 16;
__global__ void __launch_bounds__(NTHREADS, 2) fwd_mega(Params p) {
    cg::grid_group grid = cg::this_grid();
    extern __shared__ __attribute__((aligned(16))) unsigned char smem[];
    float* smf = (float*)smem;
    phase_weights(p);
    phase_norm(p, smf);
    grid.sync();
    { EpiProj e{(bf16_t*)(p.ws + OFF_PROJ)}; phase_gemm_simple((const bf16_t*)(p.ws + OFF_XN), (const bf16_t*)(p.ws + OFF_WTIN), MROWS, NPK, DM, e); }
    grid.sync();
    phase_dn_conv(p);
    grid.sync();
    if ((int)blockIdx.x < SCAN_BLOCKS) phase_dn_scan_simple(p, smf, blockIdx.x, SCAN_BLOCKS);
    else phase_attn_simple(p, smf, blockIdx.x - SCAN_BLOCKS, gridDim.x - SCAN_BLOCKS);
    grid.sync();
    phase_dn_out(p);
    grid.sync();
    { EpiOut e{p.x, p.out}; phase_gemm_simple((const bf16_t*)(p.ws + OFF_MIXED), (const bf16_t*)(p.ws + OFF_WTOUT), MROWS, DM, DM, e); }
}

extern "C" void kernel_launch(void* const* d_in, const int* in_sizes, int n_in, void* d_out, int out_size, void* d_ws, size_t ws_size, hipStream_t stream) {
    (void)in_sizes; (void)n_in; (void)out_size;
    if (ws_size < WS_NEED) { fprintf(stderr, "workspace too small: %zu < %zu\n", ws_size, (size_t)WS_NEED); return; }
    static int grid_blocks = 0;
    if (!grid_blocks) {
        int dev = 0, cus = 0, per_cu = 0;
        (void)hipGetDevice(&dev);
        (void)hipDeviceGetAttribute(&cus, hipDeviceAttributeMultiprocessorCount, dev);
        (void)hipFuncSetAttribute((const void*)fwd_mega, hipFuncAttributeMaxDynamicSharedMemorySize, (int)DYN_LDS);
        (void)hipOccupancyMaxActiveBlocksPerMultiprocessor(&per_cu, fwd_mega, NTHREADS, DYN_LDS);
        if (per_cu > 1) per_cu = 1;
        grid_blocks = cus * per_cu;
        if (grid_blocks <= SCAN_BLOCKS) fprintf(stderr, "grid too small: %d\n", grid_blocks);
    }
    Params p{};
    p.x = (const float*)d_in[0]; p.norm_w = (const float*)d_in[1]; p.w_in = (const float*)d_in[2]; p.conv_w = (const float*)d_in[3]; p.a_log = (const float*)d_in[4];
    p.dt_bias = (const float*)d_in[5]; p.dn_norm_w = (const float*)d_in[6]; p.q_norm_w = (const float*)d_in[7]; p.k_norm_w = (const float*)d_in[8]; p.rel_bias = (const float*)d_in[9];
    p.w_out = (const float*)d_in[10]; p.out = (float*)d_out; p.ws = (unsigned char*)d_ws;
    void* args[] = {&p};
    hipError_t e = hipLaunchCooperativeKernel((const void*)fwd_mega, dim3(grid_blocks), dim3(NTHREADS), args, DYN_LDS, stream);
    if (e != hipSuccess) fprintf(stderr, "cooperative launch failed: %s (grid %d)\n", hipGetErrorString(e), grid_blocks);
}
```

```cpp
#include <hip/hip_runtime.h>
#include <hip/hip_cooperative_groups.h>
namespace cg = cooperative_groups;
#include <cstdint>
#include <cstdio>

typedef unsigned short bf16_t;
typedef short bf16x8 __attribute__((ext_vector_type(8)));
typedef float f32x4 __attribute__((ext_vector_type(4)));

constexpr int NB = 8, SEQ = 4096, DM = 1024, MROWS = NB * SEQ;
constexpr int DIN = 4104, NPK = 4096;
constexpr int DNH = 4, DNHD = 128, ATH = 8, ATHD = 64;
constexpr float EPS = 1e-6f;

constexpr int PC_DNQ = 0, PC_DNK = 512, PC_DNV = 1024, PC_Z = 1536, PC_AQ = 2048, PC_AK = 2560, PC_AV = 3072, PC_GATE = 3584;

constexpr size_t OFF_XN = 0;
constexpr size_t OFF_WTIN = OFF_XN + (size_t)MROWS * DM * 2;
constexpr size_t OFF_WTOUT = OFF_WTIN + (size_t)NPK * DM * 2;
constexpr size_t OFF_BETA = OFF_WTOUT + (size_t)DM * DM * 2;
constexpr size_t OFF_G = OFF_BETA + (size_t)MROWS * 4 * 4;
constexpr size_t OFF_PROJ = OFF_G + (size_t)MROWS * 4 * 4;
constexpr size_t OFF_DNQ = OFF_PROJ + (size_t)MROWS * NPK * 2;
constexpr size_t OFF_DNK = OFF_DNQ + (size_t)MROWS * 512 * 2;
constexpr size_t OFF_DNV = OFF_DNK + (size_t)MROWS * 512 * 2;
constexpr size_t OFF_MIXED = OFF_DNV + (size_t)MROWS * 512 * 2;
constexpr size_t WS_NEED = OFF_MIXED + (size_t)MROWS * DM * 2;

__device__ __forceinline__ bf16_t f2bf(float f) { unsigned u = __float_as_uint(f); u += 0x7FFFu + ((u >> 16) & 1u); return (bf16_t)(u >> 16); }
__device__ __forceinline__ float bf2f(bf16_t b) { return __uint_as_float(((unsigned)b) << 16); }
__device__ __forceinline__ float wave_sum(float v) {
#pragma unroll
    for (int o = 32; o >= 1; o >>= 1) v += __shfl_xor(v, o);
    return v;
}
__device__ __forceinline__ float wave_max(float v) {
#pragma unroll
    for (int o = 32; o >= 1; o >>= 1) v = fmaxf(v, __shfl_xor(v, o));
    return v;
}
__device__ __forceinline__ float silu_f(float y) { return y / (1.0f + __expf(-y)); }

struct Params {
    const float* x; const float* norm_w; const float* w_in; const float* conv_w; const float* a_log; const float* dt_bias;
    const float* dn_norm_w; const float* q_norm_w; const float* k_norm_w; const float* rel_bias; const float* w_out;
    float* out; unsigned char* ws;
};

namespace pg8 {
#define PG8_LAS __attribute__((address_space(3)))
typedef unsigned short bf16_t;
typedef short bf16x8 __attribute__((ext_vector_type(8)));
typedef float f32x4 __attribute__((ext_vector_type(4)));
typedef unsigned u32x4 __attribute__((ext_vector_type(4)));
constexpr int BM = 256, BK = 64, HALF = 128, HTB = HALF * BK * 2  , STAGE_BYTES = 8 * HTB, NXCD = 8, WGM = 8;

__host__ __device__ __forceinline__ int lds_byte(int r, int c) { const int st = (r >> 4) * 2 + (c >> 5), rr = r & 15, cc = c & 31, ob = rr * 64 + cc * 2; return st * 1024 + (ob ^ (((ob >> 9) & 1) << 5)); }
__host__ __device__ __forceinline__ void stage_rc(int b, int& R, int& C) { const int st = b / 1024, sb = b % 1024, swz = sb ^ (((sb >> 9) & 1) << 5); R = (st >> 1) * 16 + swz / 64; C = (st & 1) * 32 + (swz % 64) / 2; }
__host__ __device__ __forceinline__ int perm32(int rho) { const int n = rho >> 4, i = rho & 15; return 8 * (i >> 2) + 4 * n + (i & 3); }

struct Unit { int pm, pn; };
struct Gemm { const bf16_t* A; const bf16_t* Bt; int M, N, K; };

struct StaticOrder {
    int nM, nN, nwg, G, c;
    __host__ __device__ void init(int M, int N, int G_, int c_) { nM = M / BM; nN = N / BM; nwg = nM * nN; G = G_; c = c_; }
    __host__ __device__ bool next(int i, Unit& u) const {
        const long L = (long)i * G + c; if (L >= nwg) return false;
        int wgid = (int)L; { const int q = nwg / NXCD, r = nwg % NXCD, xcd = wgid % NXCD, off = wgid / NXCD; wgid = (xcd < r ? xcd * (q + 1) : r * (q + 1) + (xcd - r) * q) + off; }
        const int nig = WGM * nN, gid = wgid / nig, fm = gid * WGM, gsz = (nM - fm) < WGM ? (nM - fm) : WGM;
        u.pm = fm + ((wgid % nig) % gsz); u.pn = (wgid % nig) / gsz; return true;
    }
    __device__ __forceinline__ void a_ready(const Unit&) const {}
    __device__ __forceinline__ void done(const Unit&) const {}
};

__device__ __forceinline__ unsigned cvt_pk_bf16(float lo, float hi) { unsigned r; asm volatile("v_cvt_pk_bf16_f32 %0, %1, %2" : "=v"(r) : "v"(lo), "v"(hi)); return r; }
typedef float f32x2 __attribute__((ext_vector_type(2)));
template <class Epi, class Sched, bool ALIGN_EPI = false, bool SP2 = false>
__device__ __forceinline__ void gemm_phase(PG8_LAS unsigned char* lds, const Gemm g, const Sched& S, const Epi& E) {
    const int tid = threadIdx.x, wid = __builtin_amdgcn_readfirstlane(tid >> 6), lane = tid & 63, wr = wid >> 2, wc = wid & 3, fr = lane & 15, fq = lane >> 4;
    const int K = g.K, nt = K / BK;
    unsigned voffA[2], voffB[2];
#pragma unroll
    for (int i = 0; i < 2; ++i) { int R, C; stage_rc(tid * 16 + i * 8192, R, C); const int Rb = Epi::PERM ? ((R & ~31) + perm32(R & 31)) : R;
        voffA[i] = (unsigned)(R * K + C) * 2u; voffB[i] = (unsigned)(Rb * K + C) * 2u; }
    const size_t kstep = (size_t)(BK * 2);
    const size_t hstep = (size_t)HALF * K * 2;
    const size_t tstep = 2 * hstep;
    const unsigned ldsw = (unsigned)wid * 1024u;
    const int aoff = lds_byte(wr * 64 + fr, fq * 8), boff = lds_byte(wc * 32 + fr, fq * 8);
#define PG8_SA(b, h) (((b) * 2 + (h)) * HTB)
#define PG8_SB(b, h) ((4 + (b) * 2 + (h)) * HTB)
#define PG8_STAGE(bufoff, gbase, voff) do { _Pragma("unroll") for (int _i = 0; _i < 2; ++_i) \
        __builtin_amdgcn_global_load_lds((const unsigned*)((const char*)(gbase) + (voff)[_i]), (PG8_LAS unsigned*)(lds + (bufoff) + ldsw + _i * 8192), 16, 0, 0); } while (0)
#define PG8_LDA(dst, b, h) do { _Pragma("unroll") for (int m = 0; m < 4; ++m) _Pragma("unroll") for (int k = 0; k < 2; ++k) dst[m][k] = *(const PG8_LAS bf16x8*)(lds + PG8_SA(b, h) + aoff + m * 2048 + k * 1024); } while (0)
#define PG8_LDB(dst, b, h) do { _Pragma("unroll") for (int n = 0; n < 2; ++n) _Pragma("unroll") for (int k = 0; k < 2; ++k) dst[n][k] = *(const PG8_LAS bf16x8*)(lds + PG8_SB(b, h) + boff + n * 2048 + k * 1024); } while (0)
#define PG8_MMA(ai, bj, At, Bt) do { __builtin_amdgcn_s_setprio(1); _Pragma("unroll") for (int m = 0; m < 4; ++m) _Pragma("unroll") for (int n = 0; n < 2; ++n) _Pragma("unroll") for (int k = 0; k < 2; ++k) \
        acc[ai][bj][m][n] = __builtin_amdgcn_mfma_f32_16x16x32_bf16(Bt[n][k], At[m][k], acc[ai][bj][m][n], 0, 0, 0); __builtin_amdgcn_s_setprio(0); } while (0)
#define PG8_WAIT_V(n) asm volatile("s_waitcnt vmcnt(" #n ")" ::: "memory")
#define PG8_WAIT_L(n) asm volatile("s_waitcnt lgkmcnt(" #n ")" ::: "memory")
#define PG8_BAR __builtin_amdgcn_s_barrier()
#define PG8_SCHED __builtin_amdgcn_sched_barrier(0)
    Unit cur, nxt; int ui = 0;
    if (!S.next(0, cur)) return;
    f32x4 acc[2][2][4][2];
#pragma unroll
    for (int a = 0; a < 2; ++a)
#pragma unroll
        for (int b = 0; b < 2; ++b)
#pragma unroll
            for (int m = 0; m < 4; ++m)
#pragma unroll
                for (int n = 0; n < 2; ++n) acc[a][b][m][n] = (f32x4){0.f, 0.f, 0.f, 0.f};
    bf16x8 At[4][2], B0[2][2], B1[2][2];
    const char* cA = (const char*)g.A + (size_t)cur.pm * tstep; const char* cB = (const char*)g.Bt + (size_t)cur.pn * tstep;
    S.a_ready(cur);
    if constexpr (SP2) {
        PG8_STAGE(PG8_SB(0, 0), cB, voffB); PG8_STAGE(PG8_SB(0, 1), cB + hstep, voffB); PG8_STAGE(PG8_SA(0, 0), cA, voffA); PG8_STAGE(PG8_SA(0, 1), cA + hstep, voffA);
        if (wr == 1) PG8_BAR;
        PG8_WAIT_V(2); PG8_BAR;
        PG8_STAGE(PG8_SB(1, 0), cB + kstep, voffB); PG8_STAGE(PG8_SA(1, 0), cA + kstep, voffA); PG8_STAGE(PG8_SB(1, 1), cB + hstep + kstep, voffB);
        PG8_WAIT_V(6); PG8_BAR;
    } else {
        PG8_STAGE(PG8_SB(0, 0), cB, voffB); PG8_STAGE(PG8_SA(0, 0), cA, voffA); PG8_STAGE(PG8_SB(0, 1), cB + hstep, voffB); PG8_STAGE(PG8_SA(0, 1), cA + hstep, voffA);
        if (wr == 1) PG8_BAR;
        PG8_WAIT_V(4); PG8_BAR;
        PG8_STAGE(PG8_SB(1, 0), cB + kstep, voffB); PG8_STAGE(PG8_SA(1, 0), cA + kstep, voffA); PG8_STAGE(PG8_SB(1, 1), cB + hstep + kstep, voffB);
        PG8_WAIT_V(6); PG8_BAR;
    }
    for (;;) {
        const bool has_next = S.next(ui + 1, nxt);
        const char* nA = has_next ? (const char*)g.A + (size_t)nxt.pm * tstep : cA; const char* nB = has_next ? (const char*)g.Bt + (size_t)nxt.pn * tstep : cB;
        for (int t = 0; t < nt; t += 2) {
            const bool last = (t == nt - 2);
            const char* a1 = cA + (size_t)(t + 1) * kstep;
            const char* a2 = last ? nA : cA + (size_t)(t + 2) * kstep; const char* b2 = last ? nB : cB + (size_t)(t + 2) * kstep;
            const char* a3 = a2 + kstep; const char* b3 = b2 + kstep;
            if (last && has_next) S.a_ready(nxt);
            if constexpr (SP2) {
            PG8_LDB(B0, 0, 0); PG8_LDB(B1, 0, 1); PG8_SCHED; PG8_LDA(At, 0, 0); PG8_STAGE(PG8_SA(1, 1), a1 + hstep, voffA);
            PG8_WAIT_V(8); PG8_WAIT_L(0); PG8_BAR; PG8_MMA(0, 0, At, B0); PG8_MMA(0, 1, At, B1); PG8_BAR; PG8_SCHED;
            PG8_LDA(At, 0, 1); PG8_STAGE(PG8_SB(0, 0), b2, voffB); PG8_STAGE(PG8_SB(0, 1), b2 + hstep, voffB); PG8_STAGE(PG8_SA(0, 0), a2, voffA);
            PG8_WAIT_V(8); PG8_WAIT_L(0); PG8_BAR; PG8_MMA(1, 0, At, B0); PG8_MMA(1, 1, At, B1); PG8_BAR; PG8_SCHED;
            PG8_LDB(B0, 1, 0); PG8_LDB(B1, 1, 1); PG8_SCHED; PG8_LDA(At, 1, 0); PG8_STAGE(PG8_SA(0, 1), a2 + hstep, voffA);
            PG8_WAIT_V(8); PG8_WAIT_L(0); PG8_BAR; PG8_MMA(0, 0, At, B0); PG8_MMA(0, 1, At, B1); PG8_BAR; PG8_SCHED;
            PG8_LDA(At, 1, 1); PG8_STAGE(PG8_SB(1, 0), b3, voffB); PG8_STAGE(PG8_SB(1, 1), b3 + hstep, voffB); PG8_STAGE(PG8_SA(1, 0), a3, voffA);
            PG8_WAIT_V(8); PG8_WAIT_L(0); PG8_BAR; PG8_MMA(1, 0, At, B0); PG8_MMA(1, 1, At, B1); PG8_BAR; PG8_SCHED;
            } else {
            PG8_LDB(B0, 0, 0); PG8_SCHED; PG8_LDA(At, 0, 0); PG8_STAGE(PG8_SA(1, 1), a1 + hstep, voffA);
            PG8_WAIT_L(8); PG8_BAR; PG8_WAIT_L(0); PG8_MMA(0, 0, At, B0); PG8_BAR; PG8_SCHED;
            PG8_LDB(B1, 0, 1); PG8_STAGE(PG8_SB(0, 0), b2, voffB);
            PG8_BAR; PG8_WAIT_L(0); PG8_MMA(0, 1, At, B1); PG8_BAR;
            PG8_LDA(At, 0, 1); PG8_STAGE(PG8_SA(0, 0), a2, voffA);
            PG8_BAR; PG8_WAIT_L(0); PG8_MMA(1, 0, At, B0); PG8_BAR; PG8_SCHED;
            PG8_STAGE(PG8_SB(0, 1), b2 + hstep, voffB);
            PG8_WAIT_V(6); PG8_BAR; PG8_MMA(1, 1, At, B1); PG8_BAR;
            PG8_LDB(B0, 1, 0); PG8_SCHED; PG8_LDA(At, 1, 0); PG8_STAGE(PG8_SA(0, 1), a2 + hstep, voffA);
            PG8_WAIT_L(8); PG8_BAR; PG8_WAIT_L(0); PG8_MMA(0, 0, At, B0); PG8_BAR; PG8_SCHED;
            PG8_LDB(B1, 1, 1); PG8_STAGE(PG8_SB(1, 0), b3, voffB);
            PG8_BAR; PG8_WAIT_L(0); PG8_MMA(0, 1, At, B1); PG8_BAR;
            PG8_LDA(At, 1, 1); PG8_STAGE(PG8_SA(1, 0), a3, voffA);
            PG8_BAR; PG8_WAIT_L(0); PG8_MMA(1, 0, At, B0); PG8_BAR; PG8_SCHED;
            PG8_STAGE(PG8_SB(1, 1), b3 + hstep, voffB);
            PG8_WAIT_V(6); PG8_BAR; PG8_MMA(1, 1, At, B1); PG8_BAR;
            }
        }
        if constexpr (ALIGN_EPI) { if (wr == 0) PG8_BAR; }
        if constexpr (!Epi::AFTER_DRAIN) { E(acc, cur, wr, wc, fr, fq); S.done(cur); }
        if (!has_next) break;
#pragma unroll
        for (int a = 0; a < 2; ++a)
#pragma unroll
            for (int b = 0; b < 2; ++b)
#pragma unroll
                for (int m = 0; m < 4; ++m)
#pragma unroll
                    for (int n = 0; n < 2; ++n) acc[a][b][m][n] = (f32x4){0.f, 0.f, 0.f, 0.f};
        cur = nxt; cA = nA; cB = nB; ++ui;
        if constexpr (ALIGN_EPI) { if (wr == 1) PG8_BAR; }
    }
    PG8_WAIT_V(0);
    if constexpr (!ALIGN_EPI) { if (wr == 0) PG8_BAR; }
    PG8_BAR;
    if constexpr (Epi::AFTER_DRAIN) { E.fused(acc, cur, wr, wc, fr, fq, lds, wid, lane); S.done(cur); }
#undef PG8_SA
#undef PG8_SB
#undef PG8_STAGE
#undef PG8_LDA
#undef PG8_LDB
#undef PG8_MMA
#undef PG8_WAIT_V
#undef PG8_WAIT_L
#undef PG8_BAR
#undef PG8_SCHED
}
}

struct EpiProjRaw {
    static constexpr bool PERM = true, AFTER_DRAIN = false;
    bf16_t* O;
    __device__ __forceinline__ void operator()(const f32x4 (&acc)[2][2][4][2], const pg8::Unit& u, int wr, int wc, int fr, int fq) const {
        const int row0 = u.pm * 256 + wr * 64 + fr, col0 = u.pn * 256 + wc * 32 + 8 * fq;
#pragma unroll
        for (int ai = 0; ai < 2; ++ai)
#pragma unroll
            for (int m = 0; m < 4; ++m) { bf16_t* rowp = O + (size_t)(row0 + ai * 128 + m * 16) * NPK + col0;
#pragma unroll
                for (int bj = 0; bj < 2; ++bj) { const f32x4 v0 = acc[ai][bj][m][0], v1 = acc[ai][bj][m][1]; pg8::u32x4 w;
                    w.x = pg8::cvt_pk_bf16(v0[0], v0[1]); w.y = pg8::cvt_pk_bf16(v0[2], v0[3]); w.z = pg8::cvt_pk_bf16(v1[0], v1[1]); w.w = pg8::cvt_pk_bf16(v1[2], v1[3]);
                    *(pg8::u32x4*)(rowp + bj * 128) = w; } }
    }
};
struct EpiOutRes {
    static constexpr bool PERM = false, AFTER_DRAIN = false;
    const float* X; float* C;
    __device__ __forceinline__ void operator()(const f32x4 (&acc)[2][2][4][2], const pg8::Unit& u, int wr, int wc, int fr, int fq) const {
        const int row0 = u.pm * 256 + wr * 64 + fr, col0 = u.pn * 256 + wc * 32 + 4 * fq;
#pragma unroll
        for (int ai = 0; ai < 2; ++ai)
#pragma unroll
            for (int m = 0; m < 4; ++m) { const size_t off = (size_t)(row0 + ai * 128 + m * 16) * DM + col0;
#pragma unroll
                for (int bj = 0; bj < 2; ++bj)
#pragma unroll
                    for (int n = 0; n < 2; ++n) { const size_t o = off + bj * 128 + n * 16; *(f32x4*)(C + o) = *(const f32x4*)(X + o) + acc[ai][bj][m][n]; } }
    }
};

__device__ void phase_weights(const Params& p) {
    bf16_t* wt_in = (bf16_t*)(p.ws + OFF_WTIN); bf16_t* wt_out = (bf16_t*)(p.ws + OFF_WTOUT);
    const size_t gt = (size_t)blockIdx.x * blockDim.x + threadIdx.x, gn = (size_t)gridDim.x * blockDim.x;
    for (size_t i = gt; i < (size_t)DM * NPK; i += gn) { const int k = (int)(i / NPK), n = (int)(i % NPK); const int col = n < 2048 ? n : n + 8;
        wt_in[(size_t)n * DM + k] = f2bf(p.w_in[(size_t)k * DIN + col]); }
    for (size_t i = gt; i < (size_t)DM * DM; i += gn) { const int k = (int)(i / DM), n = (int)(i % DM);
        wt_out[(size_t)n * DM + k] = f2bf(p.w_out[(size_t)k * DM + n]); }
}

__device__ void phase_norm(const Params& p, float* lds_w8  ) {
    bf16_t* xn = (bf16_t*)(p.ws + OFF_XN); float* beta = (float*)(p.ws + OFF_BETA); float* gdec = (float*)(p.ws + OFF_G);
    for (int i = threadIdx.x; i < 1024 * 8; i += blockDim.x) { const int k = i >> 3, j = i & 7; lds_w8[i] = p.w_in[(size_t)k * DIN + 2048 + j]; }
    __syncthreads();
    const int lane = threadIdx.x & 63, wpb = blockDim.x >> 6, gw = blockIdx.x * wpb + (threadIdx.x >> 6), nw = gridDim.x * wpb;
    f32x4 nw4[4];
#pragma unroll
    for (int i = 0; i < 4; ++i) nw4[i] = *(const f32x4*)(p.norm_w + i * 256 + lane * 4);
    for (int row = gw; row < MROWS; row += nw) {
        f32x4 xv[4]; float ss = 0.f;
#pragma unroll
        for (int i = 0; i < 4; ++i) { xv[i] = *(const f32x4*)(p.x + (size_t)row * DM + i * 256 + lane * 4); ss += xv[i][0] * xv[i][0] + xv[i][1] * xv[i][1] + xv[i][2] * xv[i][2] + xv[i][3] * xv[i][3]; }
        ss = wave_sum(ss);
        const float rstd = rsqrtf(ss * (1.0f / DM) + EPS);
        float acc[8];
#pragma unroll
        for (int j = 0; j < 8; ++j) acc[j] = 0.f;
#pragma unroll
        for (int i = 0; i < 4; ++i) {
            f32x4 h = xv[i] * rstd * nw4[i];
            uint2 pk; pk.x = (unsigned)f2bf(h[0]) | ((unsigned)f2bf(h[1]) << 16); pk.y = (unsigned)f2bf(h[2]) | ((unsigned)f2bf(h[3]) << 16);
            *(uint2*)(xn + (size_t)row * DM + i * 256 + lane * 4) = pk;
#pragma unroll
            for (int e = 0; e < 4; ++e) { const float* w8 = lds_w8 + (i * 256 + lane * 4 + e) * 8;
#pragma unroll
                for (int j = 0; j < 8; ++j) acc[j] += h[e] * w8[j]; }
        }
#pragma unroll
        for (int j = 0; j < 8; ++j) acc[j] = wave_sum(acc[j]);
        const int b = row / SEQ, s = row % SEQ;
        if (lane == 0) {
#pragma unroll
            for (int j = 0; j < 4; ++j) {
                beta[((size_t)b * 4 + j) * SEQ + s] = 1.0f / (1.0f + expf(-acc[j]));
                const float xx = acc[4 + j] + p.dt_bias[j]; const float sp = xx > 20.f ? xx : log1pf(expf(xx));
                gdec[((size_t)b * 4 + j) * SEQ + s] = -expf(p.a_log[j]) * sp;
            }
        }
    }
}

template <class Epi>
__device__ void phase_gemm_simple(const bf16_t* A, const bf16_t* Bt, int M, int N, int K, const Epi& epi) {
    const int lane = threadIdx.x & 63, wid = threadIdx.x >> 6, wr = wid >> 2, wc = wid & 3, fr = lane & 15, fq = lane >> 4;
    const int ntn = N / 256, ntiles = (M / 128) * ntn;
    for (int tile = blockIdx.x; tile < ntiles; tile += gridDim.x) {
        const int m0 = (tile / ntn) * 128 + wr * 64, n0 = (tile % ntn) * 256 + wc * 64;
        f32x4 acc[4][4];
#pragma unroll
        for (int i = 0; i < 4; ++i)
#pragma unroll
            for (int j = 0; j < 4; ++j) acc[i][j] = (f32x4){0.f, 0.f, 0.f, 0.f};
        const bf16_t* ap = A + (size_t)(m0 + fr) * K + fq * 8; const bf16_t* bp = Bt + (size_t)(n0 + fr) * K + fq * 8;
        for (int k0 = 0; k0 < K; k0 += 32) {
            bf16x8 a[4], b[4];
#pragma unroll
            for (int i = 0; i < 4; ++i) { a[i] = *(const bf16x8*)(ap + (size_t)i * 16 * K + k0); b[i] = *(const bf16x8*)(bp + (size_t)i * 16 * K + k0); }
#pragma unroll
            for (int i = 0; i < 4; ++i)
#pragma unroll
                for (int j = 0; j < 4; ++j) acc[i][j] = __builtin_amdgcn_mfma_f32_16x16x32_bf16(a[i], b[j], acc[i][j], 0, 0, 0);
        }
#pragma unroll
        for (int i = 0; i < 4; ++i)
#pragma unroll
            for (int j = 0; j < 4; ++j)
#pragma unroll
                for (int r = 0; r < 4; ++r) epi(m0 + i * 16 + fq * 4 + r, n0 + j * 16 + fr, acc[i][j][r]);
    }
}
struct EpiProj { bf16_t* proj; __device__ __forceinline__ void operator()(int m, int n, float v) const { proj[(size_t)m * NPK + n] = f2bf(v); } };
struct EpiOut { const float* x; float* out; __device__ __forceinline__ void operator()(int m, int n, float v) const { out[(size_t)m * DM + n] = x[(size_t)m * DM + n] + v; } };

__device__ void phase_dn_conv(const Params& p) {
    const bf16_t* proj = (const bf16_t*)(p.ws + OFF_PROJ);
    bf16_t* dnq = (bf16_t*)(p.ws + OFF_DNQ); bf16_t* dnk = (bf16_t*)(p.ws + OFF_DNK); bf16_t* dnv = (bf16_t*)(p.ws + OFF_DNV);
    const int lane = threadIdx.x & 63, wpb = blockDim.x >> 6, gw = blockIdx.x * wpb + (threadIdx.x >> 6), nw = gridDim.x * wpb;
    for (int item = gw; item < MROWS * 4; item += nw) {
        const int row = item >> 2, h = item & 3, b = row / SEQ, t = row % SEQ;
        float y[3][2];
#pragma unroll
        for (int g = 0; g < 3; ++g)
#pragma unroll
            for (int e = 0; e < 2; ++e) {
                const int c = g * 512 + h * 128 + e * 64 + lane; float a = 0.f;
#pragma unroll
                for (int i = 0; i < 4; ++i) { const int tt = t - 3 + i; if (tt >= 0) a += p.conv_w[i * 1536 + c] * bf2f(proj[(size_t)(b * SEQ + tt) * NPK + c]); }
                y[g][e] = silu_f(a);
            }
        const float sq = wave_sum(y[0][0] * y[0][0] + y[0][1] * y[0][1]), sk = wave_sum(y[1][0] * y[1][0] + y[1][1] * y[1][1]);
        const float rq = rsqrtf(sq + EPS) * 0.08838834764831845f, rk = rsqrtf(sk + EPS);
        const size_t o = ((size_t)(b * 4 + h) * SEQ + t) * 128;
#pragma unroll
        for (int e = 0; e < 2; ++e) { dnq[o + e * 64 + lane] = f2bf(y[0][e] * rq); dnk[o + e * 64 + lane] = f2bf(y[1][e] * rk); dnv[o + e * 64 + lane] = f2bf(y[2][e]); }
    }
}

__device__ void phase_dn_scan_simple(const Params& p, float* lds  , int vb, int vg) {
    const bf16_t* dnq = (const bf16_t*)(p.ws + OFF_DNQ); const bf16_t* dnk = (const bf16_t*)(p.ws + OFF_DNK); const bf16_t* dnv = (const bf16_t*)(p.ws + OFF_DNV);
    const float* beta = (const float*)(p.ws + OFF_BETA); const float* gdec = (const float*)(p.ws + OFF_G);
    float* odn = (float*)(p.ws + OFF_XN);
    const int gpb = blockDim.x >> 8, grp = threadIdx.x >> 8, u = threadIdx.x & 255, lane = u & 63, j = (u >> 6) * 32 + (lane & 31), hf = lane >> 5;
    float* sq = lds + grp * (3 * 16 * 128 + 32); float* sk = sq + 16 * 128; float* sv = sk + 16 * 128; float* sg = sv + 16 * 128; float* sb = sg + 16;
    for (int u0 = vb * gpb; u0 < NB * 4; u0 += vg * gpb) {
        const int unit = u0 + grp;
        float S[64];
#pragma unroll
        for (int i = 0; i < 64; ++i) S[i] = 0.f;
        const size_t base = (size_t)unit * SEQ;
        for (int t0 = 0; t0 < SEQ; t0 += 16) {
            __syncthreads();
#pragma unroll
            for (int tt = 0; tt < 8; ++tt) { const int e = tt * 256 + u; const size_t o = (base + t0) * 128 + e; sq[e] = bf2f(dnq[o]); sk[e] = bf2f(dnk[o]); sv[e] = bf2f(dnv[o]); }
            if (u < 16) { sg[u] = __expf(gdec[base + t0 + u]); sb[u] = beta[base + t0 + u]; }
            __syncthreads();
            for (int tt = 0; tt < 16; ++tt) {
                const float eg = sg[tt], bt = sb[tt]; const float* kk = sk + tt * 128 + hf * 64; const float* qq = sq + tt * 128 + hf * 64;
                float r = 0.f;
#pragma unroll
                for (int i = 0; i < 64; i += 4) { const f32x4 k4 = *(const f32x4*)(kk + i); r += k4[0] * S[i] + k4[1] * S[i + 1] + k4[2] * S[i + 2] + k4[3] * S[i + 3]; }
                r += __shfl_xor(r, 32);
                const float d = bt * (sv[tt * 128 + j] - eg * r);
                float o = 0.f;
#pragma unroll
                for (int i = 0; i < 64; i += 4) { const f32x4 k4 = *(const f32x4*)(kk + i); const f32x4 q4 = *(const f32x4*)(qq + i);
#pragma unroll
                    for (int e = 0; e < 4; ++e) { S[i + e] = eg * S[i + e] + k4[e] * d; o += q4[e] * S[i + e]; } }
                o += __shfl_xor(o, 32);
                if (hf == 0) odn[(base + t0 + tt) * 128 + j] = o;
            }
        }
    }
}

__device__ void phase_dn_out(const Params& p) {
    const float* odn = (const float*)(p.ws + OFF_XN); const bf16_t* proj = (const bf16_t*)(p.ws + OFF_PROJ); bf16_t* mixed = (bf16_t*)(p.ws + OFF_MIXED);
    const int lane = threadIdx.x & 63, wpb = blockDim.x >> 6, gw = blockIdx.x * wpb + (threadIdx.x >> 6), nw = gridDim.x * wpb;
    for (int item = gw; item < MROWS * 4; item += nw) {
        const int row = item >> 2, h = item & 3, b = row / SEQ, t = row % SEQ;
        const size_t o = ((size_t)(b * 4 + h) * SEQ + t) * 128;
        const float v0 = odn[o + lane], v1 = odn[o + 64 + lane];
        const float rstd = rsqrtf(wave_sum(v0 * v0 + v1 * v1) * (1.0f / 128.f) + EPS);
        const float z0 = bf2f(proj[(size_t)row * NPK + PC_Z + h * 128 + lane]), z1 = bf2f(proj[(size_t)row * NPK + PC_Z + h * 128 + 64 + lane]);
        mixed[(size_t)row * DM + h * 128 + lane] = f2bf(v0 * rstd * p.dn_norm_w[lane] * silu_f(z0));
        mixed[(size_t)row * DM + h * 128 + 64 + lane] = f2bf(v1 * rstd * p.dn_norm_w[64 + lane] * silu_f(z1));
    }
}

__device__ __forceinline__ int t5_bucket_dev(int d) {
    if (d < 16) return d;
    int bkt = 16;
    const int bnd[15] = {22, 30, 40, 54, 73, 99, 134, 182, 246, 332, 450, 609, 825, 1117, 1513};
#pragma unroll
    for (int i = 0; i < 15; ++i) bkt += (d >= bnd[i]) ? 1 : 0;
    return bkt;
}
__device__ void phase_attn_simple(const Params& p, float* lds  , int vb, int vg) {
    const bf16_t* proj = (const bf16_t*)(p.ws + OFF_PROJ); bf16_t* mixed = (bf16_t*)(p.ws + OFF_MIXED);
    const int lane = threadIdx.x & 63, wib = threadIdx.x >> 6, wpb = blockDim.x >> 6, gw = vb * wpb + wib, nw = vg * wpb;
    float* wq = lds + wib * 64;
    for (int item = gw; item < NB * ATH * SEQ; item += nw) {
        const int t = item % SEQ, h = (item / SEQ) % ATH, b = item / (SEQ * ATH);
        const size_t row = (size_t)b * SEQ + t;
        const float qraw = bf2f(proj[row * NPK + PC_AQ + h * 64 + lane]);
        const float qrstd = rsqrtf(wave_sum(qraw * qraw) * (1.0f / 64.f) + EPS);
        wq[lane] = qraw * qrstd * p.q_norm_w[lane] * 0.125f * p.k_norm_w[lane];
        float qk[64];
#pragma unroll
        for (int d = 0; d < 64; d += 4) { const f32x4 v = *(const f32x4*)(wq + d); qk[d] = v[0]; qk[d + 1] = v[1]; qk[d + 2] = v[2]; qk[d + 3] = v[3]; }
        float sc[7]; float mx = -INFINITY;
#pragma unroll
        for (int i = 0; i < 7; ++i) {
            const int s = lane + 64 * i; const int pt = s / 129, jj = s - pt * 129; const int r = pt == 0 ? 1 : (pt == 1 ? 4 : 16);
            const int kt = t - jj * r; const bool valid = (s < 387) && (kt >= 0);
            float v = -INFINITY;
            if (valid) {
                const bf16_t* kp = proj + ((size_t)b * SEQ + kt) * NPK + PC_AK + h * 64;
                float dot = 0.f, ssq = 0.f;
#pragma unroll
                for (int c = 0; c < 8; ++c) { const bf16x8 kv = *(const bf16x8*)(kp + c * 8);
#pragma unroll
                    for (int e = 0; e < 8; ++e) { const float kf = bf2f((bf16_t)kv[e]); dot += qk[c * 8 + e] * kf; ssq += kf * kf; } }
                v = dot * rsqrtf(ssq * (1.0f / 64.f) + EPS) + p.rel_bias[h * 32 + t5_bucket_dev(jj * r)];
            }
            sc[i] = v; mx = fmaxf(mx, v);
        }
        mx = wave_max(mx);
        float sum = 0.f;
#pragma unroll
        for (int i = 0; i < 7; ++i) { sc[i] = (sc[i] == -INFINITY) ? 0.f : __expf(sc[i] - mx); sum += sc[i]; }
        sum = wave_sum(sum);
        float o = 0.f;
#pragma unroll
        for (int i = 0; i < 7; ++i) {
            for (int l = 0; l < 64; ++l) {
                const int s = l + 64 * i; if (s >= 387) break;
                const int pt = s / 129, jj = s - pt * 129; const int r = pt == 0 ? 1 : (pt == 1 ? 4 : 16);
                const int kt = t - jj * r;
                const float e = __shfl(sc[i], l);
                if (kt >= 0) o += e * bf2f(proj[((size_t)b * SEQ + kt) * NPK + PC_AV + h * 64 + lane]);
            }
        }
        o /= sum;
        const float gt = bf2f(proj[row * NPK + PC_GATE + h * 64 + lane]);
        mixed[row * DM + 512 + h * 64 + lane] = f2bf(o * silu_f(gt));
    }
}

constexpr int NTHREADS = 512;
constexpr size_t DYN_LDS = 147456;
constexpr int SCAN_BLOCKS = 16;
__global__ void __launch_bounds__(NTHREADS, 2) fwd_mega(Params p) {
    cg::grid_group grid = cg::this_grid();
    extern __shared__ __attribute__((aligned(16))) unsigned char smem[];
    float* smf = (float*)smem;
    phase_weights(p);
    phase_norm(p, smf);
    grid.sync();
    { pg8::Gemm g{(const bf16_t*)(p.ws + OFF_XN), (const bf16_t*)(p.ws + OFF_WTIN), MROWS, NPK, DM}; pg8::StaticOrder S; S.init(MROWS, NPK, (int)gridDim.x, (int)blockIdx.x);
      EpiProjRaw E{(bf16_t*)(p.ws + OFF_PROJ)}; pg8::gemm_phase<EpiProjRaw, pg8::StaticOrder, true, true>((PG8_LAS unsigned char*)smem, g, S, E); }
    grid.sync();
    phase_dn_conv(p);
    grid.sync();
    if ((int)blockIdx.x < SCAN_BLOCKS) phase_dn_scan_simple(p, smf, blockIdx.x, SCAN_BLOCKS);
    else phase_attn_simple(p, smf, blockIdx.x - SCAN_BLOCKS, gridDim.x - SCAN_BLOCKS);
    grid.sync();
    phase_dn_out(p);
    grid.sync();
    { pg8::Gemm g{(const bf16_t*)(p.ws + OFF_MIXED), (const bf16_t*)(p.ws + OFF_WTOUT), MROWS, DM, DM}; pg8::StaticOrder S; S.init(MROWS, DM, (int)gridDim.x, (int)blockIdx.x);
      EpiOutRes E{p.x, p.out}; pg8::gemm_phase<EpiOutRes, pg8::StaticOrder, true, true>((PG8_LAS unsigned char*)smem, g, S, E); }
}

extern "C" void kernel_launch(void* const* d_in, const int* in_sizes, int n_in, void* d_out, int out_size, void* d_ws, size_t ws_size, hipStream_t stream) {
    (void)in_sizes; (void)n_in; (void)out_size;
    if (ws_size < WS_NEED) { fprintf(stderr, "workspace too small: %zu < %zu\n", ws_size, (size_t)WS_NEED); return; }
    static int grid_blocks = 0;
    if (!grid_blocks) {
        int dev = 0, cus = 0, per_cu = 0;
        (void)hipGetDevice(&dev);
        (void)hipDeviceGetAttribute(&cus, hipDeviceAttributeMultiprocessorCount, dev);
        (void)hipFuncSetAttribute((const void*)fwd_mega, hipFuncAttributeMaxDynamicSharedMemorySize, (int)DYN_LDS);
        (void)hipOccupancyMaxActiveBlocksPerMultiprocessor(&per_cu, fwd_mega, NTHREADS, DYN_LDS);
        if (per_cu > 1) per_cu = 1;
        grid_blocks = cus * per_cu;
        if (grid_blocks <= SCAN_BLOCKS) fprintf(stderr, "grid too small: %d\n", grid_blocks);
    }
    Params p{};
    p.x = (const float*)d_in[0]; p.norm_w = (const float*)d_in[1]; p.w_in = (const float*)d_in[2]; p.conv_w = (const float*)d_in[3]; p.a_log = (const float*)d_in[4];
    p.dt_bias = (const float*)d_in[5]; p.dn_norm_w = (const float*)d_in[6]; p.q_norm_w = (const float*)d_in[7]; p.k_norm_w = (const float*)d_in[8]; p.rel_bias = (const float*)d_in[9];
    p.w_out = (const float*)d_in[10]; p.out = (float*)d_out; p.ws = (unsigned char*)d_ws;
    void* args[] = {&p};
    hipError_t e = hipLaunchCooperativeKernel((const void*)fwd_mega, dim3(grid_blocks), dim3(NTHREADS), args, DYN_LDS, stream);
    if (e != hipSuccess) fprintf(stderr, "cooperative launch failed: %s (grid %d)\n", hipGetErrorString(e), grid_blocks);
}
```

```cpp
#include <hip/hip_runtime.h>
#include <hip/hip_cooperative_groups.h>
#include <cstdint>
#include <cstdio>
namespace cg = cooperative_groups;

typedef unsigned short bf16_t;
typedef short bf16x8 __attribute__((ext_vector_type(8)));
typedef float f32x4 __attribute__((ext_vector_type(4)));
typedef float f32x16 __attribute__((ext_vector_type(16)));
typedef unsigned u32x4_t __attribute__((ext_vector_type(4)));
typedef unsigned u32x2_t __attribute__((ext_vector_type(2)));
typedef __bf16 bf16x2_t __attribute__((ext_vector_type(2)));
typedef float f32x2_t __attribute__((ext_vector_type(2)));
#define LDSP __attribute__((address_space(3)))

constexpr int NB = 8, SEQ = 4096, DM = 1024, MROWS = NB * SEQ;
constexpr int DIN = 4104, NPK = 4096;
constexpr int ATH = 8;
constexpr float EPS = 1e-6f;
constexpr size_t MiB = (size_t)1 << 20;

constexpr size_t OFF_R0 = 0;
constexpr size_t OFF_XN = OFF_R0, OFF_DNQ = OFF_R0, OFF_DNK = OFF_R0 + 32 * MiB, OFF_MIXED = OFF_R0;
constexpr size_t OFF_WTIN = 64 * MiB;
constexpr size_t OFF_WTOUT = 72 * MiB;
constexpr size_t OFF_BETA = 74 * MiB;
constexpr size_t OFF_G = OFF_BETA + MiB / 2;
constexpr size_t OFF_GCUM = 75 * MiB;
constexpr size_t OFF_R3 = 76 * MiB;
constexpr size_t OFF_PROJDN = OFF_R3, OFF_ATTY = OFF_R3;
constexpr size_t OFF_Z = 176 * MiB;
constexpr size_t OFF_AQ = 208 * MiB;
constexpr size_t OFF_AK = 240 * MiB;
constexpr size_t OFF_AV = 272 * MiB;
constexpr size_t OFF_GATE = 304 * MiB;
constexpr size_t OFF_KNT = 336 * MiB;
constexpr size_t OFF_VIMG = 368 * MiB;
constexpr size_t OFF_T = 400 * MiB;
constexpr size_t OFF_ATTN = 416 * MiB;
constexpr size_t OFF_ODN = 432 * MiB;
constexpr size_t WS_NEED = 464 * MiB;

__device__ __forceinline__ bf16_t f2bf(float f) { unsigned u = __float_as_uint(f); u += 0x7FFFu + ((u >> 16) & 1u); return (bf16_t)(u >> 16); }
__device__ __forceinline__ float bf2f(bf16_t b) { return __uint_as_float(((unsigned)b) << 16); }
__device__ __forceinline__ float wave_sum(float v) {
#pragma unroll
    for (int o = 32; o >= 1; o >>= 1) v += __shfl_xor(v, o);
    return v;
}
__device__ __forceinline__ float wave_max(float v) {
#pragma unroll
    for (int o = 32; o >= 1; o >>= 1) v = fmaxf(v, __shfl_xor(v, o));
    return v;
}
__device__ __forceinline__ float silu_f(float y) { return y / (1.0f + __expf(-y)); }
__device__ __forceinline__ unsigned pk_bf16(float lo, float hi) { f32x2_t v = {lo, hi}; return __builtin_bit_cast(unsigned, __builtin_convertvector(v, bf16x2_t)); }
__device__ __forceinline__ float bflo(unsigned u) { return __uint_as_float(u << 16); }
__device__ __forceinline__ float bfhi(unsigned u) { return __uint_as_float(u & 0xFFFF0000u); }
__host__ __device__ __forceinline__ int crow(int i, int hh) { return (i & 3) + 8 * (i >> 2) + 4 * hh; }
__host__ __device__ __forceinline__ int perm16(int x) { return (x & ~12) | ((x & 4) << 1) | ((x & 8) >> 1); }
#define MFMA32(a, b, c) __builtin_amdgcn_mfma_f32_32x32x16_bf16((a), (b), (c), 0, 0, 0)
__host__ __device__ __forceinline__ size_t vimg_index(int chunk, int pos, int dv) {
    const int wsl = dv >> 5, cl = dv & 31, pt = pos >> 5, pr = pos & 31, i = 4 * (pr >> 3) + (pr & 3), hs = (pr >> 2) & 1;
    return (((((size_t)chunk * 4 + wsl) * 2 + pt) * 2 + (i >> 3)) * 64 + cl + 32 * hs) * 8 + (i & 7);
}

struct Params {
    const float* x; const float* norm_w; const float* w_in; const float* conv_w; const float* a_log; const float* dt_bias;
    const float* dn_norm_w; const float* q_norm_w; const float* k_norm_w; const float* rel_bias; const float* w_out;
    float* out; unsigned char* ws;
};

namespace pg8 {
#define PG8_LAS __attribute__((address_space(3)))
typedef unsigned short bf16_t;
typedef short bf16x8 __attribute__((ext_vector_type(8)));
typedef float f32x4 __attribute__((ext_vector_type(4)));
typedef unsigned u32x4 __attribute__((ext_vector_type(4)));
constexpr int BM = 256, BK = 64, HALF = 128, HTB = HALF * BK * 2  , STAGE_BYTES = 8 * HTB, NXCD = 8, WGM = 8;

__host__ __device__ __forceinline__ int lds_byte(int r, int c) { const int st = (r >> 4) * 2 + (c >> 5), rr = r & 15, cc = c & 31, ob = rr * 64 + cc * 2; return st * 1024 + (ob ^ (((ob >> 9) & 1) << 5)); }
__host__ __device__ __forceinline__ void stage_rc(int b, int& R, int& C) { const int st = b / 1024, sb = b % 1024, swz = sb ^ (((sb >> 9) & 1) << 5); R = (st >> 1) * 16 + swz / 64; C = (st & 1) * 32 + (swz % 64) / 2; }
__host__ __device__ __forceinline__ int perm32(int rho) { const int n = rho >> 4, i = rho & 15; return 8 * (i >> 2) + 4 * n + (i & 3); }

struct Unit { int pm, pn; };
struct Gemm { const bf16_t* A; const bf16_t* Bt; int M, N, K; };

struct StaticOrder {
    int nM, nN, nwg, G, c;
    __host__ __device__ void init(int M, int N, int G_, int c_) { nM = M / BM; nN = N / BM; nwg = nM * nN; G = G_; c = c_; }
    __host__ __device__ bool next(int i, Unit& u) const {
        const long L = (long)i * G + c; if (L >= nwg) return false;
        int wgid = (int)L; { const int q = nwg / NXCD, r = nwg % NXCD, xcd = wgid % NXCD, off = wgid / NXCD; wgid = (xcd < r ? xcd * (q + 1) : r * (q + 1) + (xcd - r) * q) + off; }
        const int nig = WGM * nN, gid = wgid / nig, fm = gid * WGM, gsz = (nM - fm) < WGM ? (nM - fm) : WGM;
        u.pm = fm + ((wgid % nig) % gsz); u.pn = (wgid % nig) / gsz; return true;
    }
    __device__ __forceinline__ void a_ready(const Unit&) const {}
    __device__ __forceinline__ void done(const Unit&) const {}
};

__device__ __forceinline__ unsigned cvt_pk_bf16(float lo, float hi) { unsigned r; asm volatile("v_cvt_pk_bf16_f32 %0, %1, %2" : "=v"(r) : "v"(lo), "v"(hi)); return r; }
typedef float f32x2 __attribute__((ext_vector_type(2)));
template <class Epi, class Sched, bool ALIGN_EPI = false, bool SP2 = false>
__device__ __forceinline__ void gemm_phase(PG8_LAS unsigned char* lds, const Gemm g, const Sched& S, const Epi& E) {
    const int tid = threadIdx.x, wid = __builtin_amdgcn_readfirstlane(tid >> 6), lane = tid & 63, wr = wid >> 2, wc = wid & 3, fr = lane & 15, fq = lane >> 4;
    const int K = g.K, nt = K / BK;
    unsigned voffA[2], voffB[2];
#pragma unroll
    for (int i = 0; i < 2; ++i) { int R, C; stage_rc(tid * 16 + i * 8192, R, C); const int Rb = Epi::PERM ? ((R & ~31) + perm32(R & 31)) : R;
        voffA[i] = (unsigned)(R * K + C) * 2u; voffB[i] = (unsigned)(Rb * K + C) * 2u; }
    const size_t kstep = (size_t)(BK * 2);
    const size_t hstep = (size_t)HALF * K * 2;
    const size_t tstep = 2 * hstep;
    const unsigned ldsw = (unsigned)wid * 1024u;
    const int aoff = lds_byte(wr * 64 + fr, fq * 8), boff = lds_byte(wc * 32 + fr, fq * 8);
#define PG8_SA(b, h) (((b) * 2 + (h)) * HTB)
#define PG8_SB(b, h) ((4 + (b) * 2 + (h)) * HTB)
#define PG8_STAGE(bufoff, gbase, voff) do { _Pragma("unroll") for (int _i = 0; _i < 2; ++_i) \
        __builtin_amdgcn_global_load_lds((const unsigned*)((const char*)(gbase) + (voff)[_i]), (PG8_LAS unsigned*)(lds + (bufoff) + ldsw + _i * 8192), 16, 0, 0); } while (0)
#define PG8_LDA(dst, b, h) do { _Pragma("unroll") for (int m = 0; m < 4; ++m) _Pragma("unroll") for (int k = 0; k < 2; ++k) dst[m][k] = *(const PG8_LAS bf16x8*)(lds + PG8_SA(b, h) + aoff + m * 2048 + k * 1024); } while (0)
#define PG8_LDB(dst, b, h) do { _Pragma("unroll") for (int n = 0; n < 2; ++n) _Pragma("unroll") for (int k = 0; k < 2; ++k) dst[n][k] = *(const PG8_LAS bf16x8*)(lds + PG8_SB(b, h) + boff + n * 2048 + k * 1024); } while (0)
#define PG8_MMA(ai, bj, At, Bt) do { __builtin_amdgcn_s_setprio(1); _Pragma("unroll") for (int m = 0; m < 4; ++m) _Pragma("unroll") for (int n = 0; n < 2; ++n) _Pragma("unroll") for (int k = 0; k < 2; ++k) \
        acc[ai][bj][m][n] = __builtin_amdgcn_mfma_f32_16x16x32_bf16(Bt[n][k], At[m][k], acc[ai][bj][m][n], 0, 0, 0); __builtin_amdgcn_s_setprio(0); } while (0)
#define PG8_WAIT_V(n) asm volatile("s_waitcnt vmcnt(" #n ")" ::: "memory")
#define PG8_WAIT_L(n) asm volatile("s_waitcnt lgkmcnt(" #n ")" ::: "memory")
#define PG8_BAR __builtin_amdgcn_s_barrier()
#define PG8_SCHED __builtin_amdgcn_sched_barrier(0)
    Unit cur, nxt; int ui = 0;
    if (!S.next(0, cur)) return;
    f32x4 acc[2][2][4][2];
#pragma unroll
    for (int a = 0; a < 2; ++a)
#pragma unroll
        for (int b = 0; b < 2; ++b)
#pragma unroll
            for (int m = 0; m < 4; ++m)
#pragma unroll
                for (int n = 0; n < 2; ++n) acc[a][b][m][n] = (f32x4){0.f, 0.f, 0.f, 0.f};
    bf16x8 At[4][2], B0[2][2], B1[2][2];
    const char* cA = (const char*)g.A + (size_t)cur.pm * tstep; const char* cB = (const char*)g.Bt + (size_t)cur.pn * tstep;
    S.a_ready(cur);
    if constexpr (SP2) {
        PG8_STAGE(PG8_SB(0, 0), cB, voffB); PG8_STAGE(PG8_SB(0, 1), cB + hstep, voffB); PG8_STAGE(PG8_SA(0, 0), cA, voffA); PG8_STAGE(PG8_SA(0, 1), cA + hstep, voffA);
        if (wr == 1) PG8_BAR;
        PG8_WAIT_V(2); PG8_BAR;
        PG8_STAGE(PG8_SB(1, 0), cB + kstep, voffB); PG8_STAGE(PG8_SA(1, 0), cA + kstep, voffA); PG8_STAGE(PG8_SB(1, 1), cB + hstep + kstep, voffB);
        PG8_WAIT_V(6); PG8_BAR;
    } else {
        PG8_STAGE(PG8_SB(0, 0), cB, voffB); PG8_STAGE(PG8_SA(0, 0), cA, voffA); PG8_STAGE(PG8_SB(0, 1), cB + hstep, voffB); PG8_STAGE(PG8_SA(0, 1), cA + hstep, voffA);
        if (wr == 1) PG8_BAR;
        PG8_WAIT_V(4); PG8_BAR;
        PG8_STAGE(PG8_SB(1, 0), cB + kstep, voffB); PG8_STAGE(PG8_SA(1, 0), cA + kstep, voffA); PG8_STAGE(PG8_SB(1, 1), cB + hstep + kstep, voffB);
        PG8_WAIT_V(6); PG8_BAR;
    }
    for (;;) {
        const bool has_next = S.next(ui + 1, nxt);
        const char* nA = has_next ? (const char*)g.A + (size_t)nxt.pm * tstep : cA; const char* nB = has_next ? (const char*)g.Bt + (size_t)nxt.pn * tstep : cB;
        for (int t = 0; t < nt; t += 2) {
            const bool last = (t == nt - 2);
            const char* a1 = cA + (size_t)(t + 1) * kstep;
            const char* a2 = last ? nA : cA + (size_t)(t + 2) * kstep; const char* b2 = last ? nB : cB + (size_t)(t + 2) * kstep;
            const char* a3 = a2 + kstep; const char* b3 = b2 + kstep;
            if (last && has_next) S.a_ready(nxt);
            if constexpr (SP2) {
            PG8_LDB(B0, 0, 0); PG8_LDB(B1, 0, 1); PG8_SCHED; PG8_LDA(At, 0, 0); PG8_STAGE(PG8_SA(1, 1), a1 + hstep, voffA);
            PG8_WAIT_V(8); PG8_WAIT_L(0); PG8_BAR; PG8_MMA(0, 0, At, B0); PG8_MMA(0, 1, At, B1); PG8_BAR; PG8_SCHED;
            PG8_LDA(At, 0, 1); PG8_STAGE(PG8_SB(0, 0), b2, voffB); PG8_STAGE(PG8_SB(0, 1), b2 + hstep, voffB); PG8_STAGE(PG8_SA(0, 0), a2, voffA);
            PG8_WAIT_V(8); PG8_WAIT_L(0); PG8_BAR; PG8_MMA(1, 0, At, B0); PG8_MMA(1, 1, At, B1); PG8_BAR; PG8_SCHED;
            PG8_LDB(B0, 1, 0); PG8_LDB(B1, 1, 1); PG8_SCHED; PG8_LDA(At, 1, 0); PG8_STAGE(PG8_SA(0, 1), a2 + hstep, voffA);
            PG8_WAIT_V(8); PG8_WAIT_L(0); PG8_BAR; PG8_MMA(0, 0, At, B0); PG8_MMA(0, 1, At, B1); PG8_BAR; PG8_SCHED;
            PG8_LDA(At, 1, 1); PG8_STAGE(PG8_SB(1, 0), b3, voffB); PG8_STAGE(PG8_SB(1, 1), b3 + hstep, voffB); PG8_STAGE(PG8_SA(1, 0), a3, voffA);
            PG8_WAIT_V(8); PG8_WAIT_L(0); PG8_BAR; PG8_MMA(1, 0, At, B0); PG8_MMA(1, 1, At, B1); PG8_BAR; PG8_SCHED;
            } else {
            PG8_LDB(B0, 0, 0); PG8_SCHED; PG8_LDA(At, 0, 0); PG8_STAGE(PG8_SA(1, 1), a1 + hstep, voffA);
            PG8_WAIT_L(8); PG8_BAR; PG8_WAIT_L(0); PG8_MMA(0, 0, At, B0); PG8_BAR; PG8_SCHED;
            PG8_LDB(B1, 0, 1); PG8_STAGE(PG8_SB(0, 0), b2, voffB);
            PG8_BAR; PG8_WAIT_L(0); PG8_MMA(0, 1, At, B1); PG8_BAR;
            PG8_LDA(At, 0, 1); PG8_STAGE(PG8_SA(0, 0), a2, voffA);
            PG8_BAR; PG8_WAIT_L(0); PG8_MMA(1, 0, At, B0); PG8_BAR; PG8_SCHED;
            PG8_STAGE(PG8_SB(0, 1), b2 + hstep, voffB);
            PG8_WAIT_V(6); PG8_BAR; PG8_MMA(1, 1, At, B1); PG8_BAR;
            PG8_LDB(B0, 1, 0); PG8_SCHED; PG8_LDA(At, 1, 0); PG8_STAGE(PG8_SA(0, 1), a2 + hstep, voffA);
            PG8_WAIT_L(8); PG8_BAR; PG8_WAIT_L(0); PG8_MMA(0, 0, At, B0); PG8_BAR; PG8_SCHED;
            PG8_LDB(B1, 1, 1); PG8_STAGE(PG8_SB(1, 0), b3, voffB);
            PG8_BAR; PG8_WAIT_L(0); PG8_MMA(0, 1, At, B1); PG8_BAR;
            PG8_LDA(At, 1, 1); PG8_STAGE(PG8_SA(1, 0), a3, voffA);
            PG8_BAR; PG8_WAIT_L(0); PG8_MMA(1, 0, At, B0); PG8_BAR; PG8_SCHED;
            PG8_STAGE(PG8_SB(1, 1), b3 + hstep, voffB);
            PG8_WAIT_V(6); PG8_BAR; PG8_MMA(1, 1, At, B1); PG8_BAR;
            }
        }
        if constexpr (ALIGN_EPI) { if (wr == 0) PG8_BAR; }
        if constexpr (!Epi::AFTER_DRAIN) { E(acc, cur, wr, wc, fr, fq); S.done(cur); }
        if (!has_next) break;
#pragma unroll
        for (int a = 0; a < 2; ++a)
#pragma unroll
            for (int b = 0; b < 2; ++b)
#pragma unroll
                for (int m = 0; m < 4; ++m)
#pragma unroll
                    for (int n = 0; n < 2; ++n) acc[a][b][m][n] = (f32x4){0.f, 0.f, 0.f, 0.f};
        cur = nxt; cA = nA; cB = nB; ++ui;
        if constexpr (ALIGN_EPI) { if (wr == 1) PG8_BAR; }
    }
    PG8_WAIT_V(0);
    if constexpr (!ALIGN_EPI) { if (wr == 0) PG8_BAR; }
    PG8_BAR;
    if constexpr (Epi::AFTER_DRAIN) { E.fused(acc, cur, wr, wc, fr, fq, lds, wid, lane); S.done(cur); }
#undef PG8_SA
#undef PG8_SB
#undef PG8_STAGE
#undef PG8_LDA
#undef PG8_LDB
#undef PG8_MMA
#undef PG8_WAIT_V
#undef PG8_WAIT_L
#undef PG8_BAR
#undef PG8_SCHED
}
}

__host__ __device__ __forceinline__ int wt_src_col(int n) {
    if (n < 2048) return n;
    if (n >= 3584) return n + 8;
    const int pn = n >> 8, vc = n & 255, bj = vc >> 7, wc = (vc >> 5) & 3, i = vc & 31;
    return 2056 + ((pn - 8) >> 1) * 512 + (4 * (pn & 1) + wc) * 64 + 32 * bj + i;
}
struct EpiProjSplit {
    static constexpr bool PERM = true, AFTER_DRAIN = false;
    unsigned char* ws; const float *qw, *kw;
    __device__ __forceinline__ static pg8::u32x4 pack8(const f32x4 v0, const f32x4 v1) { pg8::u32x4 w;
        w.x = pg8::cvt_pk_bf16(v0[0], v0[1]); w.y = pg8::cvt_pk_bf16(v0[2], v0[3]); w.z = pg8::cvt_pk_bf16(v1[0], v1[1]); w.w = pg8::cvt_pk_bf16(v1[2], v1[3]); return w; }
    __device__ __forceinline__ void operator()(const f32x4 (&acc)[2][2][4][2], const pg8::Unit& u, int wr, int wc, int fr, int fq) const {
        const int pn = u.pn, row0 = u.pm * 256 + wr * 64 + fr;
        if (pn < 8 || pn >= 14) {
            const size_t boff = pn < 6 ? OFF_PROJDN : (pn < 8 ? OFF_Z : OFF_GATE);
            const int ld = pn < 6 ? 1536 : 512, colt = pn < 6 ? pn * 256 : (pn & 1) * 256; const bool act = pn >= 6;
            bf16_t* base = (bf16_t*)(ws + boff);
            const int col0 = colt + wc * 32 + 8 * fq;
#pragma unroll
            for (int ai = 0; ai < 2; ++ai)
#pragma unroll
                for (int m = 0; m < 4; ++m) { bf16_t* rowp = base + (size_t)(row0 + ai * 128 + m * 16) * ld + col0;
#pragma unroll
                    for (int bj = 0; bj < 2; ++bj) { f32x4 v0 = acc[ai][bj][m][0], v1 = acc[ai][bj][m][1];
                        if (act) {
#pragma unroll
                            for (int e = 0; e < 4; ++e) { v0[e] = silu_f(v0[e]); v1[e] = silu_f(v1[e]); } }
                        *(pg8::u32x4*)(rowp + bj * 128) = pack8(v0, v1); } }
        } else {
            const int grp = (pn - 8) >> 1, head = 4 * (pn & 1) + wc;
            bf16_t* base = (bf16_t*)(ws + OFF_AQ + (size_t)grp * (32 * MiB));
            f32x4 wv[2][2];
            if (grp < 2) { const float* w = grp == 0 ? qw : kw; const float sc = grp == 0 ? 0.125f : 1.0f;
#pragma unroll
                for (int bj = 0; bj < 2; ++bj)
#pragma unroll
                    for (int n = 0; n < 2; ++n) wv[bj][n] = *(const f32x4*)(w + 32 * bj + 8 * fq + 4 * n) * sc; }
#pragma unroll
            for (int ai = 0; ai < 2; ++ai)
#pragma unroll
                for (int m = 0; m < 4; ++m) {
                    const int r = row0 + ai * 128 + m * 16, b = r >> 12, t = r & 4095;
                    f32x4 v[2][2];
#pragma unroll
                    for (int bj = 0; bj < 2; ++bj)
#pragma unroll
                        for (int n = 0; n < 2; ++n) v[bj][n] = acc[ai][bj][m][n];
                    if (grp < 2) {
                        float ss = 0.f;
#pragma unroll
                        for (int bj = 0; bj < 2; ++bj)
#pragma unroll
                            for (int n = 0; n < 2; ++n) ss += v[bj][n][0] * v[bj][n][0] + v[bj][n][1] * v[bj][n][1] + v[bj][n][2] * v[bj][n][2] + v[bj][n][3] * v[bj][n][3];
                        ss += __shfl_xor(ss, 16); ss += __shfl_xor(ss, 32);
                        const float rstd = rsqrtf(ss * (1.0f / 64.f) + EPS);
#pragma unroll
                        for (int bj = 0; bj < 2; ++bj)
#pragma unroll
                            for (int n = 0; n < 2; ++n) v[bj][n] = v[bj][n] * rstd * wv[bj][n];
                    }
                    bf16_t* dst = base + ((size_t)(b * 8 + head) * SEQ + t) * 64 + 8 * fq;
                    *(pg8::u32x4*)(dst) = pack8(v[0][0], v[0][1]);
                    *(pg8::u32x4*)(dst + 32) = pack8(v[1][0], v[1][1]);
                }
        }
    }
};
struct EpiOutRes {
    static constexpr bool PERM = false, AFTER_DRAIN = false;
    const float* X; float* C;
    __device__ __forceinline__ void operator()(const f32x4 (&acc)[2][2][4][2], const pg8::Unit& u, int wr, int wc, int fr, int fq) const {
        const int row0 = u.pm * 256 + wr * 64 + fr, col0 = u.pn * 256 + wc * 32 + 4 * fq;
#pragma unroll
        for (int ai = 0; ai < 2; ++ai)
#pragma unroll
            for (int m = 0; m < 4; ++m) { const size_t off = (size_t)(row0 + ai * 128 + m * 16) * DM + col0;
#pragma unroll
                for (int bj = 0; bj < 2; ++bj)
#pragma unroll
                    for (int n = 0; n < 2; ++n) { const size_t o = off + bj * 128 + n * 16; *(f32x4*)(C + o) = *(const f32x4*)(X + o) + acc[ai][bj][m][n]; } }
    }
};

__device__ void phase_weights(const Params& p) {
    bf16_t* wt_in = (bf16_t*)(p.ws + OFF_WTIN); bf16_t* wt_out = (bf16_t*)(p.ws + OFF_WTOUT);
    const size_t gt = (size_t)blockIdx.x * blockDim.x + threadIdx.x, gn = (size_t)gridDim.x * blockDim.x;
    for (size_t i = gt; i < (size_t)DM * NPK; i += gn) { const int k = (int)(i / NPK), n = (int)(i % NPK);
        wt_in[(size_t)n * DM + k] = f2bf(p.w_in[(size_t)k * DIN + wt_src_col(n)]); }
    for (size_t i = gt; i < (size_t)DM * DM; i += gn) { const int k = (int)(i / DM), n = (int)(i % DM);
        wt_out[(size_t)n * DM + k] = f2bf(p.w_out[(size_t)k * DM + n]); }
}

__device__ void phase_norm(const Params& p, float* lds_w8  ) {
    bf16_t* xn = (bf16_t*)(p.ws + OFF_XN); float* beta = (float*)(p.ws + OFF_BETA); float* gdec = (float*)(p.ws + OFF_G);
    for (int i = threadIdx.x; i < 1024 * 8; i += blockDim.x) { const int k = i >> 3, j = i & 7; lds_w8[i] = p.w_in[(size_t)k * DIN + 2048 + j]; }
    __syncthreads();
    const int lane = threadIdx.x & 63, wpb = blockDim.x >> 6, gw = blockIdx.x * wpb + (threadIdx.x >> 6), nw = gridDim.x * wpb;
    f32x4 nw4[4];
#pragma unroll
    for (int i = 0; i < 4; ++i) nw4[i] = *(const f32x4*)(p.norm_w + i * 256 + lane * 4);
    for (int row = gw; row < MROWS; row += nw) {
        f32x4 xv[4]; float ss = 0.f;
#pragma unroll
        for (int i = 0; i < 4; ++i) { xv[i] = *(const f32x4*)(p.x + (size_t)row * DM + i * 256 + lane * 4); ss += xv[i][0] * xv[i][0] + xv[i][1] * xv[i][1] + xv[i][2] * xv[i][2] + xv[i][3] * xv[i][3]; }
        ss = wave_sum(ss);
        const float rstd = rsqrtf(ss * (1.0f / DM) + EPS);
        float acc[8];
#pragma unroll
        for (int j = 0; j < 8; ++j) acc[j] = 0.f;
#pragma unroll
        for (int i = 0; i < 4; ++i) {
            f32x4 h = xv[i] * rstd * nw4[i];
            uint2 pk; pk.x = (unsigned)f2bf(h[0]) | ((unsigned)f2bf(h[1]) << 16); pk.y = (unsigned)f2bf(h[2]) | ((unsigned)f2bf(h[3]) << 16);
            *(uint2*)(xn + (size_t)row * DM + i * 256 + lane * 4) = pk;
#pragma unroll
            for (int e = 0; e < 4; ++e) { const float* w8 = lds_w8 + (i * 256 + lane * 4 + e) * 8;
#pragma unroll
                for (int j = 0; j < 8; ++j) acc[j] += h[e] * w8[j]; }
        }
#pragma unroll
        for (int j = 0; j < 8; ++j) acc[j] = wave_sum(acc[j]);
        const int b = row / SEQ, s = row % SEQ;
        if (lane == 0) {
#pragma unroll
            for (int j = 0; j < 4; ++j) {
                beta[((size_t)b * 4 + j) * SEQ + s] = 1.0f / (1.0f + expf(-acc[j]));
                const float xx = acc[4 + j] + p.dt_bias[j]; const float sp = xx > 20.f ? xx : log1pf(expf(xx));
                gdec[((size_t)b * 4 + j) * SEQ + s] = -expf(p.a_log[j]) * sp;
            }
        }
    }
}

__device__ void phase_dn_prep(const Params& p) {
    const bf16_t* proj = (const bf16_t*)(p.ws + OFF_PROJDN);
    bf16_t* qn = (bf16_t*)(p.ws + OFF_DNQ); bf16_t* kn = (bf16_t*)(p.ws + OFF_DNK); bf16_t* knT = (bf16_t*)(p.ws + OFF_KNT); bf16_t* vimg = (bf16_t*)(p.ws + OFF_VIMG);
    const float* gdec = (const float*)(p.ws + OFF_G); float* gcum = (float*)(p.ws + OFF_GCUM);
    const int lane = threadIdx.x & 63, w = threadIdx.x >> 6;
    for (int unit = blockIdx.x; unit < NB * 4 * 64; unit += gridDim.x) {
        const int n = unit & 63, bh = unit >> 6, h = bh & 3, b = bh >> 2, t0 = n * 64;
        float y[3][8][2];
#pragma unroll
        for (int g = 0; g < 3; ++g) {
            const int ch = g * 512 + h * 128 + 2 * lane;
            float cw[4][2];
#pragma unroll
            for (int i = 0; i < 4; ++i) { cw[i][0] = p.conv_w[i * 1536 + ch]; cw[i][1] = p.conv_w[i * 1536 + ch + 1]; }
            unsigned raw[11];
#pragma unroll
            for (int rr = 0; rr < 11; ++rr) { const int tt = t0 + 8 * w - 3 + rr; raw[rr] = tt >= 0 ? *(const unsigned*)(proj + (size_t)(b * SEQ + tt) * 1536 + ch) : 0u; }
#pragma unroll
            for (int pp = 0; pp < 8; ++pp) { float a0 = 0.f, a1 = 0.f;
#pragma unroll
                for (int i = 0; i < 4; ++i) { a0 += cw[i][0] * bflo(raw[pp + i]); a1 += cw[i][1] * bfhi(raw[pp + i]); }
                y[g][pp][0] = silu_f(a0); y[g][pp][1] = silu_f(a1); }
        }
        const int d = 2 * lane, dcol = (d & ~15) + perm16(d & 15);
        unsigned kpk[8][1]; bf16_t kb[8][2];
#pragma unroll
        for (int pp = 0; pp < 8; ++pp) {
            const float sq = wave_sum(y[0][pp][0] * y[0][pp][0] + y[0][pp][1] * y[0][pp][1]), sk = wave_sum(y[1][pp][0] * y[1][pp][0] + y[1][pp][1] * y[1][pp][1]);
            const float rq = rsqrtf(sq + EPS) * 0.08838834764831845f, rk = rsqrtf(sk + EPS);
            const size_t ro = ((size_t)unit * 64 + 8 * w + pp) * 128 + dcol;
            *(unsigned*)(qn + ro) = pk_bf16(y[0][pp][0] * rq, y[0][pp][1] * rq);
            const unsigned kk = pk_bf16(y[1][pp][0] * rk, y[1][pp][1] * rk);
            *(unsigned*)(kn + ro) = kk; kpk[pp][0] = kk; kb[pp][0] = (bf16_t)(kk & 0xFFFFu); kb[pp][1] = (bf16_t)(kk >> 16);
        }
#pragma unroll
        for (int e = 0; e < 2; ++e)
#pragma unroll
            for (int hs = 0; hs < 2; ++hs) {
                u32x2_t v; v.x = (unsigned)kb[4 * hs][e] | ((unsigned)kb[4 * hs + 1][e] << 16); v.y = (unsigned)kb[4 * hs + 2][e] | ((unsigned)kb[4 * hs + 3][e] << 16);
                *(u32x2_t*)(knT + ((size_t)unit * 128 + d + e) * 64 + 16 * (w >> 1) + 8 * hs + 4 * (w & 1)) = v;
            }
#pragma unroll
        for (int e = 0; e < 2; ++e)
#pragma unroll
            for (int hs = 0; hs < 2; ++hs) {
                u32x2_t v; v.x = pk_bf16(y[2][4 * hs][e], y[2][4 * hs + 1][e]); v.y = pk_bf16(y[2][4 * hs + 2][e], y[2][4 * hs + 3][e]);
                *(u32x2_t*)(vimg + vimg_index(unit, 8 * w + 4 * hs, d + e)) = v;
            }
        if (w == 0) {
            float v = gdec[(size_t)bh * SEQ + t0 + lane];
#pragma unroll
            for (int o = 1; o < 64; o <<= 1) { const float t = __shfl_up(v, o); if (lane >= o) v += t; }
            gcum[(size_t)unit * 64 + lane] = v;
        }
    }
}

constexpr int D1B_LDS_PER_WAVE = 64 * 68 * 4 + 512;
__device__ void phase_dn_chunk(const Params& p, unsigned char* smem) {
    const bf16_t* qn = (const bf16_t*)(p.ws + OFF_DNQ); const bf16_t* kn = (const bf16_t*)(p.ws + OFF_DNK);
    const float* beta = (const float*)(p.ws + OFF_BETA); const float* gcum = (const float*)(p.ws + OFF_GCUM);
    bf16_t* Tm = (bf16_t*)(p.ws + OFF_T); bf16_t* attn = (bf16_t*)(p.ws + OFF_ATTN);
    const int lane = threadIdx.x & 63, w = threadIdx.x >> 6, r = lane & 31, hh = lane >> 5;
    LDSP float* At = (LDSP float*)((LDSP unsigned char*)smem + w * D1B_LDS_PER_WAVE); LDSP float* tg = At + 64 * 68; LDSP float* tb = tg + 64;
    for (int c = blockIdx.x * 8 + w; c < NB * 4 * 64; c += gridDim.x * 8) {
        const int bh = c >> 6, n = c & 63;
        tg[lane] = gcum[(size_t)c * 64 + lane]; tb[lane] = beta[(size_t)bh * SEQ + n * 64 + lane];
        const bf16_t* kp = kn + ((size_t)c * 64 + r) * 128 + 8 * hh; const bf16_t* qp = qn + ((size_t)c * 64 + r) * 128 + 8 * hh;
        f32x16 kk00, kk10, kk11;
#pragma unroll
        for (int i = 0; i < 16; ++i) { kk00[i] = 0.f; kk10[i] = 0.f; kk11[i] = 0.f; }
#pragma unroll 2
        for (int s = 0; s < 8; ++s) {
            const bf16x8 k0 = *(const bf16x8*)(kp + 16 * s), k1 = *(const bf16x8*)(kp + 32 * 128 + 16 * s);
            kk00 = MFMA32(k0, k0, kk00); kk10 = MFMA32(k1, k0, kk10); kk11 = MFMA32(k1, k1, kk11);
        }
#define D1B_PUT_A(tile, rt, ct) do { const int cc = 32 * (ct) + r; const float gcc = tg[cc]; \
        _Pragma("unroll") for (int g4 = 0; g4 < 4; ++g4) { const int j0 = 32 * (rt) + 8 * g4 + 4 * hh; const f32x4 gj = *(const LDSP f32x4*)(tg + j0), bj = *(const LDSP f32x4*)(tb + j0); f32x4 o; \
            _Pragma("unroll") for (int e = 0; e < 4; ++e) o[e] = bj[e] * __expf(fminf(gj[e] - gcc, 0.f)) * tile[4 * g4 + e]; \
            *(LDSP f32x4*)(At + cc * 68 + j0) = o; } } while (0)
        D1B_PUT_A(kk00, 0, 0); D1B_PUT_A(kk10, 1, 0); D1B_PUT_A(kk11, 1, 1);
#undef D1B_PUT_A
        float Tr[64];
        int lane_o = lane; asm volatile("" : "+v"(lane_o));
#pragma unroll
        for (int cc = 63; cc >= 0; --cc) {
            float a0 = (lane_o == cc) ? 1.f : 0.f, a1 = 0.f;
#pragma unroll
            for (int j4 = ((cc + 1) & ~3); j4 < 64; j4 += 4) { const f32x4 av = *(const LDSP f32x4*)(At + cc * 68 + j4);
                if (j4 + 0 > cc) a0 -= Tr[j4 + 0] * av[0];
                if (j4 + 1 > cc) a1 -= Tr[j4 + 1] * av[1];
                if (j4 + 2 > cc) a0 -= Tr[j4 + 2] * av[2];
                if (j4 + 3 > cc) a1 -= Tr[j4 + 3] * av[3]; }
            Tr[cc] = a0 + a1;
        }
#pragma unroll
        for (int q = 0; q < 4; ++q)
#pragma unroll
            for (int half = 0; half < 2; ++half) { u32x4_t o;
                const int s0 = 8 * half;
                o.x = pk_bf16(Tr[16 * q + perm16(s0 + 0)], Tr[16 * q + perm16(s0 + 0) + 1]); o.y = pk_bf16(Tr[16 * q + perm16(s0 + 2)], Tr[16 * q + perm16(s0 + 2) + 1]);
                o.z = pk_bf16(Tr[16 * q + perm16(s0 + 4)], Tr[16 * q + perm16(s0 + 4) + 1]); o.w = pk_bf16(Tr[16 * q + perm16(s0 + 6)], Tr[16 * q + perm16(s0 + 6) + 1]);
                *(u32x4_t*)(Tm + ((size_t)c * 64 + lane) * 64 + 16 * q + s0) = o; }
        f32x16 qk00, qk01, qk11;
#pragma unroll
        for (int i = 0; i < 16; ++i) { qk00[i] = 0.f; qk01[i] = 0.f; qk11[i] = 0.f; }
#pragma unroll 2
        for (int s = 0; s < 8; ++s) {
            const bf16x8 k0 = *(const bf16x8*)(kp + 16 * s), k1 = *(const bf16x8*)(kp + 32 * 128 + 16 * s);
            const bf16x8 q0 = *(const bf16x8*)(qp + 16 * s), q1 = *(const bf16x8*)(qp + 32 * 128 + 16 * s);
            qk00 = MFMA32(k0, q0, qk00); qk01 = MFMA32(k0, q1, qk01); qk11 = MFMA32(k1, q1, qk11);
        }
#define D1B_PUT_ATT(tile, jt, it) do { const int qi = 32 * (it) + r; const float gi = tg[qi]; \
        _Pragma("unroll") for (int s2 = 0; s2 < 2; ++s2) { float v[8]; \
            _Pragma("unroll") for (int a = 0; a < 2; ++a) { const int j0 = 32 * (jt) + 16 * s2 + 8 * a + 4 * hh; const f32x4 gj = *(const LDSP f32x4*)(tg + j0); \
                _Pragma("unroll") for (int e = 0; e < 4; ++e) v[4 * a + e] = (qi >= j0 + e) ? __expf(fminf(gi - gj[e], 0.f)) * tile[8 * s2 + 4 * a + e] : 0.f; } \
            u32x4_t o; o.x = pk_bf16(v[0], v[1]); o.y = pk_bf16(v[2], v[3]); o.z = pk_bf16(v[4], v[5]); o.w = pk_bf16(v[6], v[7]); \
            *(u32x4_t*)(attn + ((size_t)c * 64 + qi) * 64 + 32 * (jt) + 16 * s2 + 8 * hh) = o; } } while (0)
        D1B_PUT_ATT(qk00, 0, 0); D1B_PUT_ATT(qk01, 0, 1); D1B_PUT_ATT(qk11, 1, 1);
#undef D1B_PUT_ATT
    }
}

constexpr int SCAN_BUF = 65536, SCAN_TBL = 2 * SCAN_BUF;
__device__ __forceinline__ int swz256(int row, int ch) { return (row * 16 + (ch ^ (row & 15))) * 16; }
__device__ __forceinline__ int swz128(int row, int ch) { const int sr = row >> 1; return (sr * 16 + ((((row & 1) << 3) | ch) ^ (sr & 7))) * 16; }
__device__ void phase_dn_scan(const Params& p, unsigned char* smem, int bh) {
    const unsigned char* qnb = p.ws + OFF_DNQ; const unsigned char* knb = p.ws + OFF_DNK; const unsigned char* kntb = p.ws + OFF_KNT;
    const unsigned char* tb_ = p.ws + OFF_T; const unsigned char* atb = p.ws + OFF_ATTN;
    const bf16_t* vimg = (const bf16_t*)(p.ws + OFF_VIMG); bf16_t* oimg = (bf16_t*)(p.ws + OFF_ODN);
    const float* beta = (const float*)(p.ws + OFF_BETA); const float* gcum = (const float*)(p.ws + OFF_GCUM);
    const int lane = threadIdx.x & 63, w = __builtin_amdgcn_readfirstlane(threadIdx.x >> 6), r = lane & 31, hh = lane >> 5;
    LDSP unsigned char* lds = (LDSP unsigned char*)smem;
    auto stage = [&](int n, int bsel) {
        const size_t chunk = (size_t)bh * 64 + n;
#pragma unroll
        for (int i = 0; i < 8; ++i) {
            const int k = w * 8 + i; const unsigned char* src;
            if (k < 32) { const int sl = (k & 15) * 64 + lane, row = sl >> 4, ch = (sl & 15) ^ (row & 15); src = (k < 16 ? knb : qnb) + chunk * 16384 + row * 256 + ch * 16; }
            else { const int sl = (k < 48 ? (k - 32) : (k < 56 ? (k - 48) : (k - 56))) * 64 + lane, sr = sl >> 4, lp = (sl & 15) ^ (sr & 7), row = sr * 2 + (lp >> 3), ch = lp & 7;
                   src = (k < 48 ? kntb + chunk * 16384 : (k < 56 ? tb_ + chunk * 8192 : atb + chunk * 8192)) + row * 128 + ch * 16; }
            __builtin_amdgcn_global_load_lds((const unsigned*)src, (LDSP unsigned*)(lds + bsel * SCAN_BUF + k * 1024), 16, 0, 0);
        }
        if (w == 7) { LDSP float* tbl = (LDSP float*)(lds + SCAN_TBL + bsel * 512); tbl[lane] = gcum[chunk * 64 + lane]; tbl[64 + lane] = beta[(size_t)bh * SEQ + n * 64 + lane]; }
    };
    f32x16 S[4]; bf16x8 Sb[4][2];
#pragma unroll
    for (int dt = 0; dt < 4; ++dt) {
#pragma unroll
        for (int i = 0; i < 16; ++i) S[dt][i] = 0.f;
#pragma unroll
        for (int s = 0; s < 2; ++s)
#pragma unroll
            for (int j = 0; j < 8; ++j) Sb[dt][s][j] = 0;
    }
    stage(0, 0);
    asm volatile("s_waitcnt vmcnt(0)" ::: "memory");
    __syncthreads();
    for (int n = 0; n < 64; ++n) {
        const int bsel = n & 1;
        if (n + 1 < 64) stage(n + 1, bsel ^ 1);
        if (w < 4) {
            const size_t chunk = (size_t)bh * 64 + n;
            LDSP unsigned char* B = lds + bsel * SCAN_BUF; LDSP float* tg = (LDSP float*)(lds + SCAN_TBL + bsel * 512); LDSP float* tbt = tg + 64;
            LDSP unsigned char* Bkn = B, *Bqn = B + 16384, *BknT = B + 32768, *BT = B + 49152, *Bat = B + 57344;
            u32x4_t vr[2][2];
#pragma unroll
            for (int pt = 0; pt < 2; ++pt)
#pragma unroll
                for (int g = 0; g < 2; ++g) vr[pt][g] = *(const u32x4_t*)(vimg + (((((size_t)chunk * 4 + w) * 2 + pt) * 2 + g) * 64 + lane) * 8);
            f32x16 X[2];
#pragma unroll
            for (int i = 0; i < 16; ++i) { X[0][i] = 0.f; X[1][i] = 0.f; }
#pragma unroll
            for (int kc = 0; kc < 8; ++kc) {
                const bf16x8 a0 = *(const LDSP bf16x8*)(Bkn + swz256(r, 2 * kc + hh)), a1 = *(const LDSP bf16x8*)(Bkn + swz256(32 + r, 2 * kc + hh));
                X[0] = MFMA32(a0, Sb[kc >> 1][kc & 1], X[0]); X[1] = MFMA32(a1, Sb[kc >> 1][kc & 1], X[1]);
            }
            asm volatile("" ::: "memory");
            const float gl_last = tg[63];
            bf16x8 Yb[2][2];
#pragma unroll
            for (int pt = 0; pt < 2; ++pt) {
                unsigned yp[8];
#pragma unroll
                for (int g4 = 0; g4 < 4; ++g4) { const int j0 = 32 * pt + 8 * g4 + 4 * hh; const f32x4 gj = *(const LDSP f32x4*)(tg + j0), bj = *(const LDSP f32x4*)(tbt + j0);
                    float yv[4];
#pragma unroll
                    for (int e = 0; e < 4; ++e) { const int i = 4 * g4 + e;
                        const unsigned vw = vr[pt][i >> 3][(i & 7) >> 1]; const float vv = (i & 1) ? bfhi(vw) : bflo(vw);
                        yv[e] = bj[e] * (vv - __expf(gj[e]) * X[pt][i]); }
                    yp[2 * g4] = pk_bf16(yv[0], yv[1]); yp[2 * g4 + 1] = pk_bf16(yv[2], yv[3]); }
#pragma unroll
                for (int s = 0; s < 2; ++s) { u32x4_t t4; t4.x = yp[4 * s]; t4.y = yp[4 * s + 1]; t4.z = yp[4 * s + 2]; t4.w = yp[4 * s + 3]; Yb[pt][s] = __builtin_bit_cast(bf16x8, t4); }
            }
            asm volatile("" ::: "memory");
            f32x16 Vn[2];
#pragma unroll
            for (int i = 0; i < 16; ++i) { Vn[0][i] = 0.f; Vn[1][i] = 0.f; }
#pragma unroll
            for (int kc = 0; kc < 4; ++kc) {
                if (kc < 2) { const bf16x8 a0 = *(const LDSP bf16x8*)(BT + swz128(r, 2 * kc + hh)); Vn[0] = MFMA32(a0, Yb[kc >> 1][kc & 1], Vn[0]); }
                const bf16x8 a1 = *(const LDSP bf16x8*)(BT + swz128(32 + r, 2 * kc + hh)); Vn[1] = MFMA32(a1, Yb[kc >> 1][kc & 1], Vn[1]);
            }
            asm volatile("" ::: "memory");
            bf16x8 Vnb[2][2], Vsb[2][2];
#pragma unroll
            for (int pt = 0; pt < 2; ++pt) {
                unsigned np[8], sp[8];
#pragma unroll
                for (int g4 = 0; g4 < 4; ++g4) { const int j0 = 32 * pt + 8 * g4 + 4 * hh; const f32x4 gj = *(const LDSP f32x4*)(tg + j0);
                    float et[4];
#pragma unroll
                    for (int e = 0; e < 4; ++e) et[e] = __expf(gl_last - gj[e]);
                    np[2 * g4] = pk_bf16(Vn[pt][4 * g4], Vn[pt][4 * g4 + 1]); np[2 * g4 + 1] = pk_bf16(Vn[pt][4 * g4 + 2], Vn[pt][4 * g4 + 3]);
                    sp[2 * g4] = pk_bf16(Vn[pt][4 * g4] * et[0], Vn[pt][4 * g4 + 1] * et[1]); sp[2 * g4 + 1] = pk_bf16(Vn[pt][4 * g4 + 2] * et[2], Vn[pt][4 * g4 + 3] * et[3]); }
#pragma unroll
                for (int s = 0; s < 2; ++s) { u32x4_t a4, b4; a4.x = np[4 * s]; a4.y = np[4 * s + 1]; a4.z = np[4 * s + 2]; a4.w = np[4 * s + 3]; b4.x = sp[4 * s]; b4.y = sp[4 * s + 1]; b4.z = sp[4 * s + 2]; b4.w = sp[4 * s + 3];
                    Vnb[pt][s] = __builtin_bit_cast(bf16x8, a4); Vsb[pt][s] = __builtin_bit_cast(bf16x8, b4); }
            }
            asm volatile("" ::: "memory");
            f32x16 O[2];
#pragma unroll
            for (int i = 0; i < 16; ++i) { O[0][i] = 0.f; O[1][i] = 0.f; }
#pragma unroll
            for (int kc = 0; kc < 8; ++kc) {
                const bf16x8 a0 = *(const LDSP bf16x8*)(Bqn + swz256(r, 2 * kc + hh)), a1 = *(const LDSP bf16x8*)(Bqn + swz256(32 + r, 2 * kc + hh));
                O[0] = MFMA32(a0, Sb[kc >> 1][kc & 1], O[0]); O[1] = MFMA32(a1, Sb[kc >> 1][kc & 1], O[1]);
            }
#pragma unroll
            for (int pt = 0; pt < 2; ++pt)
#pragma unroll
                for (int g4 = 0; g4 < 4; ++g4) { const int j0 = 32 * pt + 8 * g4 + 4 * hh; const f32x4 gj = *(const LDSP f32x4*)(tg + j0);
#pragma unroll
                    for (int e = 0; e < 4; ++e) O[pt][4 * g4 + e] *= __expf(gj[e]); }
#pragma unroll
            for (int kc = 0; kc < 4; ++kc) {
                if (kc < 2) { const bf16x8 a0 = *(const LDSP bf16x8*)(Bat + swz128(r, 2 * kc + hh)); O[0] = MFMA32(a0, Vnb[kc >> 1][kc & 1], O[0]); }
                const bf16x8 a1 = *(const LDSP bf16x8*)(Bat + swz128(32 + r, 2 * kc + hh)); O[1] = MFMA32(a1, Vnb[kc >> 1][kc & 1], O[1]);
            }
#pragma unroll
            for (int pt = 0; pt < 2; ++pt)
#pragma unroll
                for (int g = 0; g < 2; ++g) { u32x4_t o; o.x = pk_bf16(O[pt][8 * g], O[pt][8 * g + 1]); o.y = pk_bf16(O[pt][8 * g + 2], O[pt][8 * g + 3]); o.z = pk_bf16(O[pt][8 * g + 4], O[pt][8 * g + 5]); o.w = pk_bf16(O[pt][8 * g + 6], O[pt][8 * g + 7]);
                    *(u32x4_t*)(oimg + (((((size_t)chunk * 4 + w) * 2 + pt) * 2 + g) * 64 + lane) * 8) = o; }
            asm volatile("" ::: "memory");
            const float glf = __expf(gl_last);
#pragma unroll
            for (int dt = 0; dt < 4; ++dt) {
#pragma unroll
                for (int i = 0; i < 16; ++i) S[dt][i] *= glf;
#pragma unroll
                for (int kc = 0; kc < 4; ++kc) { const bf16x8 a = *(const LDSP bf16x8*)(BknT + swz128(32 * dt + r, 2 * kc + hh)); S[dt] = MFMA32(a, Vsb[kc >> 1][kc & 1], S[dt]); }
#pragma unroll
                for (int s = 0; s < 2; ++s) { u32x4_t t4; t4.x = pk_bf16(S[dt][8 * s], S[dt][8 * s + 1]); t4.y = pk_bf16(S[dt][8 * s + 2], S[dt][8 * s + 3]); t4.z = pk_bf16(S[dt][8 * s + 4], S[dt][8 * s + 5]); t4.w = pk_bf16(S[dt][8 * s + 6], S[dt][8 * s + 7]);
                    Sb[dt][s] = __builtin_bit_cast(bf16x8, t4); }
            }
        }
        asm volatile("s_waitcnt vmcnt(0)" ::: "memory");
        __syncthreads();
    }
}

__device__ void phase_mix(const Params& p) {
    const bf16_t* odn = (const bf16_t*)(p.ws + OFF_ODN); const bf16_t* zs = (const bf16_t*)(p.ws + OFF_Z); const bf16_t* atty = (const bf16_t*)(p.ws + OFF_ATTY);
    bf16_t* mixed = (bf16_t*)(p.ws + OFF_MIXED);
    const int lane = threadIdx.x & 63, wpb = blockDim.x >> 6, gw = blockIdx.x * wpb + (threadIdx.x >> 6), nw = gridDim.x * wpb;
    for (int item = gw; item < MROWS * 4; item += nw) {
        const int row = item >> 2, h = item & 3, b = row / SEQ, t = row % SEQ;
        const int chunk = (b * 4 + h) * 64 + (t >> 6);
        const float v0 = bf2f(odn[vimg_index(chunk, t & 63, lane)]), v1 = bf2f(odn[vimg_index(chunk, t & 63, 64 + lane)]);
        const float rstd = rsqrtf(wave_sum(v0 * v0 + v1 * v1) * (1.0f / 128.f) + EPS);
        const float z0 = bf2f(zs[(size_t)row * 512 + h * 128 + lane]), z1 = bf2f(zs[(size_t)row * 512 + h * 128 + 64 + lane]);
        mixed[(size_t)row * DM + h * 128 + lane] = f2bf(v0 * rstd * p.dn_norm_w[lane] * z0);
        mixed[(size_t)row * DM + h * 128 + 64 + lane] = f2bf(v1 * rstd * p.dn_norm_w[64 + lane] * z1);
        mixed[(size_t)row * DM + 512 + h * 128 + lane] = atty[(size_t)row * 512 + h * 128 + lane];
        mixed[(size_t)row * DM + 512 + h * 128 + 64 + lane] = atty[(size_t)row * 512 + h * 128 + 64 + lane];
    }
}

__device__ __forceinline__ int t5_bucket_dev(int d) {
    if (d < 16) return d;
    int bkt = 16;
    const int bnd[15] = {22, 30, 40, 54, 73, 99, 134, 182, 246, 332, 450, 609, 825, 1117, 1513};
#pragma unroll
    for (int i = 0; i < 15; ++i) bkt += (d >= bnd[i]) ? 1 : 0;
    return bkt;
}
__device__ void phase_attn_simple(const Params& p, float* lds  , int vb, int vg) {
    const bf16_t* aq = (const bf16_t*)(p.ws + OFF_AQ); const bf16_t* ak = (const bf16_t*)(p.ws + OFF_AK); const bf16_t* av = (const bf16_t*)(p.ws + OFF_AV);
    const bf16_t* gate = (const bf16_t*)(p.ws + OFF_GATE); bf16_t* atty = (bf16_t*)(p.ws + OFF_ATTY);
    const int lane = threadIdx.x & 63, wib = threadIdx.x >> 6, wpb = blockDim.x >> 6, gw = vb * wpb + wib, nw = vg * wpb;
    float* wq = lds + wib * 64;
    for (int item = gw; item < NB * ATH * SEQ; item += nw) {
        const int t = item % SEQ, h = (item / SEQ) % ATH, b = item / (SEQ * ATH);
        const size_t row = (size_t)b * SEQ + t, hb = (size_t)(b * 8 + h) * SEQ;
        wq[lane] = bf2f(aq[(hb + t) * 64 + lane]);
        float qk[64];
#pragma unroll
        for (int d = 0; d < 64; d += 4) { const f32x4 v = *(const f32x4*)(wq + d); qk[d] = v[0]; qk[d + 1] = v[1]; qk[d + 2] = v[2]; qk[d + 3] = v[3]; }
        float sc[7]; float mx = -INFINITY;
#pragma unroll
        for (int i = 0; i < 7; ++i) {
            const int s = lane + 64 * i; const int pt = s / 129, jj = s - pt * 129; const int r = pt == 0 ? 1 : (pt == 1 ? 4 : 16);
            const int kt = t - jj * r; const bool valid = (s < 387) && (kt >= 0);
            float v = -INFINITY;
            if (valid) {
                const bf16_t* kp = ak + (hb + kt) * 64;
                float dot = 0.f;
#pragma unroll
                for (int c = 0; c < 8; ++c) { const bf16x8 kv = *(const bf16x8*)(kp + c * 8);
#pragma unroll
                    for (int e = 0; e < 8; ++e) dot += qk[c * 8 + e] * bf2f((bf16_t)kv[e]); }
                v = dot + p.rel_bias[h * 32 + t5_bucket_dev(jj * r)];
            }
            sc[i] = v; mx = fmaxf(mx, v);
        }
        mx = wave_max(mx);
        float sum = 0.f;
#pragma unroll
        for (int i = 0; i < 7; ++i) { sc[i] = (sc[i] == -INFINITY) ? 0.f : __expf(sc[i] - mx); sum += sc[i]; }
        sum = wave_sum(sum);
        float o = 0.f;
#pragma unroll
        for (int i = 0; i < 7; ++i) {
            for (int l = 0; l < 64; ++l) {
                const int s = l + 64 * i; if (s >= 387) break;
                const int pt = s / 129, jj = s - pt * 129; const int r = pt == 0 ? 1 : (pt == 1 ? 4 : 16);
                const int kt = t - jj * r;
                const float e = __shfl(sc[i], l);
                if (kt >= 0) o += e * bf2f(av[(hb + kt) * 64 + lane]);
            }
        }
        o /= sum;
        atty[row * 512 + h * 64 + lane] = f2bf(o * bf2f(gate[row * 512 + h * 64 + lane]));
    }
}

constexpr int NTHREADS = 512;
constexpr size_t DYN_LDS = 147456;
constexpr int SCAN_BLOCKS = 32;
__global__ void __launch_bounds__(NTHREADS, 2) fwd_mega(Params p) {
    cg::grid_group grid = cg::this_grid();
    extern __shared__ __attribute__((aligned(16))) unsigned char smem[];
    float* smf = (float*)smem;
    phase_weights(p);
    phase_norm(p, smf);
    grid.sync();
    { pg8::Gemm g{(const bf16_t*)(p.ws + OFF_XN), (const bf16_t*)(p.ws + OFF_WTIN), MROWS, NPK, DM}; pg8::StaticOrder S; S.init(MROWS, NPK, (int)gridDim.x, (int)blockIdx.x);
      EpiProjSplit E{p.ws, p.q_norm_w, p.k_norm_w};
      pg8::gemm_phase<EpiProjSplit, pg8::StaticOrder, true, true>((PG8_LAS unsigned char*)smem, g, S, E); }
    grid.sync();
    phase_dn_prep(p);
    grid.sync();
    phase_dn_chunk(p, smem);
    grid.sync();
    if ((int)blockIdx.x < SCAN_BLOCKS) phase_dn_scan(p, smem, blockIdx.x);
    else phase_attn_simple(p, smf, blockIdx.x - SCAN_BLOCKS, gridDim.x - SCAN_BLOCKS);
    grid.sync();
    phase_mix(p);
    grid.sync();
    { pg8::Gemm g{(const bf16_t*)(p.ws + OFF_MIXED), (const bf16_t*)(p.ws + OFF_WTOUT), MROWS, DM, DM}; pg8::StaticOrder S; S.init(MROWS, DM, (int)gridDim.x, (int)blockIdx.x);
      EpiOutRes E{p.x, p.out}; pg8::gemm_phase<EpiOutRes, pg8::StaticOrder, true, true>((PG8_LAS unsigned char*)smem, g, S, E); }
}

extern "C" void kernel_launch(void* const* d_in, const int* in_sizes, int n_in, void* d_out, int out_size, void* d_ws, size_t ws_size, hipStream_t stream) {
    (void)in_sizes; (void)n_in; (void)out_size;
    if (ws_size < WS_NEED) { fprintf(stderr, "workspace too small: %zu < %zu\n", ws_size, (size_t)WS_NEED); return; }
    static int grid_blocks = 0;
    if (!grid_blocks) {
        int dev = 0, cus = 0, per_cu = 0;
        (void)hipGetDevice(&dev);
        (void)hipDeviceGetAttribute(&cus, hipDeviceAttributeMultiprocessorCount, dev);
        (void)hipFuncSetAttribute((const void*)fwd_mega, hipFuncAttributeMaxDynamicSharedMemorySize, (int)DYN_LDS);
        (void)hipOccupancyMaxActiveBlocksPerMultiprocessor(&per_cu, fwd_mega, NTHREADS, DYN_LDS);
        if (per_cu > 1) per_cu = 1;
        grid_blocks = cus * per_cu;
        if (grid_blocks <= SCAN_BLOCKS) fprintf(stderr, "grid too small: %d\n", grid_blocks);
    }
    Params p{};
    p.x = (const float*)d_in[0]; p.norm_w = (const float*)d_in[1]; p.w_in = (const float*)d_in[2]; p.conv_w = (const float*)d_in[3]; p.a_log = (const float*)d_in[4];
    p.dt_bias = (const float*)d_in[5]; p.dn_norm_w = (const float*)d_in[6]; p.q_norm_w = (const float*)d_in[7]; p.k_norm_w = (const float*)d_in[8]; p.rel_bias = (const float*)d_in[9];
    p.w_out = (const float*)d_in[10]; p.out = (float*)d_out; p.ws = (unsigned char*)d_ws;
    void* args[] = {&p};
    hipError_t e = hipLaunchCooperativeKernel((const void*)fwd_mega, dim3(grid_blocks), dim3(NTHREADS), args, DYN_LDS, stream);
    if (e != hipSuccess) fprintf(stderr, "cooperative launch failed: %s (grid %d)\n", hipGetErrorString(e), grid_blocks);
}
```

```cpp
#include <hip/hip_runtime.h>
#include <hip/hip_cooperative_groups.h>
#include <cstdint>
#include <cstdio>
namespace cg = cooperative_groups;

typedef unsigned short bf16_t;
typedef short bf16x8 __attribute__((ext_vector_type(8)));
typedef float f32x4 __attribute__((ext_vector_type(4)));
typedef float f32x16 __attribute__((ext_vector_type(16)));
typedef unsigned u32x4_t __attribute__((ext_vector_type(4)));
typedef unsigned u32x2_t __attribute__((ext_vector_type(2)));
typedef __bf16 bf16x2_t __attribute__((ext_vector_type(2)));
typedef float f32x2_t __attribute__((ext_vector_type(2)));
#define LDSP __attribute__((address_space(3)))

constexpr int NB = 8, SEQ = 4096, DM = 1024, MROWS = NB * SEQ;
constexpr int DIN = 4104, NPK = 4096;
constexpr int ATH = 8;
constexpr float EPS = 1e-6f;
constexpr size_t MiB = (size_t)1 << 20;

constexpr size_t OFF_R0 = 0;
constexpr size_t OFF_XN = OFF_R0, OFF_DNQ = OFF_R0, OFF_DNK = OFF_R0 + 32 * MiB, OFF_MIXED = OFF_R0;
constexpr size_t OFF_WTIN = 64 * MiB;
constexpr size_t OFF_WTOUT = 72 * MiB;
constexpr size_t OFF_BETA = 74 * MiB;
constexpr size_t OFF_G = OFF_BETA + MiB / 2;
constexpr size_t OFF_GCUM = 75 * MiB;
constexpr size_t OFF_R3 = 76 * MiB;
constexpr size_t OFF_PROJDN = OFF_R3, OFF_ATTP = OFF_R3  , OFF_LSE = OFF_R3 + 96 * MiB  ;
constexpr size_t OFF_Z = 176 * MiB;
constexpr size_t OFF_AQ = 208 * MiB;
constexpr size_t OFF_AK = 240 * MiB;
constexpr size_t OFF_AV = 272 * MiB;
constexpr size_t OFF_GATE = 304 * MiB;
constexpr size_t OFF_KNT = 336 * MiB;
constexpr size_t OFF_VIMG = 368 * MiB;
constexpr size_t OFF_T = 400 * MiB;
constexpr size_t OFF_ATTN = 416 * MiB;
constexpr size_t OFF_ODN = 432 * MiB;
constexpr size_t WS_NEED = 464 * MiB;

__device__ __forceinline__ bf16_t f2bf(float f) { unsigned u = __float_as_uint(f); u += 0x7FFFu + ((u >> 16) & 1u); return (bf16_t)(u >> 16); }
__device__ __forceinline__ float bf2f(bf16_t b) { return __uint_as_float(((unsigned)b) << 16); }
__device__ __forceinline__ float wave_sum(float v) {
#pragma unroll
    for (int o = 32; o >= 1; o >>= 1) v += __shfl_xor(v, o);
    return v;
}
__device__ __forceinline__ float wave_max(float v) {
#pragma unroll
    for (int o = 32; o >= 1; o >>= 1) v = fmaxf(v, __shfl_xor(v, o));
    return v;
}
__device__ __forceinline__ float silu_f(float y) { return y / (1.0f + __expf(-y)); }
__device__ __forceinline__ unsigned pk_bf16(float lo, float hi) { f32x2_t v = {lo, hi}; return __builtin_bit_cast(unsigned, __builtin_convertvector(v, bf16x2_t)); }
__device__ __forceinline__ float bflo(unsigned u) { return __uint_as_float(u << 16); }
__device__ __forceinline__ float bfhi(unsigned u) { return __uint_as_float(u & 0xFFFF0000u); }
__host__ __device__ __forceinline__ int crow(int i, int hh) { return (i & 3) + 8 * (i >> 2) + 4 * hh; }
__host__ __device__ __forceinline__ int perm16(int x) { return (x & ~12) | ((x & 4) << 1) | ((x & 8) >> 1); }
#define MFMA32(a, b, c) __builtin_amdgcn_mfma_f32_32x32x16_bf16((a), (b), (c), 0, 0, 0)
__host__ __device__ __forceinline__ size_t vimg_index(int chunk, int pos, int dv) {
    const int wsl = dv >> 5, cl = dv & 31, pt = pos >> 5, pr = pos & 31, i = 4 * (pr >> 3) + (pr & 3), hs = (pr >> 2) & 1;
    return (((((size_t)chunk * 4 + wsl) * 2 + pt) * 2 + (i >> 3)) * 64 + cl + 32 * hs) * 8 + (i & 7);
}

__device__ __forceinline__ int opaque_tid() { int t = threadIdx.x; asm volatile("" : "+v"(t)); return t & 511; }
__device__ __forceinline__ unsigned char* opaque_ptr(unsigned char* q) { asm volatile("" : "+s"(q)); return q; }
struct Params {
    const float* x; const float* norm_w; const float* w_in; const float* conv_w; const float* a_log; const float* dt_bias;
    const float* dn_norm_w; const float* q_norm_w; const float* k_norm_w; const float* rel_bias; const float* w_out;
    float* out; unsigned char* ws;
};

namespace pg8 {
#define PG8_LAS __attribute__((address_space(3)))
typedef unsigned short bf16_t;
typedef short bf16x8 __attribute__((ext_vector_type(8)));
typedef float f32x4 __attribute__((ext_vector_type(4)));
typedef unsigned u32x4 __attribute__((ext_vector_type(4)));
constexpr int BM = 256, BK = 64, HALF = 128, HTB = HALF * BK * 2  , STAGE_BYTES = 8 * HTB, NXCD = 8, WGM = 8;

__host__ __device__ __forceinline__ int lds_byte(int r, int c) { const int st = (r >> 4) * 2 + (c >> 5), rr = r & 15, cc = c & 31, ob = rr * 64 + cc * 2; return st * 1024 + (ob ^ (((ob >> 9) & 1) << 5)); }
__host__ __device__ __forceinline__ void stage_rc(int b, int& R, int& C) { const int st = b / 1024, sb = b % 1024, swz = sb ^ (((sb >> 9) & 1) << 5); R = (st >> 1) * 16 + swz / 64; C = (st & 1) * 32 + (swz % 64) / 2; }
__host__ __device__ __forceinline__ int perm32(int rho) { const int n = rho >> 4, i = rho & 15; return 8 * (i >> 2) + 4 * n + (i & 3); }

struct Unit { int pm, pn; };
struct Gemm { const bf16_t* A; const bf16_t* Bt; int M, N, K; };

struct StaticOrder {
    int nM, nN, nwg, G, c;
    __host__ __device__ void init(int M, int N, int G_, int c_) { nM = M / BM; nN = N / BM; nwg = nM * nN; G = G_; c = c_; }
    __host__ __device__ bool next(int i, Unit& u) const {
        const long L = (long)i * G + c; if (L >= nwg) return false;
        int wgid = (int)L; { const int q = nwg / NXCD, r = nwg % NXCD, xcd = wgid % NXCD, off = wgid / NXCD; wgid = (xcd < r ? xcd * (q + 1) : r * (q + 1) + (xcd - r) * q) + off; }
        const int nig = WGM * nN, gid = wgid / nig, fm = gid * WGM, gsz = (nM - fm) < WGM ? (nM - fm) : WGM;
        u.pm = fm + ((wgid % nig) % gsz); u.pn = (wgid % nig) / gsz; return true;
    }
    __device__ __forceinline__ void a_ready(const Unit&) const {}
    __device__ __forceinline__ void done(const Unit&) const {}
};

__device__ __forceinline__ unsigned cvt_pk_bf16(float lo, float hi) { unsigned r; asm volatile("v_cvt_pk_bf16_f32 %0, %1, %2" : "=v"(r) : "v"(lo), "v"(hi)); return r; }
typedef float f32x2 __attribute__((ext_vector_type(2)));
template <class Epi, class Sched, bool ALIGN_EPI = false, bool SP2 = false>
__device__ __forceinline__ void gemm_phase(PG8_LAS unsigned char* lds, const Gemm g, const Sched& S, const Epi& E) {
    const int tid = opaque_tid(), wid = __builtin_amdgcn_readfirstlane(tid >> 6), lane = tid & 63, wr = wid >> 2, wc = wid & 3, fr = lane & 15, fq = lane >> 4;
    const int K = g.K, nt = K / BK;
    unsigned voffA[2], voffB[2];
#pragma unroll
    for (int i = 0; i < 2; ++i) { int R, C; stage_rc(tid * 16 + i * 8192, R, C); const int Rb = Epi::PERM ? ((R & ~31) + perm32(R & 31)) : R;
        voffA[i] = (unsigned)(R * K + C) * 2u; voffB[i] = (unsigned)(Rb * K + C) * 2u; }
    const size_t kstep = (size_t)(BK * 2);
    const size_t hstep = (size_t)HALF * K * 2;
    const size_t tstep = 2 * hstep;
    const unsigned ldsw = (unsigned)wid * 1024u;
    const int aoff = lds_byte(wr * 64 + fr, fq * 8), boff = lds_byte(wc * 32 + fr, fq * 8);
#define PG8_SA(b, h) (((b) * 2 + (h)) * HTB)
#define PG8_SB(b, h) ((4 + (b) * 2 + (h)) * HTB)
#define PG8_STAGE(bufoff, gbase, voff) do { _Pragma("unroll") for (int _i = 0; _i < 2; ++_i) \
        __builtin_amdgcn_global_load_lds((const unsigned*)((const char*)(gbase) + (voff)[_i]), (PG8_LAS unsigned*)(lds + (bufoff) + ldsw + _i * 8192), 16, 0, 0); } while (0)
#define PG8_LDA(dst, b, h) do { _Pragma("unroll") for (int m = 0; m < 4; ++m) _Pragma("unroll") for (int k = 0; k < 2; ++k) dst[m][k] = *(const PG8_LAS bf16x8*)(lds + PG8_SA(b, h) + aoff + m * 2048 + k * 1024); } while (0)
#define PG8_LDB(dst, b, h) do { _Pragma("unroll") for (int n = 0; n < 2; ++n) _Pragma("unroll") for (int k = 0; k < 2; ++k) dst[n][k] = *(const PG8_LAS bf16x8*)(lds + PG8_SB(b, h) + boff + n * 2048 + k * 1024); } while (0)
#define PG8_MMA(ai, bj, At, Bt) do { __builtin_amdgcn_s_setprio(1); _Pragma("unroll") for (int m = 0; m < 4; ++m) _Pragma("unroll") for (int n = 0; n < 2; ++n) _Pragma("unroll") for (int k = 0; k < 2; ++k) \
        acc[ai][bj][m][n] = __builtin_amdgcn_mfma_f32_16x16x32_bf16(Bt[n][k], At[m][k], acc[ai][bj][m][n], 0, 0, 0); __builtin_amdgcn_s_setprio(0); } while (0)
#define PG8_WAIT_V(n) asm volatile("s_waitcnt vmcnt(" #n ")" ::: "memory")
#define PG8_WAIT_L(n) asm volatile("s_waitcnt lgkmcnt(" #n ")" ::: "memory")
#define PG8_BAR __builtin_amdgcn_s_barrier()
#define PG8_SCHED __builtin_amdgcn_sched_barrier(0)
    Unit cur, nxt; int ui = 0;
    if (!S.next(0, cur)) return;
    f32x4 acc[2][2][4][2];
#pragma unroll
    for (int a = 0; a < 2; ++a)
#pragma unroll
        for (int b = 0; b < 2; ++b)
#pragma unroll
            for (int m = 0; m < 4; ++m)
#pragma unroll
                for (int n = 0; n < 2; ++n) acc[a][b][m][n] = (f32x4){0.f, 0.f, 0.f, 0.f};
    bf16x8 At[4][2], B0[2][2], B1[2][2];
    const char* cA = (const char*)g.A + (size_t)cur.pm * tstep; const char* cB = (const char*)g.Bt + (size_t)cur.pn * tstep;
    S.a_ready(cur);
    if constexpr (SP2) {
        PG8_STAGE(PG8_SB(0, 0), cB, voffB); PG8_STAGE(PG8_SB(0, 1), cB + hstep, voffB); PG8_STAGE(PG8_SA(0, 0), cA, voffA); PG8_STAGE(PG8_SA(0, 1), cA + hstep, voffA);
        if (wr == 1) PG8_BAR;
        PG8_WAIT_V(2); PG8_BAR;
        PG8_STAGE(PG8_SB(1, 0), cB + kstep, voffB); PG8_STAGE(PG8_SA(1, 0), cA + kstep, voffA); PG8_STAGE(PG8_SB(1, 1), cB + hstep + kstep, voffB);
        PG8_WAIT_V(6); PG8_BAR;
    } else {
        PG8_STAGE(PG8_SB(0, 0), cB, voffB); PG8_STAGE(PG8_SA(0, 0), cA, voffA); PG8_STAGE(PG8_SB(0, 1), cB + hstep, voffB); PG8_STAGE(PG8_SA(0, 1), cA + hstep, voffA);
        if (wr == 1) PG8_BAR;
        PG8_WAIT_V(4); PG8_BAR;
        PG8_STAGE(PG8_SB(1, 0), cB + kstep, voffB); PG8_STAGE(PG8_SA(1, 0), cA + kstep, voffA); PG8_STAGE(PG8_SB(1, 1), cB + hstep + kstep, voffB);
        PG8_WAIT_V(6); PG8_BAR;
    }
    for (;;) {
        const bool has_next = S.next(ui + 1, nxt);
        const char* nA = has_next ? (const char*)g.A + (size_t)nxt.pm * tstep : cA; const char* nB = has_next ? (const char*)g.Bt + (size_t)nxt.pn * tstep : cB;
        for (int t = 0; t < nt; t += 2) {
            const bool last = (t == nt - 2);
            const char* a1 = cA + (size_t)(t + 1) * kstep;
            const char* a2 = last ? nA : cA + (size_t)(t + 2) * kstep; const char* b2 = last ? nB : cB + (size_t)(t + 2) * kstep;
            const char* a3 = a2 + kstep; const char* b3 = b2 + kstep;
            if (last && has_next) S.a_ready(nxt);
            if constexpr (SP2) {
            PG8_LDB(B0, 0, 0); PG8_LDB(B1, 0, 1); PG8_SCHED; PG8_LDA(At, 0, 0); PG8_STAGE(PG8_SA(1, 1), a1 + hstep, voffA);
            PG8_WAIT_V(8); PG8_WAIT_L(0); PG8_BAR; PG8_MMA(0, 0, At, B0); PG8_MMA(0, 1, At, B1); PG8_BAR; PG8_SCHED;
            PG8_LDA(At, 0, 1); PG8_STAGE(PG8_SB(0, 0), b2, voffB); PG8_STAGE(PG8_SB(0, 1), b2 + hstep, voffB); PG8_STAGE(PG8_SA(0, 0), a2, voffA);
            PG8_WAIT_V(8); PG8_WAIT_L(0); PG8_BAR; PG8_MMA(1, 0, At, B0); PG8_MMA(1, 1, At, B1); PG8_BAR; PG8_SCHED;
            PG8_LDB(B0, 1, 0); PG8_LDB(B1, 1, 1); PG8_SCHED; PG8_LDA(At, 1, 0); PG8_STAGE(PG8_SA(0, 1), a2 + hstep, voffA);
            PG8_WAIT_V(8); PG8_WAIT_L(0); PG8_BAR; PG8_MMA(0, 0, At, B0); PG8_MMA(0, 1, At, B1); PG8_BAR; PG8_SCHED;
            PG8_LDA(At, 1, 1); PG8_STAGE(PG8_SB(1, 0), b3, voffB); PG8_STAGE(PG8_SB(1, 1), b3 + hstep, voffB); PG8_STAGE(PG8_SA(1, 0), a3, voffA);
            PG8_WAIT_V(8); PG8_WAIT_L(0); PG8_BAR; PG8_MMA(1, 0, At, B0); PG8_MMA(1, 1, At, B1); PG8_BAR; PG8_SCHED;
            } else {
            PG8_LDB(B0, 0, 0); PG8_SCHED; PG8_LDA(At, 0, 0); PG8_STAGE(PG8_SA(1, 1), a1 + hstep, voffA);
            PG8_WAIT_L(8); PG8_BAR; PG8_WAIT_L(0); PG8_MMA(0, 0, At, B0); PG8_BAR; PG8_SCHED;
            PG8_LDB(B1, 0, 1); PG8_STAGE(PG8_SB(0, 0), b2, voffB);
            PG8_BAR; PG8_WAIT_L(0); PG8_MMA(0, 1, At, B1); PG8_BAR;
            PG8_LDA(At, 0, 1); PG8_STAGE(PG8_SA(0, 0), a2, voffA);
            PG8_BAR; PG8_WAIT_L(0); PG8_MMA(1, 0, At, B0); PG8_BAR; PG8_SCHED;
            PG8_STAGE(PG8_SB(0, 1), b2 + hstep, voffB);
            PG8_WAIT_V(6); PG8_BAR; PG8_MMA(1, 1, At, B1); PG8_BAR;
            PG8_LDB(B0, 1, 0); PG8_SCHED; PG8_LDA(At, 1, 0); PG8_STAGE(PG8_SA(0, 1), a2 + hstep, voffA);
            PG8_WAIT_L(8); PG8_BAR; PG8_WAIT_L(0); PG8_MMA(0, 0, At, B0); PG8_BAR; PG8_SCHED;
            PG8_LDB(B1, 1, 1); PG8_STAGE(PG8_SB(1, 0), b3, voffB);
            PG8_BAR; PG8_WAIT_L(0); PG8_MMA(0, 1, At, B1); PG8_BAR;
            PG8_LDA(At, 1, 1); PG8_STAGE(PG8_SA(1, 0), a3, voffA);
            PG8_BAR; PG8_WAIT_L(0); PG8_MMA(1, 0, At, B0); PG8_BAR; PG8_SCHED;
            PG8_STAGE(PG8_SB(1, 1), b3 + hstep, voffB);
            PG8_WAIT_V(6); PG8_BAR; PG8_MMA(1, 1, At, B1); PG8_BAR;
            }
        }
        if constexpr (ALIGN_EPI) { if (wr == 0) PG8_BAR; }
        if constexpr (!Epi::AFTER_DRAIN) { E(acc, cur, wr, wc, fr, fq); S.done(cur); }
        if (!has_next) break;
#pragma unroll
        for (int a = 0; a < 2; ++a)
#pragma unroll
            for (int b = 0; b < 2; ++b)
#pragma unroll
                for (int m = 0; m < 4; ++m)
#pragma unroll
                    for (int n = 0; n < 2; ++n) acc[a][b][m][n] = (f32x4){0.f, 0.f, 0.f, 0.f};
        cur = nxt; cA = nA; cB = nB; ++ui;
        if constexpr (ALIGN_EPI) { if (wr == 1) PG8_BAR; }
    }
    PG8_WAIT_V(0);
    if constexpr (!ALIGN_EPI) { if (wr == 0) PG8_BAR; }
    PG8_BAR;
    if constexpr (Epi::AFTER_DRAIN) { E.fused(acc, cur, wr, wc, fr, fq, lds, wid, lane); S.done(cur); }
#undef PG8_SA
#undef PG8_SB
#undef PG8_STAGE
#undef PG8_LDA
#undef PG8_LDB
#undef PG8_MMA
#undef PG8_WAIT_V
#undef PG8_WAIT_L
#undef PG8_BAR
#undef PG8_SCHED
}
}

__host__ __device__ __forceinline__ int wt_src_col(int n) {
    if (n < 2048) return n;
    if (n >= 3584) return n + 8;
    const int pn = n >> 8, vc = n & 255, bj = vc >> 7, wc = (vc >> 5) & 3, i = vc & 31;
    return 2056 + ((pn - 8) >> 1) * 512 + (4 * (pn & 1) + wc) * 64 + 32 * bj + i;
}
struct EpiProjSplit {
    static constexpr bool PERM = true, AFTER_DRAIN = false;
    unsigned char* ws; const float *qw, *kw;
    __device__ __forceinline__ static pg8::u32x4 pack8(const f32x4 v0, const f32x4 v1) { pg8::u32x4 w;
        w.x = pg8::cvt_pk_bf16(v0[0], v0[1]); w.y = pg8::cvt_pk_bf16(v0[2], v0[3]); w.z = pg8::cvt_pk_bf16(v1[0], v1[1]); w.w = pg8::cvt_pk_bf16(v1[2], v1[3]); return w; }
    __device__ __forceinline__ void operator()(const f32x4 (&acc)[2][2][4][2], const pg8::Unit& u, int wr, int wc, int fr, int fq) const {
        const int pn = u.pn, row0 = u.pm * 256 + wr * 64 + fr;
        if (pn < 8 || pn >= 14) {
            const size_t boff = pn < 6 ? OFF_PROJDN : (pn < 8 ? OFF_Z : OFF_GATE);
            const int ld = pn < 6 ? 1536 : 512, colt = pn < 6 ? pn * 256 : (pn & 1) * 256; const bool act = pn >= 6;
            bf16_t* base = (bf16_t*)(ws + boff);
            const int col0 = colt + wc * 32 + 8 * fq;
#pragma unroll
            for (int ai = 0; ai < 2; ++ai)
#pragma unroll
                for (int m = 0; m < 4; ++m) { bf16_t* rowp = base + (size_t)(row0 + ai * 128 + m * 16) * ld + col0;
#pragma unroll
                    for (int bj = 0; bj < 2; ++bj) { f32x4 v0 = acc[ai][bj][m][0], v1 = acc[ai][bj][m][1];
                        if (act) {
#pragma unroll
                            for (int e = 0; e < 4; ++e) { v0[e] = silu_f(v0[e]); v1[e] = silu_f(v1[e]); } }
                        *(pg8::u32x4*)(rowp + bj * 128) = pack8(v0, v1); } }
        } else {
            const int grp = (pn - 8) >> 1, head = 4 * (pn & 1) + wc;
            bf16_t* base = (bf16_t*)(ws + OFF_AQ + (size_t)grp * (32 * MiB));
            f32x4 wv[2][2];
            if (grp < 2) { const float* w = grp == 0 ? qw : kw; const float sc = grp == 0 ? 0.125f : 1.0f;
#pragma unroll
                for (int bj = 0; bj < 2; ++bj)
#pragma unroll
                    for (int n = 0; n < 2; ++n) wv[bj][n] = *(const f32x4*)(w + 32 * bj + 8 * fq + 4 * n) * sc; }
#pragma unroll
            for (int ai = 0; ai < 2; ++ai)
#pragma unroll
                for (int m = 0; m < 4; ++m) {
                    const int r = row0 + ai * 128 + m * 16, b = r >> 12, t = r & 4095;
                    f32x4 v[2][2];
#pragma unroll
                    for (int bj = 0; bj < 2; ++bj)
#pragma unroll
                        for (int n = 0; n < 2; ++n) v[bj][n] = acc[ai][bj][m][n];
                    if (grp < 2) {
                        float ss = 0.f;
#pragma unroll
                        for (int bj = 0; bj < 2; ++bj)
#pragma unroll
                            for (int n = 0; n < 2; ++n) ss += v[bj][n][0] * v[bj][n][0] + v[bj][n][1] * v[bj][n][1] + v[bj][n][2] * v[bj][n][2] + v[bj][n][3] * v[bj][n][3];
                        ss += __shfl_xor(ss, 16); ss += __shfl_xor(ss, 32);
                        const float rstd = rsqrtf(ss * (1.0f / 64.f) + EPS);
#pragma unroll
                        for (int bj = 0; bj < 2; ++bj)
#pragma unroll
                            for (int n = 0; n < 2; ++n) v[bj][n] = v[bj][n] * rstd * wv[bj][n];
                    }
                    bf16_t* dst = base + ((size_t)(b * 8 + head) * SEQ + t) * 64 + 8 * fq;
                    *(pg8::u32x4*)(dst) = pack8(v[0][0], v[0][1]);
                    *(pg8::u32x4*)(dst + 32) = pack8(v[1][0], v[1][1]);
                }
        }
    }
};
struct EpiOutRes {
    static constexpr bool PERM = false, AFTER_DRAIN = false;
    const float* X; float* C;
    __device__ __forceinline__ void operator()(const f32x4 (&acc)[2][2][4][2], const pg8::Unit& u, int wr, int wc, int fr, int fq) const {
        const int row0 = u.pm * 256 + wr * 64 + fr, col0 = u.pn * 256 + wc * 32 + 4 * fq;
#pragma unroll
        for (int ai = 0; ai < 2; ++ai)
#pragma unroll
            for (int m = 0; m < 4; ++m) { const size_t off = (size_t)(row0 + ai * 128 + m * 16) * DM + col0;
#pragma unroll
                for (int bj = 0; bj < 2; ++bj)
#pragma unroll
                    for (int n = 0; n < 2; ++n) { const size_t o = off + bj * 128 + n * 16; *(f32x4*)(C + o) = *(const f32x4*)(X + o) + acc[ai][bj][m][n]; } }
    }
};

__device__ void phase_weights(const Params& p) {
    bf16_t* wt_in = (bf16_t*)(p.ws + OFF_WTIN); bf16_t* wt_out = (bf16_t*)(p.ws + OFF_WTOUT);
    const size_t gt = (size_t)blockIdx.x * blockDim.x + opaque_tid(), gn = (size_t)gridDim.x * blockDim.x;
    for (size_t i = gt; i < (size_t)DM * NPK; i += gn) { const int k = (int)(i / NPK), n = (int)(i % NPK);
        wt_in[(size_t)n * DM + k] = f2bf(p.w_in[(size_t)k * DIN + wt_src_col(n)]); }
    for (size_t i = gt; i < (size_t)DM * DM; i += gn) { const int k = (int)(i / DM), n = (int)(i % DM);
        wt_out[(size_t)n * DM + k] = f2bf(p.w_out[(size_t)k * DM + n]); }
}

__device__ void phase_norm(const Params& p, float* lds_w8  ) {
    bf16_t* xn = (bf16_t*)(p.ws + OFF_XN); float* beta = (float*)(p.ws + OFF_BETA); float* gdec = (float*)(p.ws + OFF_G);
    const int tid = opaque_tid();
    for (int i = tid; i < 1024 * 8; i += blockDim.x) { const int k = i >> 3, j = i & 7; lds_w8[i] = p.w_in[(size_t)k * DIN + 2048 + j]; }
    __syncthreads();
    const int lane = tid & 63, wpb = blockDim.x >> 6, gw = blockIdx.x * wpb + (tid >> 6), nw = gridDim.x * wpb;
    f32x4 nw4[4];
#pragma unroll
    for (int i = 0; i < 4; ++i) nw4[i] = *(const f32x4*)(p.norm_w + i * 256 + lane * 4);
    for (int row = gw; row < MROWS; row += nw) {
        f32x4 xv[4]; float ss = 0.f;
#pragma unroll
        for (int i = 0; i < 4; ++i) { xv[i] = *(const f32x4*)(p.x + (size_t)row * DM + i * 256 + lane * 4); ss += xv[i][0] * xv[i][0] + xv[i][1] * xv[i][1] + xv[i][2] * xv[i][2] + xv[i][3] * xv[i][3]; }
        ss = wave_sum(ss);
        const float rstd = rsqrtf(ss * (1.0f / DM) + EPS);
        float acc[8];
#pragma unroll
        for (int j = 0; j < 8; ++j) acc[j] = 0.f;
#pragma unroll
        for (int i = 0; i < 4; ++i) {
            f32x4 h = xv[i] * rstd * nw4[i];
            uint2 pk; pk.x = (unsigned)f2bf(h[0]) | ((unsigned)f2bf(h[1]) << 16); pk.y = (unsigned)f2bf(h[2]) | ((unsigned)f2bf(h[3]) << 16);
            *(uint2*)(xn + (size_t)row * DM + i * 256 + lane * 4) = pk;
#pragma unroll
            for (int e = 0; e < 4; ++e) { const float* w8 = lds_w8 + (i * 256 + lane * 4 + e) * 8;
#pragma unroll
                for (int j = 0; j < 8; ++j) acc[j] += h[e] * w8[j]; }
        }
#pragma unroll
        for (int j = 0; j < 8; ++j) acc[j] = wave_sum(acc[j]);
        const int b = row / SEQ, s = row % SEQ;
        if (lane == 0) {
#pragma unroll
            for (int j = 0; j < 4; ++j) {
                beta[((size_t)b * 4 + j) * SEQ + s] = 1.0f / (1.0f + expf(-acc[j]));
                const float xx = acc[4 + j] + p.dt_bias[j]; const float sp = xx > 20.f ? xx : log1pf(expf(xx));
                gdec[((size_t)b * 4 + j) * SEQ + s] = -expf(p.a_log[j]) * sp;
            }
        }
    }
}

__device__ void phase_dn_prep(const Params& p) {
    const bf16_t* proj = (const bf16_t*)(p.ws + OFF_PROJDN);
    bf16_t* qn = (bf16_t*)(p.ws + OFF_DNQ); bf16_t* kn = (bf16_t*)(p.ws + OFF_DNK); bf16_t* knT = (bf16_t*)(p.ws + OFF_KNT); bf16_t* vimg = (bf16_t*)(p.ws + OFF_VIMG);
    const float* gdec = (const float*)(p.ws + OFF_G); float* gcum = (float*)(p.ws + OFF_GCUM);
    const int tid = opaque_tid(), lane = tid & 63, w = tid >> 6;
    for (int unit = blockIdx.x; unit < NB * 4 * 64; unit += gridDim.x) {
        const int n = unit & 63, bh = unit >> 6, h = bh & 3, b = bh >> 2, t0 = n * 64;
        float y[3][8][2];
#pragma unroll
        for (int g = 0; g < 3; ++g) {
            const int ch = g * 512 + h * 128 + 2 * lane;
            float cw[4][2];
#pragma unroll
            for (int i = 0; i < 4; ++i) { cw[i][0] = p.conv_w[i * 1536 + ch]; cw[i][1] = p.conv_w[i * 1536 + ch + 1]; }
            unsigned raw[11];
#pragma unroll
            for (int rr = 0; rr < 11; ++rr) { const int tt = t0 + 8 * w - 3 + rr; raw[rr] = tt >= 0 ? *(const unsigned*)(proj + (size_t)(b * SEQ + tt) * 1536 + ch) : 0u; }
#pragma unroll
            for (int pp = 0; pp < 8; ++pp) { float a0 = 0.f, a1 = 0.f;
#pragma unroll
                for (int i = 0; i < 4; ++i) { a0 += cw[i][0] * bflo(raw[pp + i]); a1 += cw[i][1] * bfhi(raw[pp + i]); }
                y[g][pp][0] = silu_f(a0); y[g][pp][1] = silu_f(a1); }
        }
        const int d = 2 * lane, dcol = (d & ~15) + perm16(d & 15);
        unsigned kpk[8][1]; bf16_t kb[8][2];
#pragma unroll
        for (int pp = 0; pp < 8; ++pp) {
            const float sq = wave_sum(y[0][pp][0] * y[0][pp][0] + y[0][pp][1] * y[0][pp][1]), sk = wave_sum(y[1][pp][0] * y[1][pp][0] + y[1][pp][1] * y[1][pp][1]);
            const float rq = rsqrtf(sq + EPS) * 0.08838834764831845f, rk = rsqrtf(sk + EPS);
            const size_t ro = ((size_t)unit * 64 + 8 * w + pp) * 128 + dcol;
            *(unsigned*)(qn + ro) = pk_bf16(y[0][pp][0] * rq, y[0][pp][1] * rq);
            const unsigned kk = pk_bf16(y[1][pp][0] * rk, y[1][pp][1] * rk);
            *(unsigned*)(kn + ro) = kk; kpk[pp][0] = kk; kb[pp][0] = (bf16_t)(kk & 0xFFFFu); kb[pp][1] = (bf16_t)(kk >> 16);
        }
#pragma unroll
        for (int e = 0; e < 2; ++e)
#pragma unroll
            for (int hs = 0; hs < 2; ++hs) {
                u32x2_t v; v.x = (unsigned)kb[4 * hs][e] | ((unsigned)kb[4 * hs + 1][e] << 16); v.y = (unsigned)kb[4 * hs + 2][e] | ((unsigned)kb[4 * hs + 3][e] << 16);
                *(u32x2_t*)(knT + ((size_t)unit * 128 + d + e) * 64 + 16 * (w >> 1) + 8 * hs + 4 * (w & 1)) = v;
            }
#pragma unroll
        for (int e = 0; e < 2; ++e)
#pragma unroll
            for (int hs = 0; hs < 2; ++hs) {
                u32x2_t v; v.x = pk_bf16(y[2][4 * hs][e], y[2][4 * hs + 1][e]); v.y = pk_bf16(y[2][4 * hs + 2][e], y[2][4 * hs + 3][e]);
                *(u32x2_t*)(vimg + vimg_index(unit, 8 * w + 4 * hs, d + e)) = v;
            }
        if (w == 0) {
            float v = gdec[(size_t)bh * SEQ + t0 + lane];
#pragma unroll
            for (int o = 1; o < 64; o <<= 1) { const float t = __shfl_up(v, o); if (lane >= o) v += t; }
            gcum[(size_t)unit * 64 + lane] = v;
        }
    }
}

constexpr int D1B_LDS_PER_WAVE = 64 * 68 * 4 + 512;
__device__ void phase_dn_chunk(const Params& p, unsigned char* smem) {
    const bf16_t* qn = (const bf16_t*)(p.ws + OFF_DNQ); const bf16_t* kn = (const bf16_t*)(p.ws + OFF_DNK);
    const float* beta = (const float*)(p.ws + OFF_BETA); const float* gcum = (const float*)(p.ws + OFF_GCUM);
    bf16_t* Tm = (bf16_t*)(p.ws + OFF_T); bf16_t* attn = (bf16_t*)(p.ws + OFF_ATTN);
    const int tid0 = opaque_tid(), w = tid0 >> 6, lane = tid0 & 63, r = lane & 31, hh = lane >> 5;
    LDSP float* At = (LDSP float*)((LDSP unsigned char*)smem + w * D1B_LDS_PER_WAVE); LDSP float* tg = At + 64 * 68; LDSP float* tb = tg + 64;
    for (int c = blockIdx.x * 8 + w; c < NB * 4 * 64; c += gridDim.x * 8) {
        const int bh = c >> 6, n = c & 63;
        tg[lane] = gcum[(size_t)c * 64 + lane]; tb[lane] = beta[(size_t)bh * SEQ + n * 64 + lane];
        const bf16_t* kp = kn + ((size_t)c * 64 + r) * 128 + 8 * hh; const bf16_t* qp = qn + ((size_t)c * 64 + r) * 128 + 8 * hh;
#define D1B_TILE_A(rt, ct) do { f32x16 tile; _Pragma("unroll") for (int i = 0; i < 16; ++i) tile[i] = 0.f; \
        _Pragma("unroll 2") for (int s = 0; s < 8; ++s) { const bf16x8 ka = *(const bf16x8*)(kp + (rt) * 32 * 128 + 16 * s), kb2 = *(const bf16x8*)(kp + (ct) * 32 * 128 + 16 * s); tile = MFMA32(ka, kb2, tile); } \
        const int cc = 32 * (ct) + r; const float gcc = tg[cc]; \
        _Pragma("unroll") for (int g4 = 0; g4 < 4; ++g4) { const int j0 = 32 * (rt) + 8 * g4 + 4 * hh; const f32x4 gj = *(const LDSP f32x4*)(tg + j0), bj = *(const LDSP f32x4*)(tb + j0); f32x4 o; \
            _Pragma("unroll") for (int e = 0; e < 4; ++e) o[e] = bj[e] * __expf(fminf(gj[e] - gcc, 0.f)) * tile[4 * g4 + e]; \
            *(LDSP f32x4*)(At + cc * 68 + j0) = o; } \
        asm volatile("" ::: "memory"); } while (0)
        D1B_TILE_A(0, 0); D1B_TILE_A(1, 0); D1B_TILE_A(1, 1);
#undef D1B_TILE_A
        float Tr[64];
        int lane_o = lane; asm volatile("" : "+v"(lane_o));
#pragma unroll
        for (int cc = 63; cc >= 0; --cc) {
            float a0 = (lane_o == cc) ? 1.f : 0.f, a1 = 0.f;
#pragma unroll
            for (int j4 = ((cc + 1) & ~3); j4 < 64; j4 += 4) { const f32x4 av = *(const LDSP f32x4*)(At + cc * 68 + j4);
                if (j4 + 0 > cc) a0 -= Tr[j4 + 0] * av[0];
                if (j4 + 1 > cc) a1 -= Tr[j4 + 1] * av[1];
                if (j4 + 2 > cc) a0 -= Tr[j4 + 2] * av[2];
                if (j4 + 3 > cc) a1 -= Tr[j4 + 3] * av[3]; }
            Tr[cc] = a0 + a1;
        }
#pragma unroll
        for (int q = 0; q < 4; ++q)
#pragma unroll
            for (int half = 0; half < 2; ++half) { u32x4_t o;
                const int s0 = 8 * half;
                o.x = pk_bf16(Tr[16 * q + perm16(s0 + 0)], Tr[16 * q + perm16(s0 + 0) + 1]); o.y = pk_bf16(Tr[16 * q + perm16(s0 + 2)], Tr[16 * q + perm16(s0 + 2) + 1]);
                o.z = pk_bf16(Tr[16 * q + perm16(s0 + 4)], Tr[16 * q + perm16(s0 + 4) + 1]); o.w = pk_bf16(Tr[16 * q + perm16(s0 + 6)], Tr[16 * q + perm16(s0 + 6) + 1]);
                *(u32x4_t*)(Tm + ((size_t)c * 64 + lane) * 64 + 16 * q + s0) = o; }
#define D1B_TILE_ATT(jt, it) do { f32x16 tile; _Pragma("unroll") for (int i = 0; i < 16; ++i) tile[i] = 0.f; \
        _Pragma("unroll 2") for (int s = 0; s < 8; ++s) { const bf16x8 ka = *(const bf16x8*)(kp + (jt) * 32 * 128 + 16 * s), qb2 = *(const bf16x8*)(qp + (it) * 32 * 128 + 16 * s); tile = MFMA32(ka, qb2, tile); } \
        const int qi = 32 * (it) + r; const float gi = tg[qi]; \
        _Pragma("unroll") for (int s2 = 0; s2 < 2; ++s2) { float v[8]; \
            _Pragma("unroll") for (int a = 0; a < 2; ++a) { const int j0 = 32 * (jt) + 16 * s2 + 8 * a + 4 * hh; const f32x4 gj = *(const LDSP f32x4*)(tg + j0); \
                _Pragma("unroll") for (int e = 0; e < 4; ++e) v[4 * a + e] = (qi >= j0 + e) ? __expf(fminf(gi - gj[e], 0.f)) * tile[8 * s2 + 4 * a + e] : 0.f; } \
            u32x4_t o; o.x = pk_bf16(v[0], v[1]); o.y = pk_bf16(v[2], v[3]); o.z = pk_bf16(v[4], v[5]); o.w = pk_bf16(v[6], v[7]); \
            *(u32x4_t*)(attn + ((size_t)c * 64 + qi) * 64 + 32 * (jt) + 16 * s2 + 8 * hh) = o; } \
        asm volatile("" ::: "memory"); } while (0)
        D1B_TILE_ATT(0, 0); D1B_TILE_ATT(0, 1); D1B_TILE_ATT(1, 1);
#undef D1B_TILE_ATT
    }
}

constexpr int SCAN_BUF = 65536, SCAN_TBL = 2 * SCAN_BUF;
__device__ __forceinline__ int swz256(int row, int ch) { return (row * 16 + (ch ^ (row & 15))) * 16; }
__device__ __forceinline__ int swz128(int row, int ch) { const int sr = row >> 1; return (sr * 16 + ((((row & 1) << 3) | ch) ^ (sr & 7))) * 16; }
__device__ void phase_dn_scan(const Params& p, unsigned char* smem, int bh) {
    const unsigned char* qnb = p.ws + OFF_DNQ; const unsigned char* knb = p.ws + OFF_DNK; const unsigned char* kntb = p.ws + OFF_KNT;
    const unsigned char* tb_ = p.ws + OFF_T; const unsigned char* atb = p.ws + OFF_ATTN;
    const bf16_t* vimg = (const bf16_t*)(p.ws + OFF_VIMG); bf16_t* oimg = (bf16_t*)(p.ws + OFF_ODN);
    const float* beta = (const float*)(p.ws + OFF_BETA); const float* gcum = (const float*)(p.ws + OFF_GCUM);
    const int tid = opaque_tid(), lane = tid & 63, w = __builtin_amdgcn_readfirstlane(tid >> 6), r = lane & 31, hh = lane >> 5;
    LDSP unsigned char* lds = (LDSP unsigned char*)smem;
    auto stage = [&](int n, int bsel) {
        const size_t chunk = (size_t)bh * 64 + n;
        int ln = lane; asm volatile("" : "+v"(ln)); ln &= 63;
#pragma unroll
        for (int i = 0; i < 8; ++i) {
            const int k = w * 8 + i; const unsigned char* src;
            if (k < 32) { const int sl = (k & 15) * 64 + ln, row = sl >> 4, ch = (sl & 15) ^ (row & 15); src = (k < 16 ? knb : qnb) + chunk * 16384 + row * 256 + ch * 16; }
            else { const int sl = (k < 48 ? (k - 32) : (k < 56 ? (k - 48) : (k - 56))) * 64 + ln, sr = sl >> 4, lp = (sl & 15) ^ (sr & 7), row = sr * 2 + (lp >> 3), ch = lp & 7;
                   src = (k < 48 ? kntb + chunk * 16384 : (k < 56 ? tb_ + chunk * 8192 : atb + chunk * 8192)) + row * 128 + ch * 16; }
            __builtin_amdgcn_global_load_lds((const unsigned*)src, (LDSP unsigned*)(lds + bsel * SCAN_BUF + k * 1024), 16, 0, 0);
        }
        if (w == 7) { LDSP float* tbl = (LDSP float*)(lds + SCAN_TBL + bsel * 512); tbl[ln] = gcum[chunk * 64 + ln]; tbl[64 + ln] = beta[(size_t)bh * SEQ + n * 64 + ln]; }
    };
    f32x16 S[4];
#pragma unroll
    for (int dt = 0; dt < 4; ++dt)
#pragma unroll
        for (int i = 0; i < 16; ++i) S[dt][i] = 0.f;
#define SCAN_SB(kc) __builtin_bit_cast(bf16x8, (u32x4_t){pk_bf16(S[(kc) >> 1][8 * ((kc) & 1)], S[(kc) >> 1][8 * ((kc) & 1) + 1]), pk_bf16(S[(kc) >> 1][8 * ((kc) & 1) + 2], S[(kc) >> 1][8 * ((kc) & 1) + 3]), \
                                                     pk_bf16(S[(kc) >> 1][8 * ((kc) & 1) + 4], S[(kc) >> 1][8 * ((kc) & 1) + 5]), pk_bf16(S[(kc) >> 1][8 * ((kc) & 1) + 6], S[(kc) >> 1][8 * ((kc) & 1) + 7])})
    u32x4_t vr[2][2];
    if (w < 4) {
#pragma unroll
        for (int pt = 0; pt < 2; ++pt)
#pragma unroll
            for (int g = 0; g < 2; ++g) vr[pt][g] = *(const u32x4_t*)(vimg + (((((size_t)bh * 64 * 4 + w) * 2 + pt) * 2 + g) * 64 + lane) * 8);
    }
    stage(0, 0);
    asm volatile("s_waitcnt vmcnt(0)" ::: "memory");
    __syncthreads();
    for (int n = 0; n < 64; ++n) {
        const int bsel = n & 1;
        if (n + 1 < 64) stage(n + 1, bsel ^ 1);
        if (w < 4) {
            const size_t chunk = (size_t)bh * 64 + n;
            LDSP unsigned char* B = lds + bsel * SCAN_BUF; LDSP float* tg = (LDSP float*)(lds + SCAN_TBL + bsel * 512); LDSP float* tbt = tg + 64;
            LDSP unsigned char* Bkn = B, *Bqn = B + 16384, *BknT = B + 32768, *BT = B + 49152, *Bat = B + 57344;
            f32x16 X[2];
#pragma unroll
            for (int i = 0; i < 16; ++i) { X[0][i] = 0.f; X[1][i] = 0.f; }
#pragma unroll
            for (int kc = 0; kc < 8; ++kc) {
                const bf16x8 a0 = *(const LDSP bf16x8*)(Bkn + swz256(r, 2 * kc + hh)), a1 = *(const LDSP bf16x8*)(Bkn + swz256(32 + r, 2 * kc + hh));
                const bf16x8 sb = SCAN_SB(kc); X[0] = MFMA32(a0, sb, X[0]); X[1] = MFMA32(a1, sb, X[1]);
            }
            asm volatile("" ::: "memory");
            const float gl_last = tg[63];
            bf16x8 Yb[2][2];
#pragma unroll
            for (int pt = 0; pt < 2; ++pt) {
                unsigned yp[8];
#pragma unroll
                for (int g4 = 0; g4 < 4; ++g4) { const int j0 = 32 * pt + 8 * g4 + 4 * hh; const f32x4 gj = *(const LDSP f32x4*)(tg + j0), bj = *(const LDSP f32x4*)(tbt + j0);
                    float yv[4];
#pragma unroll
                    for (int e = 0; e < 4; ++e) { const int i = 4 * g4 + e;
                        const unsigned vw = vr[pt][i >> 3][(i & 7) >> 1]; const float vv = (i & 1) ? bfhi(vw) : bflo(vw);
                        yv[e] = bj[e] * (vv - __expf(gj[e]) * X[pt][i]); }
                    yp[2 * g4] = pk_bf16(yv[0], yv[1]); yp[2 * g4 + 1] = pk_bf16(yv[2], yv[3]); }
#pragma unroll
                for (int s = 0; s < 2; ++s) { u32x4_t t4; t4.x = yp[4 * s]; t4.y = yp[4 * s + 1]; t4.z = yp[4 * s + 2]; t4.w = yp[4 * s + 3]; Yb[pt][s] = __builtin_bit_cast(bf16x8, t4); }
            }
            asm volatile("" ::: "memory");
            f32x16 Vn[2];
#pragma unroll
            for (int i = 0; i < 16; ++i) { Vn[0][i] = 0.f; Vn[1][i] = 0.f; }
#pragma unroll
            for (int kc = 0; kc < 4; ++kc) {
                if (kc < 2) { const bf16x8 a0 = *(const LDSP bf16x8*)(BT + swz128(r, 2 * kc + hh)); Vn[0] = MFMA32(a0, Yb[kc >> 1][kc & 1], Vn[0]); }
                const bf16x8 a1 = *(const LDSP bf16x8*)(BT + swz128(32 + r, 2 * kc + hh)); Vn[1] = MFMA32(a1, Yb[kc >> 1][kc & 1], Vn[1]);
            }
            asm volatile("" ::: "memory");
            bf16x8 Vnb[2][2], Vsb[2][2];
#pragma unroll
            for (int pt = 0; pt < 2; ++pt) {
                unsigned np[8], sp[8];
#pragma unroll
                for (int g4 = 0; g4 < 4; ++g4) { const int j0 = 32 * pt + 8 * g4 + 4 * hh; const f32x4 gj = *(const LDSP f32x4*)(tg + j0);
                    float et[4];
#pragma unroll
                    for (int e = 0; e < 4; ++e) et[e] = __expf(gl_last - gj[e]);
                    np[2 * g4] = pk_bf16(Vn[pt][4 * g4], Vn[pt][4 * g4 + 1]); np[2 * g4 + 1] = pk_bf16(Vn[pt][4 * g4 + 2], Vn[pt][4 * g4 + 3]);
                    sp[2 * g4] = pk_bf16(Vn[pt][4 * g4] * et[0], Vn[pt][4 * g4 + 1] * et[1]); sp[2 * g4 + 1] = pk_bf16(Vn[pt][4 * g4 + 2] * et[2], Vn[pt][4 * g4 + 3] * et[3]); }
#pragma unroll
                for (int s = 0; s < 2; ++s) { u32x4_t a4, b4; a4.x = np[4 * s]; a4.y = np[4 * s + 1]; a4.z = np[4 * s + 2]; a4.w = np[4 * s + 3]; b4.x = sp[4 * s]; b4.y = sp[4 * s + 1]; b4.z = sp[4 * s + 2]; b4.w = sp[4 * s + 3];
                    Vnb[pt][s] = __builtin_bit_cast(bf16x8, a4); Vsb[pt][s] = __builtin_bit_cast(bf16x8, b4); }
            }
            asm volatile("" ::: "memory");
            f32x16 O[2];
#pragma unroll
            for (int i = 0; i < 16; ++i) { O[0][i] = 0.f; O[1][i] = 0.f; }
#pragma unroll
            for (int kc = 0; kc < 8; ++kc) {
                const bf16x8 a0 = *(const LDSP bf16x8*)(Bqn + swz256(r, 2 * kc + hh)), a1 = *(const LDSP bf16x8*)(Bqn + swz256(32 + r, 2 * kc + hh));
                const bf16x8 sb = SCAN_SB(kc); O[0] = MFMA32(a0, sb, O[0]); O[1] = MFMA32(a1, sb, O[1]);
            }
#pragma unroll
            for (int pt = 0; pt < 2; ++pt)
#pragma unroll
                for (int g4 = 0; g4 < 4; ++g4) { const int j0 = 32 * pt + 8 * g4 + 4 * hh; const f32x4 gj = *(const LDSP f32x4*)(tg + j0);
#pragma unroll
                    for (int e = 0; e < 4; ++e) O[pt][4 * g4 + e] *= __expf(gj[e]); }
#pragma unroll
            for (int kc = 0; kc < 4; ++kc) {
                if (kc < 2) { const bf16x8 a0 = *(const LDSP bf16x8*)(Bat + swz128(r, 2 * kc + hh)); O[0] = MFMA32(a0, Vnb[kc >> 1][kc & 1], O[0]); }
                const bf16x8 a1 = *(const LDSP bf16x8*)(Bat + swz128(32 + r, 2 * kc + hh)); O[1] = MFMA32(a1, Vnb[kc >> 1][kc & 1], O[1]);
            }
#pragma unroll
            for (int pt = 0; pt < 2; ++pt)
#pragma unroll
                for (int g = 0; g < 2; ++g) { u32x4_t o; o.x = pk_bf16(O[pt][8 * g], O[pt][8 * g + 1]); o.y = pk_bf16(O[pt][8 * g + 2], O[pt][8 * g + 3]); o.z = pk_bf16(O[pt][8 * g + 4], O[pt][8 * g + 5]); o.w = pk_bf16(O[pt][8 * g + 6], O[pt][8 * g + 7]);
                    *(u32x4_t*)(oimg + (((((size_t)chunk * 4 + w) * 2 + pt) * 2 + g) * 64 + lane) * 8) = o; }
            if (n + 1 < 64) {
#pragma unroll
                for (int pt = 0; pt < 2; ++pt)
#pragma unroll
                    for (int g = 0; g < 2; ++g) vr[pt][g] = *(const u32x4_t*)(vimg + ((((((size_t)chunk + 1) * 4 + w) * 2 + pt) * 2 + g) * 64 + lane) * 8);
            }
            asm volatile("" ::: "memory");
            const float glf = __expf(gl_last);
#pragma unroll
            for (int dt = 0; dt < 4; ++dt) {
#pragma unroll
                for (int i = 0; i < 16; ++i) S[dt][i] *= glf;
#pragma unroll
                for (int kc = 0; kc < 4; ++kc) { const bf16x8 a = *(const LDSP bf16x8*)(BknT + swz128(32 * dt + r, 2 * kc + hh)); S[dt] = MFMA32(a, Vsb[kc >> 1][kc & 1], S[dt]); }
            }
        }
        asm volatile("s_waitcnt vmcnt(0)" ::: "memory");
        __syncthreads();
    }
}

__device__ void phase_mix(const Params& p) {
    const bf16_t* odn = (const bf16_t*)(p.ws + OFF_ODN); const bf16_t* zs = (const bf16_t*)(p.ws + OFF_Z); const bf16_t* gate = (const bf16_t*)(p.ws + OFF_GATE);
    const bf16_t* attp = (const bf16_t*)(p.ws + OFF_ATTP); const float* lse = (const float*)(p.ws + OFF_LSE);
    bf16_t* mixed = (bf16_t*)(p.ws + OFF_MIXED);
    const int tid = opaque_tid(), lane = tid & 63, wpb = blockDim.x >> 6, gw = blockIdx.x * wpb + (tid >> 6), nw = gridDim.x * wpb;
    for (int item = gw; item < MROWS * 12; item += nw) {
        const int row = item / 12, j = item % 12, b = row / SEQ, t = row % SEQ;
        if (j < 4) {
            const int h = j, chunk = (b * 4 + h) * 64 + (t >> 6);
            const float v0 = bf2f(odn[vimg_index(chunk, t & 63, lane)]), v1 = bf2f(odn[vimg_index(chunk, t & 63, 64 + lane)]);
            const float rstd = rsqrtf(wave_sum(v0 * v0 + v1 * v1) * (1.0f / 128.f) + EPS);
            const float z0 = bf2f(zs[(size_t)row * 512 + h * 128 + lane]), z1 = bf2f(zs[(size_t)row * 512 + h * 128 + 64 + lane]);
            mixed[(size_t)row * DM + h * 128 + lane] = f2bf(v0 * rstd * p.dn_norm_w[lane] * z0);
            mixed[(size_t)row * DM + h * 128 + 64 + lane] = f2bf(v1 * rstd * p.dn_norm_w[64 + lane] * z1);
        } else {
            const int h = j - 4; const size_t q = (size_t)(b * 8 + h) * SEQ + t, PS = (size_t)MROWS * 8;
            const float l0 = lse[q], l1 = lse[PS + q], l2 = lse[2 * PS + q], mx = fmaxf(l0, fmaxf(l1, l2));
            const float w0 = __expf(l0 - mx), w1 = __expf(l1 - mx), w2 = __expf(l2 - mx);
            const float o = (w0 * bf2f(attp[q * 64 + lane]) + w1 * bf2f(attp[(PS + q) * 64 + lane]) + w2 * bf2f(attp[(2 * PS + q) * 64 + lane])) / (w0 + w1 + w2);
            mixed[(size_t)row * DM + 512 + h * 64 + lane] = f2bf(o * bf2f(gate[(size_t)row * 512 + h * 64 + lane]));
        }
    }
}

__device__ __forceinline__ int t5_bucket_dev(int d) {
    if (d < 16) return d;
    int bkt = 16;
    const int bnd[15] = {22, 30, 40, 54, 73, 99, 134, 182, 246, 332, 450, 609, 825, 1117, 1513};
#pragma unroll
    for (int i = 0; i < 15; ++i) bkt += (d >= bnd[i]) ? 1 : 0;
    return bkt;
}
constexpr int ATT_UNITS = NB * 8 * 48, ATT_VBYTES = 384 * 128, ATT_TAB = ATT_VBYTES + 1024;
typedef short s16x4_t __attribute__((ext_vector_type(4)));
__device__ void phase_attn(const Params& p, unsigned char* smem, int vb, int vg) {
    const bf16_t* aq = (const bf16_t*)(p.ws + OFF_AQ); const bf16_t* ak = (const bf16_t*)(p.ws + OFF_AK); const unsigned char* avb = p.ws + OFF_AV;
    const int tid = opaque_tid(), w = __builtin_amdgcn_readfirstlane(tid >> 6);
    LDSP unsigned char* lds = (LDSP unsigned char*)smem; LDSP float* btab = (LDSP float*)(lds + ATT_TAB);
    for (int unit = vb; unit < ATT_UNITS; unit += vg) {
        int lane = tid; asm volatile("" : "+v"(lane)); lane &= 63;
        const int r = lane & 31, hh = lane >> 5, blk16 = (lane >> 4) & 1, q4 = (lane & 15) >> 2, pp = lane & 3;
        const int bh = unit / 48, u = unit % 48, pat = u >> 4, v = u & 15, h = bh & 7;
        const int rd = pat == 0 ? 1 : (pat == 1 ? 4 : 16), res = pat == 0 ? 0 : (pat == 1 ? (v >> 2) : v), M0 = (pat == 0 ? v : (pat == 1 ? (v & 3) : 0)) * 256;
        const size_t hb = (size_t)bh * SEQ;
        __syncthreads();
        if (tid < 129) btab[tid] = p.rel_bias[h * 32 + t5_bucket_dev(tid * rd)];
#pragma unroll
        for (int i = 0; i < 6; ++i) {
            const int k = w * 6 + i, sl = k * 64 + lane, row = sl >> 3, ch = (sl & 7) ^ (((row >> 1) & 1) << 2);
            int mk = M0 - 128 + row; mk = mk < 0 ? 0 : mk;
            __builtin_amdgcn_global_load_lds((const unsigned*)(avb + (hb + (size_t)(mk * rd + res)) * 128 + ch * 16), (LDSP unsigned*)(lds + k * 1024), 16, 0, 0);
        }
        const int mq = M0 + 32 * w + r; const size_t tq = hb + (size_t)(mq * rd + res);
        bf16x8 qf[4];
#pragma unroll
        for (int s = 0; s < 4; ++s) qf[s] = *(const bf16x8*)(aq + tq * 64 + 16 * s + 8 * hh);
        f32x16 Sc[5];
        bf16x8 kf[2][4];
#define ATT_LOADK(kt_, dst) do { int mk_ = M0 + 32 * w - 128 + 32 * (kt_) + r; mk_ = mk_ < 0 ? 0 : mk_; const bf16_t* kp_ = ak + (hb + (size_t)(mk_ * rd + res)) * 64 + 8 * hh; \
        _Pragma("unroll") for (int s = 0; s < 4; ++s) dst[s] = *(const bf16x8*)(kp_ + 16 * s); } while (0)
        ATT_LOADK(0, kf[0]);
#pragma unroll
        for (int kt = 0; kt < 5; ++kt) {
            if (kt < 4) ATT_LOADK(kt + 1, kf[(kt + 1) & 1]);
            asm volatile("" ::: "memory");
#pragma unroll
            for (int i = 0; i < 16; ++i) Sc[kt][i] = 0.f;
#pragma unroll
            for (int s = 0; s < 4; ++s) Sc[kt] = MFMA32(kf[kt & 1][s], qf[s], Sc[kt]);
        }
#undef ATT_LOADK
        asm volatile("s_waitcnt vmcnt(0)" ::: "memory");
        __syncthreads();
        const int jb = 128 + r - 4 * hh, kb0 = M0 + 32 * w - 128 + 4 * hh;
        float mx = -INFINITY;
#pragma unroll
        for (int kt = 0; kt < 5; ++kt) {
            asm volatile("" ::: "memory");
#pragma unroll
            for (int i = 0; i < 16; ++i) { const int dj = 32 * kt + 8 * (i >> 2) + (i & 3), j = jb - dj;
                const bool ok = (j >= 0) && (j <= 128) && (kb0 + dj >= 0);
                const float sc = ok ? Sc[kt][i] + btab[j] : -INFINITY; Sc[kt][i] = sc; mx = fmaxf(mx, sc); }
        }
        mx = fmaxf(mx, __shfl_xor(mx, 32));
        float lsum = 0.f;
#pragma unroll
        for (int kt = 0; kt < 5; ++kt)
#pragma unroll
            for (int i = 0; i < 16; ++i) { const float e = __expf(Sc[kt][i] - mx); Sc[kt][i] = e; lsum += e; }
        lsum += __shfl_xor(lsum, 32);
        f32x16 O[2];
#pragma unroll
        for (int i = 0; i < 16; ++i) { O[0][i] = 0.f; O[1][i] = 0.f; }
        const int xb = (q4 >> 1) & 1;
        LDSP unsigned char* vl0 = lds + (32 * w + 4 * hh + q4) * 128 + ((2 * blk16 + (pp >> 1)) + 4 * xb) * 16 + 8 * (pp & 1);
        LDSP unsigned char* vl1 = lds + (32 * w + 4 * hh + q4) * 128 + ((2 * blk16 + (pp >> 1)) + 4 * (xb ^ 1)) * 16 + 8 * (pp & 1);
#pragma unroll
        for (int kt = 0; kt < 5; ++kt)
#pragma unroll
            for (int s2 = 0; s2 < 2; ++s2) {
                asm volatile("" ::: "memory");
                u32x4_t pk; pk.x = pk_bf16(Sc[kt][8 * s2], Sc[kt][8 * s2 + 1]); pk.y = pk_bf16(Sc[kt][8 * s2 + 2], Sc[kt][8 * s2 + 3]); pk.z = pk_bf16(Sc[kt][8 * s2 + 4], Sc[kt][8 * s2 + 5]); pk.w = pk_bf16(Sc[kt][8 * s2 + 6], Sc[kt][8 * s2 + 7]);
                const bf16x8 pb = __builtin_bit_cast(bf16x8, pk);
                const int ro = (32 * kt + 16 * s2) * 128;
                const s16x4_t a0l = __builtin_amdgcn_ds_read_tr16_b64_v4i16((LDSP s16x4_t*)(vl0 + ro)), a0h = __builtin_amdgcn_ds_read_tr16_b64_v4i16((LDSP s16x4_t*)(vl0 + ro + 8 * 128));
                const s16x4_t a1l = __builtin_amdgcn_ds_read_tr16_b64_v4i16((LDSP s16x4_t*)(vl1 + ro)), a1h = __builtin_amdgcn_ds_read_tr16_b64_v4i16((LDSP s16x4_t*)(vl1 + ro + 8 * 128));
                O[0] = MFMA32(__builtin_shufflevector(a0l, a0h, 0, 1, 2, 3, 4, 5, 6, 7), pb, O[0]);
                O[1] = MFMA32(__builtin_shufflevector(a1l, a1h, 0, 1, 2, 3, 4, 5, 6, 7), pb, O[1]);
            }
        const float inv = 1.0f / lsum;
        bf16_t* op = (bf16_t*)(p.ws + OFF_ATTP) + ((size_t)pat * MROWS * 8 + tq) * 64;
#pragma unroll
        for (int dt = 0; dt < 2; ++dt)
#pragma unroll
            for (int g4 = 0; g4 < 4; ++g4) { u32x2_t o; o.x = pk_bf16(O[dt][4 * g4] * inv, O[dt][4 * g4 + 1] * inv); o.y = pk_bf16(O[dt][4 * g4 + 2] * inv, O[dt][4 * g4 + 3] * inv);
                *(u32x2_t*)(op + 32 * dt + 8 * g4 + 4 * hh) = o; }
        if (hh == 0) ((float*)(p.ws + OFF_LSE))[(size_t)pat * MROWS * 8 + tq] = mx + __logf(lsum);
    }
}

constexpr int NTHREADS = 512;
constexpr size_t DYN_LDS = 147456;
constexpr int SCAN_BLOCKS = 32;
__global__ void __launch_bounds__(NTHREADS, 2) fwd_mega(Params p) {
    cg::grid_group grid = cg::this_grid();
    extern __shared__ __attribute__((aligned(16))) unsigned char smem[];
    float* smf = (float*)smem;
    phase_weights(p);
    phase_norm(p, smf);
    grid.sync();
    { pg8::Gemm g{(const bf16_t*)(p.ws + OFF_XN), (const bf16_t*)(p.ws + OFF_WTIN), MROWS, NPK, DM}; pg8::StaticOrder S; S.init(MROWS, NPK, (int)gridDim.x, (int)blockIdx.x);
      EpiProjSplit E{p.ws, p.q_norm_w, p.k_norm_w};
      pg8::gemm_phase<EpiProjSplit, pg8::StaticOrder, true, true>((PG8_LAS unsigned char*)smem, g, S, E); }
    grid.sync();
    phase_dn_prep(p);
    grid.sync();
    phase_dn_chunk(p, smem);
    grid.sync();
    if ((int)blockIdx.x < SCAN_BLOCKS) phase_dn_scan(p, smem, blockIdx.x);
    else phase_attn(p, smem, blockIdx.x - SCAN_BLOCKS, gridDim.x - SCAN_BLOCKS);
    grid.sync();
    phase_mix(p);
    grid.sync();
    { pg8::Gemm g{(const bf16_t*)(p.ws + OFF_MIXED), (const bf16_t*)(p.ws + OFF_WTOUT), MROWS, DM, DM}; pg8::StaticOrder S; S.init(MROWS, DM, (int)gridDim.x, (int)blockIdx.x);
      EpiOutRes E{p.x, p.out}; pg8::gemm_phase<EpiOutRes, pg8::StaticOrder, true, true>((PG8_LAS unsigned char*)smem, g, S, E); }
}

extern "C" void kernel_launch(void* const* d_in, const int* in_sizes, int n_in, void* d_out, int out_size, void* d_ws, size_t ws_size, hipStream_t stream) {
    (void)in_sizes; (void)n_in; (void)out_size;
    if (ws_size < WS_NEED) { fprintf(stderr, "workspace too small: %zu < %zu\n", ws_size, (size_t)WS_NEED); return; }
    static int grid_blocks = 0;
    if (!grid_blocks) {
        int dev = 0, cus = 0, per_cu = 0;
        (void)hipGetDevice(&dev);
        (void)hipDeviceGetAttribute(&cus, hipDeviceAttributeMultiprocessorCount, dev);
        (void)hipFuncSetAttribute((const void*)fwd_mega, hipFuncAttributeMaxDynamicSharedMemorySize, (int)DYN_LDS);
        (void)hipOccupancyMaxActiveBlocksPerMultiprocessor(&per_cu, fwd_mega, NTHREADS, DYN_LDS);
        if (per_cu > 1) per_cu = 1;
        grid_blocks = cus * per_cu;
        if (grid_blocks <= SCAN_BLOCKS) fprintf(stderr, "grid too small: %d\n", grid_blocks);
    }
    Params p{};
    p.x = (const float*)d_in[0]; p.norm_w = (const float*)d_in[1]; p.w_in = (const float*)d_in[2]; p.conv_w = (const float*)d_in[3]; p.a_log = (const float*)d_in[4];
    p.dt_bias = (const float*)d_in[5]; p.dn_norm_w = (const float*)d_in[6]; p.q_norm_w = (const float*)d_in[7]; p.k_norm_w = (const float*)d_in[8]; p.rel_bias = (const float*)d_in[9];
    p.w_out = (const float*)d_in[10]; p.out = (float*)d_out; p.ws = (unsigned char*)d_ws;
    void* args[] = {&p};
    hipError_t e = hipLaunchCooperativeKernel((const void*)fwd_mega, dim3(grid_blocks), dim3(NTHREADS), args, DYN_LDS, stream);
    if (e != hipSuccess) fprintf(stderr, "cooperative launch failed: %s (grid %d)\n", hipGetErrorString(e), grid_blocks);
}
```

```cpp
#include <hip/hip_runtime.h>
#include <hip/hip_cooperative_groups.h>
#include <cstdint>
#include <cstdio>
namespace cg = cooperative_groups;

typedef unsigned short bf16_t;
typedef short bf16x8 __attribute__((ext_vector_type(8)));
typedef float f32x4 __attribute__((ext_vector_type(4)));
typedef float f32x16 __attribute__((ext_vector_type(16)));
typedef unsigned u32x4_t __attribute__((ext_vector_type(4)));
typedef unsigned u32x2_t __attribute__((ext_vector_type(2)));
typedef __bf16 bf16x2_t __attribute__((ext_vector_type(2)));
typedef float f32x2_t __attribute__((ext_vector_type(2)));
#define LDSP __attribute__((address_space(3)))

constexpr int NB = 8, SEQ = 4096, DM = 1024, MROWS = NB * SEQ;
constexpr int DIN = 4104, NPK = 4096;
constexpr int ATH = 8;
constexpr float EPS = 1e-6f;
constexpr size_t MiB = (size_t)1 << 20;

constexpr size_t OFF_R0 = 0;
constexpr size_t OFF_XN = OFF_R0, OFF_DNQ = OFF_R0, OFF_DNK = OFF_R0 + 32 * MiB, OFF_MIXED = OFF_R0;
constexpr size_t OFF_WTIN = 64 * MiB;
constexpr size_t OFF_WTOUT = 72 * MiB;
constexpr size_t OFF_BETA = 74 * MiB;
constexpr size_t OFF_G = OFF_BETA + MiB / 2;
constexpr size_t OFF_GCUM = 75 * MiB;
constexpr size_t OFF_BAR = 75 * MiB + MiB / 2;
constexpr size_t OFF_R3 = 76 * MiB;
constexpr size_t OFF_PROJDN = OFF_R3, OFF_ATTP = OFF_R3  , OFF_LSE = OFF_R3 + 96 * MiB  ;
constexpr size_t OFF_Z = 176 * MiB;
constexpr size_t OFF_AQ = 208 * MiB;
constexpr size_t OFF_AK = 240 * MiB;
constexpr size_t OFF_AV = 272 * MiB;
constexpr size_t OFF_GATE = 304 * MiB;
constexpr size_t OFF_KNT = 336 * MiB;
constexpr size_t OFF_VIMG = 368 * MiB;
constexpr size_t OFF_T = 400 * MiB;
constexpr size_t OFF_ATTN = 416 * MiB;
constexpr size_t OFF_ODN = 432 * MiB;
constexpr size_t WS_NEED = 464 * MiB;

__device__ __forceinline__ bf16_t f2bf(float f) { unsigned u = __float_as_uint(f); u += 0x7FFFu + ((u >> 16) & 1u); return (bf16_t)(u >> 16); }
__device__ __forceinline__ float bf2f(bf16_t b) { return __uint_as_float(((unsigned)b) << 16); }
__device__ __forceinline__ float wave_sum(float v) {
#pragma unroll
    for (int o = 32; o >= 1; o >>= 1) v += __shfl_xor(v, o);
    return v;
}
__device__ __forceinline__ float wave_max(float v) {
#pragma unroll
    for (int o = 32; o >= 1; o >>= 1) v = fmaxf(v, __shfl_xor(v, o));
    return v;
}
__device__ __forceinline__ float silu_f(float y) { return y / (1.0f + __expf(-y)); }
__device__ __forceinline__ unsigned pk_bf16(float lo, float hi) { f32x2_t v = {lo, hi}; return __builtin_bit_cast(unsigned, __builtin_convertvector(v, bf16x2_t)); }
__device__ __forceinline__ float bflo(unsigned u) { return __uint_as_float(u << 16); }
__device__ __forceinline__ float bfhi(unsigned u) { return __uint_as_float(u & 0xFFFF0000u); }
__host__ __device__ __forceinline__ int crow(int i, int hh) { return (i & 3) + 8 * (i >> 2) + 4 * hh; }
__host__ __device__ __forceinline__ int perm16(int x) { return (x & ~12) | ((x & 4) << 1) | ((x & 8) >> 1); }
#define MFMA32(a, b, c) __builtin_amdgcn_mfma_f32_32x32x16_bf16((a), (b), (c), 0, 0, 0)
__host__ __device__ __forceinline__ size_t vimg_index(int chunk, int pos, int dv) {
    const int wsl = dv >> 5, cl = dv & 31, pt = pos >> 5, pr = pos & 31, i = 4 * (pr >> 3) + (pr & 3), hs = (pr >> 2) & 1;
    return (((((size_t)chunk * 4 + wsl) * 2 + pt) * 2 + (i >> 3)) * 64 + cl + 32 * hs) * 8 + (i & 7);
}

__device__ __forceinline__ int opaque_tid() { int t = threadIdx.x; asm volatile("" : "+v"(t)); return t & 511; }
__device__ __forceinline__ unsigned char* opaque_ptr(unsigned char* q) { asm volatile("" : "+s"(q)); return q; }
struct Params {
    const float* x; const float* norm_w; const float* w_in; const float* conv_w; const float* a_log; const float* dt_bias;
    const float* dn_norm_w; const float* q_norm_w; const float* k_norm_w; const float* rel_bias; const float* w_out;
    float* out; unsigned char* ws;
};

namespace pg8 {
#define PG8_LAS __attribute__((address_space(3)))
typedef unsigned short bf16_t;
typedef short bf16x8 __attribute__((ext_vector_type(8)));
typedef float f32x4 __attribute__((ext_vector_type(4)));
typedef unsigned u32x4 __attribute__((ext_vector_type(4)));
constexpr int BM = 256, BK = 64, HALF = 128, HTB = HALF * BK * 2  , STAGE_BYTES = 8 * HTB, NXCD = 8, WGM = 8;

__host__ __device__ __forceinline__ int lds_byte(int r, int c) { const int st = (r >> 4) * 2 + (c >> 5), rr = r & 15, cc = c & 31, ob = rr * 64 + cc * 2; return st * 1024 + (ob ^ (((ob >> 9) & 1) << 5)); }
__host__ __device__ __forceinline__ void stage_rc(int b, int& R, int& C) { const int st = b / 1024, sb = b % 1024, swz = sb ^ (((sb >> 9) & 1) << 5); R = (st >> 1) * 16 + swz / 64; C = (st & 1) * 32 + (swz % 64) / 2; }
__host__ __device__ __forceinline__ int perm32(int rho) { const int n = rho >> 4, i = rho & 15; return 8 * (i >> 2) + 4 * n + (i & 3); }

struct Unit { int pm, pn; };
struct Gemm { const bf16_t* A; const bf16_t* Bt; int M, N, K; };

struct StaticOrder {
    int nM, nN, nwg, G, c;
    __host__ __device__ void init(int M, int N, int G_, int c_) { nM = M / BM; nN = N / BM; nwg = nM * nN; G = G_; c = c_; }
    __host__ __device__ bool next(int i, Unit& u) const {
        const long L = (long)i * G + c; if (L >= nwg) return false;
        int wgid = (int)L; { const int q = nwg / NXCD, r = nwg % NXCD, xcd = wgid % NXCD, off = wgid / NXCD; wgid = (xcd < r ? xcd * (q + 1) : r * (q + 1) + (xcd - r) * q) + off; }
        const int nig = WGM * nN, gid = wgid / nig, fm = gid * WGM, gsz = (nM - fm) < WGM ? (nM - fm) : WGM;
        u.pm = fm + ((wgid % nig) % gsz); u.pn = (wgid % nig) / gsz; return true;
    }
    __device__ __forceinline__ void a_ready(const Unit&) const {}
    __device__ __forceinline__ void done(const Unit&) const {}
};

__device__ __forceinline__ unsigned cvt_pk_bf16(float lo, float hi) { unsigned r; asm volatile("v_cvt_pk_bf16_f32 %0, %1, %2" : "=v"(r) : "v"(lo), "v"(hi)); return r; }
typedef float f32x2 __attribute__((ext_vector_type(2)));
template <class Epi, class Sched, bool ALIGN_EPI = false, bool SP2 = false>
__device__ __forceinline__ void gemm_phase(PG8_LAS unsigned char* lds, const Gemm g, const Sched& S, const Epi& E) {
    const int tid = opaque_tid(), wid = __builtin_amdgcn_readfirstlane(tid >> 6), lane = tid & 63, wr = wid >> 2, wc = wid & 3, fr = lane & 15, fq = lane >> 4;
    const int K = g.K, nt = K / BK;
    unsigned voffA[2], voffB[2];
#pragma unroll
    for (int i = 0; i < 2; ++i) { int R, C; stage_rc(tid * 16 + i * 8192, R, C); const int Rb = Epi::PERM ? ((R & ~31) + perm32(R & 31)) : R;
        voffA[i] = (unsigned)(R * K + C) * 2u; voffB[i] = (unsigned)(Rb * K + C) * 2u; }
    const size_t kstep = (size_t)(BK * 2);
    const size_t hstep = (size_t)HALF * K * 2;
    const size_t tstep = 2 * hstep;
    const unsigned ldsw = (unsigned)wid * 1024u;
    const int aoff = lds_byte(wr * 64 + fr, fq * 8), boff = lds_byte(wc * 32 + fr, fq * 8);
#define PG8_SA(b, h) (((b) * 2 + (h)) * HTB)
#define PG8_SB(b, h) ((4 + (b) * 2 + (h)) * HTB)
#define PG8_STAGE(bufoff, gbase, voff) do { _Pragma("unroll") for (int _i = 0; _i < 2; ++_i) \
        __builtin_amdgcn_global_load_lds((const unsigned*)((const char*)(gbase) + (voff)[_i]), (PG8_LAS unsigned*)(lds + (bufoff) + ldsw + _i * 8192), 16, 0, 0); } while (0)
#define PG8_LDA(dst, b, h) do { _Pragma("unroll") for (int m = 0; m < 4; ++m) _Pragma("unroll") for (int k = 0; k < 2; ++k) dst[m][k] = *(const PG8_LAS bf16x8*)(lds + PG8_SA(b, h) + aoff + m * 2048 + k * 1024); } while (0)
#define PG8_LDB(dst, b, h) do { _Pragma("unroll") for (int n = 0; n < 2; ++n) _Pragma("unroll") for (int k = 0; k < 2; ++k) dst[n][k] = *(const PG8_LAS bf16x8*)(lds + PG8_SB(b, h) + boff + n * 2048 + k * 1024); } while (0)
#define PG8_MMA(ai, bj, At, Bt) do { __builtin_amdgcn_s_setprio(1); _Pragma("unroll") for (int m = 0; m < 4; ++m) _Pragma("unroll") for (int n = 0; n < 2; ++n) _Pragma("unroll") for (int k = 0; k < 2; ++k) \
        acc[ai][bj][m][n] = __builtin_amdgcn_mfma_f32_16x16x32_bf16(Bt[n][k], At[m][k], acc[ai][bj][m][n], 0, 0, 0); __builtin_amdgcn_s_setprio(0); } while (0)
#define PG8_WAIT_V(n) asm volatile("s_waitcnt vmcnt(" #n ")" ::: "memory")
#define PG8_WAIT_L(n) asm volatile("s_waitcnt lgkmcnt(" #n ")" ::: "memory")
#define PG8_BAR __builtin_amdgcn_s_barrier()
#define PG8_SCHED __builtin_amdgcn_sched_barrier(0)
    Unit cur, nxt; int ui = 0;
    if (!S.next(0, cur)) return;
    f32x4 acc[2][2][4][2];
#pragma unroll
    for (int a = 0; a < 2; ++a)
#pragma unroll
        for (int b = 0; b < 2; ++b)
#pragma unroll
            for (int m = 0; m < 4; ++m)
#pragma unroll
                for (int n = 0; n < 2; ++n) acc[a][b][m][n] = (f32x4){0.f, 0.f, 0.f, 0.f};
    bf16x8 At[4][2], B0[2][2], B1[2][2];
    const char* cA = (const char*)g.A + (size_t)cur.pm * tstep; const char* cB = (const char*)g.Bt + (size_t)cur.pn * tstep;
    S.a_ready(cur);
    if constexpr (SP2) {
        PG8_STAGE(PG8_SB(0, 0), cB, voffB); PG8_STAGE(PG8_SB(0, 1), cB + hstep, voffB); PG8_STAGE(PG8_SA(0, 0), cA, voffA); PG8_STAGE(PG8_SA(0, 1), cA + hstep, voffA);
        if (wr == 1) PG8_BAR;
        PG8_WAIT_V(2); PG8_BAR;
        PG8_STAGE(PG8_SB(1, 0), cB + kstep, voffB); PG8_STAGE(PG8_SA(1, 0), cA + kstep, voffA); PG8_STAGE(PG8_SB(1, 1), cB + hstep + kstep, voffB);
        PG8_WAIT_V(6); PG8_BAR;
    } else {
        PG8_STAGE(PG8_SB(0, 0), cB, voffB); PG8_STAGE(PG8_SA(0, 0), cA, voffA); PG8_STAGE(PG8_SB(0, 1), cB + hstep, voffB); PG8_STAGE(PG8_SA(0, 1), cA + hstep, voffA);
        if (wr == 1) PG8_BAR;
        PG8_WAIT_V(4); PG8_BAR;
        PG8_STAGE(PG8_SB(1, 0), cB + kstep, voffB); PG8_STAGE(PG8_SA(1, 0), cA + kstep, voffA); PG8_STAGE(PG8_SB(1, 1), cB + hstep + kstep, voffB);
        PG8_WAIT_V(6); PG8_BAR;
    }
    for (;;) {
        const bool has_next = S.next(ui + 1, nxt);
        const char* nA = has_next ? (const char*)g.A + (size_t)nxt.pm * tstep : cA; const char* nB = has_next ? (const char*)g.Bt + (size_t)nxt.pn * tstep : cB;
        for (int t = 0; t < nt; t += 2) {
            const bool last = (t == nt - 2);
            const char* a1 = cA + (size_t)(t + 1) * kstep;
            const char* a2 = last ? nA : cA + (size_t)(t + 2) * kstep; const char* b2 = last ? nB : cB + (size_t)(t + 2) * kstep;
            const char* a3 = a2 + kstep; const char* b3 = b2 + kstep;
            if (last && has_next) S.a_ready(nxt);
            if constexpr (SP2) {
            PG8_LDB(B0, 0, 0); PG8_LDB(B1, 0, 1); PG8_SCHED; PG8_LDA(At, 0, 0); PG8_STAGE(PG8_SA(1, 1), a1 + hstep, voffA);
            PG8_WAIT_V(8); PG8_WAIT_L(0); PG8_BAR; PG8_MMA(0, 0, At, B0); PG8_MMA(0, 1, At, B1); PG8_BAR; PG8_SCHED;
            PG8_LDA(At, 0, 1); PG8_STAGE(PG8_SB(0, 0), b2, voffB); PG8_STAGE(PG8_SB(0, 1), b2 + hstep, voffB); PG8_STAGE(PG8_SA(0, 0), a2, voffA);
            PG8_WAIT_V(8); PG8_WAIT_L(0); PG8_BAR; PG8_MMA(1, 0, At, B0); PG8_MMA(1, 1, At, B1); PG8_BAR; PG8_SCHED;
            PG8_LDB(B0, 1, 0); PG8_LDB(B1, 1, 1); PG8_SCHED; PG8_LDA(At, 1, 0); PG8_STAGE(PG8_SA(0, 1), a2 + hstep, voffA);
            PG8_WAIT_V(8); PG8_WAIT_L(0); PG8_BAR; PG8_MMA(0, 0, At, B0); PG8_MMA(0, 1, At, B1); PG8_BAR; PG8_SCHED;
            PG8_LDA(At, 1, 1); PG8_STAGE(PG8_SB(1, 0), b3, voffB); PG8_STAGE(PG8_SB(1, 1), b3 + hstep, voffB); PG8_STAGE(PG8_SA(1, 0), a3, voffA);
            PG8_WAIT_V(8); PG8_WAIT_L(0); PG8_BAR; PG8_MMA(1, 0, At, B0); PG8_MMA(1, 1, At, B1); PG8_BAR; PG8_SCHED;
            } else {
            PG8_LDB(B0, 0, 0); PG8_SCHED; PG8_LDA(At, 0, 0); PG8_STAGE(PG8_SA(1, 1), a1 + hstep, voffA);
            PG8_WAIT_L(8); PG8_BAR; PG8_WAIT_L(0); PG8_MMA(0, 0, At, B0); PG8_BAR; PG8_SCHED;
            PG8_LDB(B1, 0, 1); PG8_STAGE(PG8_SB(0, 0), b2, voffB);
            PG8_BAR; PG8_WAIT_L(0); PG8_MMA(0, 1, At, B1); PG8_BAR;
            PG8_LDA(At, 0, 1); PG8_STAGE(PG8_SA(0, 0), a2, voffA);
            PG8_BAR; PG8_WAIT_L(0); PG8_MMA(1, 0, At, B0); PG8_BAR; PG8_SCHED;
            PG8_STAGE(PG8_SB(0, 1), b2 + hstep, voffB);
            PG8_WAIT_V(6); PG8_BAR; PG8_MMA(1, 1, At, B1); PG8_BAR;
            PG8_LDB(B0, 1, 0); PG8_SCHED; PG8_LDA(At, 1, 0); PG8_STAGE(PG8_SA(0, 1), a2 + hstep, voffA);
            PG8_WAIT_L(8); PG8_BAR; PG8_WAIT_L(0); PG8_MMA(0, 0, At, B0); PG8_BAR; PG8_SCHED;
            PG8_LDB(B1, 1, 1); PG8_STAGE(PG8_SB(1, 0), b3, voffB);
            PG8_BAR; PG8_WAIT_L(0); PG8_MMA(0, 1, At, B1); PG8_BAR;
            PG8_LDA(At, 1, 1); PG8_STAGE(PG8_SA(1, 0), a3, voffA);
            PG8_BAR; PG8_WAIT_L(0); PG8_MMA(1, 0, At, B0); PG8_BAR; PG8_SCHED;
            PG8_STAGE(PG8_SB(1, 1), b3 + hstep, voffB);
            PG8_WAIT_V(6); PG8_BAR; PG8_MMA(1, 1, At, B1); PG8_BAR;
            }
        }
        if constexpr (ALIGN_EPI) { if (wr == 0) PG8_BAR; }
        if constexpr (!Epi::AFTER_DRAIN) { E(acc, cur, wr, wc, fr, fq); S.done(cur); }
        if (!has_next) break;
#pragma unroll
        for (int a = 0; a < 2; ++a)
#pragma unroll
            for (int b = 0; b < 2; ++b)
#pragma unroll
                for (int m = 0; m < 4; ++m)
#pragma unroll
                    for (int n = 0; n < 2; ++n) acc[a][b][m][n] = (f32x4){0.f, 0.f, 0.f, 0.f};
        cur = nxt; cA = nA; cB = nB; ++ui;
        if constexpr (ALIGN_EPI) { if (wr == 1) PG8_BAR; }
    }
    PG8_WAIT_V(0);
    if constexpr (!ALIGN_EPI) { if (wr == 0) PG8_BAR; }
    PG8_BAR;
    if constexpr (Epi::AFTER_DRAIN) { E.fused(acc, cur, wr, wc, fr, fq, lds, wid, lane); S.done(cur); }
#undef PG8_SA
#undef PG8_SB
#undef PG8_STAGE
#undef PG8_LDA
#undef PG8_LDB
#undef PG8_MMA
#undef PG8_WAIT_V
#undef PG8_WAIT_L
#undef PG8_BAR
#undef PG8_SCHED
}
}

__host__ __device__ __forceinline__ int wt_src_col(int n) {
    if (n < 2048) return n;
    if (n >= 3584) return n + 8;
    const int pn = n >> 8, vc = n & 255, bj = vc >> 7, wc = (vc >> 5) & 3, i = vc & 31;
    return 2056 + ((pn - 8) >> 1) * 512 + (4 * (pn & 1) + wc) * 64 + 32 * bj + i;
}
struct EpiProjSplit {
    static constexpr bool PERM = true, AFTER_DRAIN = false;
    unsigned char* ws; const float *qw, *kw;
    __device__ __forceinline__ static pg8::u32x4 pack8(const f32x4 v0, const f32x4 v1) { pg8::u32x4 w;
        w.x = pg8::cvt_pk_bf16(v0[0], v0[1]); w.y = pg8::cvt_pk_bf16(v0[2], v0[3]); w.z = pg8::cvt_pk_bf16(v1[0], v1[1]); w.w = pg8::cvt_pk_bf16(v1[2], v1[3]); return w; }
    __device__ __forceinline__ void operator()(const f32x4 (&acc)[2][2][4][2], const pg8::Unit& u, int wr, int wc, int fr, int fq) const {
        const int pn = u.pn, row0 = u.pm * 256 + wr * 64 + fr;
        if (pn < 8 || pn >= 14) {
            const size_t boff = pn < 6 ? OFF_PROJDN : (pn < 8 ? OFF_Z : OFF_GATE);
            const int ld = pn < 6 ? 1536 : 512, colt = pn < 6 ? pn * 256 : (pn & 1) * 256; const bool act = pn >= 6;
            bf16_t* base = (bf16_t*)(ws + boff);
            const int col0 = colt + wc * 32 + 8 * fq;
#pragma unroll
            for (int ai = 0; ai < 2; ++ai)
#pragma unroll
                for (int m = 0; m < 4; ++m) { bf16_t* rowp = base + (size_t)(row0 + ai * 128 + m * 16) * ld + col0;
#pragma unroll
                    for (int bj = 0; bj < 2; ++bj) { f32x4 v0 = acc[ai][bj][m][0], v1 = acc[ai][bj][m][1];
                        if (act) {
#pragma unroll
                            for (int e = 0; e < 4; ++e) { v0[e] = silu_f(v0[e]); v1[e] = silu_f(v1[e]); } }
                        *(pg8::u32x4*)(rowp + bj * 128) = pack8(v0, v1); } }
        } else {
            const int grp = (pn - 8) >> 1, head = 4 * (pn & 1) + wc;
            bf16_t* base = (bf16_t*)(ws + OFF_AQ + (size_t)grp * (32 * MiB));
            f32x4 wv[2][2];
            if (grp < 2) { const float* w = grp == 0 ? qw : kw; const float sc = grp == 0 ? 0.125f : 1.0f;
#pragma unroll
                for (int bj = 0; bj < 2; ++bj)
#pragma unroll
                    for (int n = 0; n < 2; ++n) wv[bj][n] = *(const f32x4*)(w + 32 * bj + 8 * fq + 4 * n) * sc; }
#pragma unroll
            for (int ai = 0; ai < 2; ++ai)
#pragma unroll
                for (int m = 0; m < 4; ++m) {
                    const int r = row0 + ai * 128 + m * 16, b = r >> 12, t = r & 4095;
                    f32x4 v[2][2];
#pragma unroll
                    for (int bj = 0; bj < 2; ++bj)
#pragma unroll
                        for (int n = 0; n < 2; ++n) v[bj][n] = acc[ai][bj][m][n];
                    if (grp < 2) {
                        float ss = 0.f;
#pragma unroll
                        for (int bj = 0; bj < 2; ++bj)
#pragma unroll
                            for (int n = 0; n < 2; ++n) ss += v[bj][n][0] * v[bj][n][0] + v[bj][n][1] * v[bj][n][1] + v[bj][n][2] * v[bj][n][2] + v[bj][n][3] * v[bj][n][3];
                        ss += __shfl_xor(ss, 16); ss += __shfl_xor(ss, 32);
                        const float rstd = rsqrtf(ss * (1.0f / 64.f) + EPS);
#pragma unroll
                        for (int bj = 0; bj < 2; ++bj)
#pragma unroll
                            for (int n = 0; n < 2; ++n) v[bj][n] = v[bj][n] * rstd * wv[bj][n];
                    }
                    bf16_t* dst = base + ((size_t)(b * 8 + head) * SEQ + t) * 64 + 8 * fq;
                    *(pg8::u32x4*)(dst) = pack8(v[0][0], v[0][1]);
                    *(pg8::u32x4*)(dst + 32) = pack8(v[1][0], v[1][1]);
                }
        }
    }
};
struct EpiOutRes {
    static constexpr bool PERM = false, AFTER_DRAIN = false;
    const float* X; float* C;
    __device__ __forceinline__ void operator()(const f32x4 (&acc)[2][2][4][2], const pg8::Unit& u, int wr, int wc, int fr, int fq) const {
        const int row0 = u.pm * 256 + wr * 64 + fr, col0 = u.pn * 256 + wc * 32 + 4 * fq;
#pragma unroll
        for (int ai = 0; ai < 2; ++ai)
#pragma unroll
            for (int m = 0; m < 4; ++m) { const size_t off = (size_t)(row0 + ai * 128 + m * 16) * DM + col0;
#pragma unroll
                for (int bj = 0; bj < 2; ++bj)
#pragma unroll
                    for (int n = 0; n < 2; ++n) { const size_t o = off + bj * 128 + n * 16; *(f32x4*)(C + o) = *(const f32x4*)(X + o) + acc[ai][bj][m][n]; } }
    }
};

__device__ void phase_weights(const Params& p) {
    bf16_t* wt_in = (bf16_t*)(p.ws + OFF_WTIN); bf16_t* wt_out = (bf16_t*)(p.ws + OFF_WTOUT);
    const size_t gt = (size_t)blockIdx.x * blockDim.x + opaque_tid(), gn = (size_t)gridDim.x * blockDim.x;
    for (size_t i = gt; i < (size_t)DM * NPK; i += gn) { const int k = (int)(i / NPK), n = (int)(i % NPK);
        wt_in[(size_t)n * DM + k] = f2bf(p.w_in[(size_t)k * DIN + wt_src_col(n)]); }
    for (size_t i = gt; i < (size_t)DM * DM; i += gn) { const int k = (int)(i / DM), n = (int)(i % DM);
        wt_out[(size_t)n * DM + k] = f2bf(p.w_out[(size_t)k * DM + n]); }
}

__device__ void phase_norm(const Params& p, float* lds_w8  ) {
    bf16_t* xn = (bf16_t*)(p.ws + OFF_XN); float* beta = (float*)(p.ws + OFF_BETA); float* gdec = (float*)(p.ws + OFF_G);
    const int tid = opaque_tid();
    for (int i = tid; i < 1024 * 8; i += blockDim.x) { const int k = i >> 3, j = i & 7; lds_w8[i] = p.w_in[(size_t)k * DIN + 2048 + j]; }
    __syncthreads();
    const int lane = tid & 63, wpb = blockDim.x >> 6, gw = blockIdx.x * wpb + (tid >> 6), nw = gridDim.x * wpb;
    f32x4 nw4[4];
#pragma unroll
    for (int i = 0; i < 4; ++i) nw4[i] = *(const f32x4*)(p.norm_w + i * 256 + lane * 4);
    for (int row = gw; row < MROWS; row += nw) {
        f32x4 xv[4]; float ss = 0.f;
#pragma unroll
        for (int i = 0; i < 4; ++i) { xv[i] = *(const f32x4*)(p.x + (size_t)row * DM + i * 256 + lane * 4); ss += xv[i][0] * xv[i][0] + xv[i][1] * xv[i][1] + xv[i][2] * xv[i][2] + xv[i][3] * xv[i][3]; }
        ss = wave_sum(ss);
        const float rstd = rsqrtf(ss * (1.0f / DM) + EPS);
        float acc[8];
#pragma unroll
        for (int j = 0; j < 8; ++j) acc[j] = 0.f;
#pragma unroll
        for (int i = 0; i < 4; ++i) {
            f32x4 h = xv[i] * rstd * nw4[i];
            uint2 pk; pk.x = (unsigned)f2bf(h[0]) | ((unsigned)f2bf(h[1]) << 16); pk.y = (unsigned)f2bf(h[2]) | ((unsigned)f2bf(h[3]) << 16);
            *(uint2*)(xn + (size_t)row * DM + i * 256 + lane * 4) = pk;
#pragma unroll
            for (int e = 0; e < 4; ++e) { const float* w8 = lds_w8 + (i * 256 + lane * 4 + e) * 8;
#pragma unroll
                for (int j = 0; j < 8; ++j) acc[j] += h[e] * w8[j]; }
        }
#pragma unroll
        for (int j = 0; j < 8; ++j) acc[j] = wave_sum(acc[j]);
        const int b = row / SEQ, s = row % SEQ;
        if (lane == 0) {
#pragma unroll
            for (int j = 0; j < 4; ++j) {
                beta[((size_t)b * 4 + j) * SEQ + s] = 1.0f / (1.0f + expf(-acc[j]));
                const float xx = acc[4 + j] + p.dt_bias[j]; const float sp = xx > 20.f ? xx : log1pf(expf(xx));
                gdec[((size_t)b * 4 + j) * SEQ + s] = -expf(p.a_log[j]) * sp;
            }
        }
    }
}

__device__ void phase_dn_prep(const Params& p) {
    const bf16_t* proj = (const bf16_t*)(p.ws + OFF_PROJDN);
    bf16_t* qn = (bf16_t*)(p.ws + OFF_DNQ); bf16_t* kn = (bf16_t*)(p.ws + OFF_DNK); bf16_t* knT = (bf16_t*)(p.ws + OFF_KNT); bf16_t* vimg = (bf16_t*)(p.ws + OFF_VIMG);
    const float* gdec = (const float*)(p.ws + OFF_G); float* gcum = (float*)(p.ws + OFF_GCUM);
    const int tid = opaque_tid(), lane = tid & 63, w = tid >> 6;
    for (int unit = blockIdx.x; unit < NB * 4 * 64; unit += gridDim.x) {
        const int n = unit & 63, bh = unit >> 6, h = bh & 3, b = bh >> 2, t0 = n * 64;
        float y[3][8][2];
#pragma unroll
        for (int g = 0; g < 3; ++g) {
            const int ch = g * 512 + h * 128 + 2 * lane;
            float cw[4][2];
#pragma unroll
            for (int i = 0; i < 4; ++i) { cw[i][0] = p.conv_w[i * 1536 + ch]; cw[i][1] = p.conv_w[i * 1536 + ch + 1]; }
            unsigned raw[11];
#pragma unroll
            for (int rr = 0; rr < 11; ++rr) { const int tt = t0 + 8 * w - 3 + rr; raw[rr] = tt >= 0 ? *(const unsigned*)(proj + (size_t)(b * SEQ + tt) * 1536 + ch) : 0u; }
#pragma unroll
            for (int pp = 0; pp < 8; ++pp) { float a0 = 0.f, a1 = 0.f;
#pragma unroll
                for (int i = 0; i < 4; ++i) { a0 += cw[i][0] * bflo(raw[pp + i]); a1 += cw[i][1] * bfhi(raw[pp + i]); }
                y[g][pp][0] = silu_f(a0); y[g][pp][1] = silu_f(a1); }
        }
        const int d = 2 * lane, dcol = (d & ~15) + perm16(d & 15);
        unsigned kpk[8][1]; bf16_t kb[8][2];
#pragma unroll
        for (int pp = 0; pp < 8; ++pp) {
            const float sq = wave_sum(y[0][pp][0] * y[0][pp][0] + y[0][pp][1] * y[0][pp][1]), sk = wave_sum(y[1][pp][0] * y[1][pp][0] + y[1][pp][1] * y[1][pp][1]);
            const float rq = rsqrtf(sq + EPS) * 0.08838834764831845f, rk = rsqrtf(sk + EPS);
            const size_t ro = ((size_t)unit * 64 + 8 * w + pp) * 128 + dcol;
            *(unsigned*)(qn + ro) = pk_bf16(y[0][pp][0] * rq, y[0][pp][1] * rq);
            const unsigned kk = pk_bf16(y[1][pp][0] * rk, y[1][pp][1] * rk);
            *(unsigned*)(kn + ro) = kk; kpk[pp][0] = kk; kb[pp][0] = (bf16_t)(kk & 0xFFFFu); kb[pp][1] = (bf16_t)(kk >> 16);
        }
#pragma unroll
        for (int e = 0; e < 2; ++e)
#pragma unroll
            for (int hs = 0; hs < 2; ++hs) {
                u32x2_t v; v.x = (unsigned)kb[4 * hs][e] | ((unsigned)kb[4 * hs + 1][e] << 16); v.y = (unsigned)kb[4 * hs + 2][e] | ((unsigned)kb[4 * hs + 3][e] << 16);
                *(u32x2_t*)(knT + ((size_t)unit * 128 + d + e) * 64 + 16 * (w >> 1) + 8 * hs + 4 * (w & 1)) = v;
            }
#pragma unroll
        for (int e = 0; e < 2; ++e)
#pragma unroll
            for (int hs = 0; hs < 2; ++hs) {
                u32x2_t v; v.x = pk_bf16(y[2][4 * hs][e], y[2][4 * hs + 1][e]); v.y = pk_bf16(y[2][4 * hs + 2][e], y[2][4 * hs + 3][e]);
                *(u32x2_t*)(vimg + vimg_index(unit, 8 * w + 4 * hs, d + e)) = v;
            }
        if (w == 0) {
            float v = gdec[(size_t)bh * SEQ + t0 + lane];
#pragma unroll
            for (int o = 1; o < 64; o <<= 1) { const float t = __shfl_up(v, o); if (lane >= o) v += t; }
            gcum[(size_t)unit * 64 + lane] = v;
        }
    }
}

constexpr int D1B_LDS_PER_WAVE = 512;
__device__ void phase_dn_chunk(const Params& p, unsigned char* smem) {
    const bf16_t* qn = (const bf16_t*)(p.ws + OFF_DNQ); const bf16_t* kn = (const bf16_t*)(p.ws + OFF_DNK);
    const float* beta = (const float*)(p.ws + OFF_BETA); const float* gcum = (const float*)(p.ws + OFF_GCUM);
    bf16_t* Tm = (bf16_t*)(p.ws + OFF_T); bf16_t* attn = (bf16_t*)(p.ws + OFF_ATTN);
    const int tid0 = opaque_tid(), w = tid0 >> 6, lane = tid0 & 63, r = lane & 31, hh = lane >> 5;
    LDSP float* tg = (LDSP float*)((LDSP unsigned char*)smem + w * D1B_LDS_PER_WAVE); LDSP float* tb = tg + 64;
    for (int c = blockIdx.x * 8 + w; c < NB * 4 * 64; c += gridDim.x * 8) {
        const int bh = c >> 6, n = c & 63;
        tg[lane] = gcum[(size_t)c * 64 + lane]; tb[lane] = beta[(size_t)bh * SEQ + n * 64 + lane];
        const bf16_t* kp = kn + ((size_t)c * 64 + r) * 128 + 8 * hh; const bf16_t* qp = qn + ((size_t)c * 64 + r) * 128 + 8 * hh;
        f32x16 A00, A10, A11;
#define D1B_TILE_A(tile, rt, ct) do { _Pragma("unroll") for (int i = 0; i < 16; ++i) tile[i] = 0.f; \
        _Pragma("unroll 2") for (int s = 0; s < 8; ++s) { const bf16x8 ka = *(const bf16x8*)(kp + (rt) * 32 * 128 + 16 * s), kb2 = *(const bf16x8*)(kp + (ct) * 32 * 128 + 16 * s); tile = MFMA32(ka, kb2, tile); } \
        const float gcc = tg[32 * (ct) + r]; \
        _Pragma("unroll") for (int g4 = 0; g4 < 4; ++g4) { const int j0 = 32 * (rt) + 8 * g4 + 4 * hh; const f32x4 gj = *(const LDSP f32x4*)(tg + j0), bj = *(const LDSP f32x4*)(tb + j0); \
            _Pragma("unroll") for (int e = 0; e < 4; ++e) tile[4 * g4 + e] *= bj[e] * __expf(fminf(gj[e] - gcc, 0.f)); } } while (0)
        D1B_TILE_A(A00, 0, 0); D1B_TILE_A(A10, 1, 0); D1B_TILE_A(A11, 1, 1);
#undef D1B_TILE_A
        float Tr[64];
        int lane_o = lane; asm volatile("" : "+v"(lane_o));
#pragma unroll
        for (int cc = 63; cc >= 0; --cc) {
            float a0 = (lane_o == cc) ? 1.f : 0.f, a1 = 0.f;
            int z = 0;
            if (cc < 63) asm volatile("" : "+s"(z) : "v"(Tr[cc + 1]));
#pragma unroll
            for (int j = cc + 1; j < 64; ++j) {
                const int rt = j >> 5, ct = cc >> 5, i = 4 * ((j & 31) >> 3) + (j & 3), src = (cc & 31) + 32 * ((j >> 2) & 1);
                const float av = __int_as_float(__builtin_amdgcn_readlane(__float_as_int(rt == 0 ? A00[i] : (ct == 0 ? A10[i] : A11[i])), src + z));
                if (j & 1) a1 -= Tr[j] * av; else a0 -= Tr[j] * av;
            }
            Tr[cc] = a0 + a1;
        }
#pragma unroll
        for (int q = 0; q < 4; ++q)
#pragma unroll
            for (int half = 0; half < 2; ++half) { u32x4_t o;
                const int s0 = 8 * half;
                o.x = pk_bf16(Tr[16 * q + perm16(s0 + 0)], Tr[16 * q + perm16(s0 + 0) + 1]); o.y = pk_bf16(Tr[16 * q + perm16(s0 + 2)], Tr[16 * q + perm16(s0 + 2) + 1]);
                o.z = pk_bf16(Tr[16 * q + perm16(s0 + 4)], Tr[16 * q + perm16(s0 + 4) + 1]); o.w = pk_bf16(Tr[16 * q + perm16(s0 + 6)], Tr[16 * q + perm16(s0 + 6) + 1]);
                *(u32x4_t*)(Tm + ((size_t)c * 64 + lane) * 64 + 16 * q + s0) = o; }
#define D1B_TILE_ATT(jt, it) do { f32x16 tile; _Pragma("unroll") for (int i = 0; i < 16; ++i) tile[i] = 0.f; \
        _Pragma("unroll 2") for (int s = 0; s < 8; ++s) { const bf16x8 ka = *(const bf16x8*)(kp + (jt) * 32 * 128 + 16 * s), qb2 = *(const bf16x8*)(qp + (it) * 32 * 128 + 16 * s); tile = MFMA32(ka, qb2, tile); } \
        const int qi = 32 * (it) + r; const float gi = tg[qi]; \
        _Pragma("unroll") for (int s2 = 0; s2 < 2; ++s2) { float v[8]; \
            _Pragma("unroll") for (int a = 0; a < 2; ++a) { const int j0 = 32 * (jt) + 16 * s2 + 8 * a + 4 * hh; const f32x4 gj = *(const LDSP f32x4*)(tg + j0); \
                _Pragma("unroll") for (int e = 0; e < 4; ++e) v[4 * a + e] = (qi >= j0 + e) ? __expf(fminf(gi - gj[e], 0.f)) * tile[8 * s2 + 4 * a + e] : 0.f; } \
            u32x4_t o; o.x = pk_bf16(v[0], v[1]); o.y = pk_bf16(v[2], v[3]); o.z = pk_bf16(v[4], v[5]); o.w = pk_bf16(v[6], v[7]); \
            *(u32x4_t*)(attn + ((size_t)c * 64 + qi) * 64 + 32 * (jt) + 16 * s2 + 8 * hh) = o; } \
        asm volatile("" ::: "memory"); } while (0)
        D1B_TILE_ATT(0, 0); D1B_TILE_ATT(0, 1); D1B_TILE_ATT(1, 1);
#undef D1B_TILE_ATT
    }
}

constexpr int SCAN_BUF = 65536, SCAN_TBL = 2 * SCAN_BUF;
__device__ __forceinline__ int swz256(int row, int ch) { return (row * 16 + (ch ^ (row & 15))) * 16; }
__device__ __forceinline__ int swz128(int row, int ch) { const int sr = row >> 1; return (sr * 16 + ((((row & 1) << 3) | ch) ^ (sr & 7))) * 16; }
__device__ void phase_dn_scan(const Params& p, unsigned char* smem, int bh) {
    const unsigned char* qnb = p.ws + OFF_DNQ; const unsigned char* knb = p.ws + OFF_DNK; const unsigned char* kntb = p.ws + OFF_KNT;
    const unsigned char* tb_ = p.ws + OFF_T; const unsigned char* atb = p.ws + OFF_ATTN;
    const bf16_t* vimg = (const bf16_t*)(p.ws + OFF_VIMG); bf16_t* orm = (bf16_t*)(p.ws + OFF_ODN);
    const float* beta = (const float*)(p.ws + OFF_BETA); const float* gcum = (const float*)(p.ws + OFF_GCUM);
    const int tid = opaque_tid(), lane = tid & 63, w = __builtin_amdgcn_readfirstlane(tid >> 6), r = lane & 31, hh = lane >> 5;
    LDSP unsigned char* lds = (LDSP unsigned char*)smem;
    auto stage = [&](int n, int bsel) {
        const size_t chunk = (size_t)bh * 64 + n;
        int ln = lane; asm volatile("" : "+v"(ln)); ln &= 63;
#pragma unroll
        for (int i = 0; i < 8; ++i) {
            const int k = w * 8 + i; const unsigned char* src;
            if (k < 32) { const int sl = (k & 15) * 64 + ln, row = sl >> 4, ch = (sl & 15) ^ (row & 15); src = (k < 16 ? knb : qnb) + chunk * 16384 + row * 256 + ch * 16; }
            else { const int sl = (k < 48 ? (k - 32) : (k < 56 ? (k - 48) : (k - 56))) * 64 + ln, sr = sl >> 4, lp = (sl & 15) ^ (sr & 7), row = sr * 2 + (lp >> 3), ch = lp & 7;
                   src = (k < 48 ? kntb + chunk * 16384 : (k < 56 ? tb_ + chunk * 8192 : atb + chunk * 8192)) + row * 128 + ch * 16; }
            __builtin_amdgcn_global_load_lds((const unsigned*)src, (LDSP unsigned*)(lds + bsel * SCAN_BUF + k * 1024), 16, 0, 0);
        }
        if (w == 7) { LDSP float* tbl = (LDSP float*)(lds + SCAN_TBL + bsel * 512); tbl[ln] = gcum[chunk * 64 + ln]; tbl[64 + ln] = beta[(size_t)bh * SEQ + n * 64 + ln]; }
    };
    f32x16 S[4];
#pragma unroll
    for (int dt = 0; dt < 4; ++dt)
#pragma unroll
        for (int i = 0; i < 16; ++i) S[dt][i] = 0.f;
#define SCAN_SB(kc) __builtin_bit_cast(bf16x8, (u32x4_t){pk_bf16(S[(kc) >> 1][8 * ((kc) & 1)], S[(kc) >> 1][8 * ((kc) & 1) + 1]), pk_bf16(S[(kc) >> 1][8 * ((kc) & 1) + 2], S[(kc) >> 1][8 * ((kc) & 1) + 3]), \
                                                     pk_bf16(S[(kc) >> 1][8 * ((kc) & 1) + 4], S[(kc) >> 1][8 * ((kc) & 1) + 5]), pk_bf16(S[(kc) >> 1][8 * ((kc) & 1) + 6], S[(kc) >> 1][8 * ((kc) & 1) + 7])})
    u32x4_t vr[2][2];
    if (w < 4) {
#pragma unroll
        for (int pt = 0; pt < 2; ++pt)
#pragma unroll
            for (int g = 0; g < 2; ++g) vr[pt][g] = *(const u32x4_t*)(vimg + (((((size_t)bh * 64 * 4 + w) * 2 + pt) * 2 + g) * 64 + lane) * 8);
    }
    stage(0, 0);
    asm volatile("s_waitcnt vmcnt(0)" ::: "memory");
    __syncthreads();
    for (int n = 0; n < 64; ++n) {
        const int bsel = n & 1;
        if (n + 1 < 64) stage(n + 1, bsel ^ 1);
        if (w < 4) {
            const size_t chunk = (size_t)bh * 64 + n;
            LDSP unsigned char* B = lds + bsel * SCAN_BUF; LDSP float* tg = (LDSP float*)(lds + SCAN_TBL + bsel * 512); LDSP float* tbt = tg + 64;
            LDSP unsigned char* Bkn = B, *Bqn = B + 16384, *BknT = B + 32768, *BT = B + 49152, *Bat = B + 57344;
            f32x16 X[2];
#pragma unroll
            for (int i = 0; i < 16; ++i) { X[0][i] = 0.f; X[1][i] = 0.f; }
#pragma unroll
            for (int kc = 0; kc < 8; ++kc) {
                const bf16x8 a0 = *(const LDSP bf16x8*)(Bkn + swz256(r, 2 * kc + hh)), a1 = *(const LDSP bf16x8*)(Bkn + swz256(32 + r, 2 * kc + hh));
                const bf16x8 sb = SCAN_SB(kc); X[0] = MFMA32(a0, sb, X[0]); X[1] = MFMA32(a1, sb, X[1]);
            }
            asm volatile("" ::: "memory");
            const float gl_last = tg[63];
            bf16x8 Yb[2][2];
#pragma unroll
            for (int pt = 0; pt < 2; ++pt) {
                unsigned yp[8];
#pragma unroll
                for (int g4 = 0; g4 < 4; ++g4) { const int j0 = 32 * pt + 8 * g4 + 4 * hh; const f32x4 gj = *(const LDSP f32x4*)(tg + j0), bj = *(const LDSP f32x4*)(tbt + j0);
                    float yv[4];
#pragma unroll
                    for (int e = 0; e < 4; ++e) { const int i = 4 * g4 + e;
                        const unsigned vw = vr[pt][i >> 3][(i & 7) >> 1]; const float vv = (i & 1) ? bfhi(vw) : bflo(vw);
                        yv[e] = bj[e] * (vv - __expf(gj[e]) * X[pt][i]); }
                    yp[2 * g4] = pk_bf16(yv[0], yv[1]); yp[2 * g4 + 1] = pk_bf16(yv[2], yv[3]); }
#pragma unroll
                for (int s = 0; s < 2; ++s) { u32x4_t t4; t4.x = yp[4 * s]; t4.y = yp[4 * s + 1]; t4.z = yp[4 * s + 2]; t4.w = yp[4 * s + 3]; Yb[pt][s] = __builtin_bit_cast(bf16x8, t4); }
            }
            asm volatile("" ::: "memory");
            f32x16 Vn[2];
#pragma unroll
            for (int i = 0; i < 16; ++i) { Vn[0][i] = 0.f; Vn[1][i] = 0.f; }
#pragma unroll
            for (int kc = 0; kc < 4; ++kc) {
                if (kc < 2) { const bf16x8 a0 = *(const LDSP bf16x8*)(BT + swz128(r, 2 * kc + hh)); Vn[0] = MFMA32(a0, Yb[kc >> 1][kc & 1], Vn[0]); }
                const bf16x8 a1 = *(const LDSP bf16x8*)(BT + swz128(32 + r, 2 * kc + hh)); Vn[1] = MFMA32(a1, Yb[kc >> 1][kc & 1], Vn[1]);
            }
            asm volatile("" ::: "memory");
            bf16x8 Vnb[2][2], Vsb[2][2];
#pragma unroll
            for (int pt = 0; pt < 2; ++pt) {
                unsigned np[8], sp[8];
#pragma unroll
                for (int g4 = 0; g4 < 4; ++g4) { const int j0 = 32 * pt + 8 * g4 + 4 * hh; const f32x4 gj = *(const LDSP f32x4*)(tg + j0);
                    float et[4];
#pragma unroll
                    for (int e = 0; e < 4; ++e) et[e] = __expf(gl_last - gj[e]);
                    np[2 * g4] = pk_bf16(Vn[pt][4 * g4], Vn[pt][4 * g4 + 1]); np[2 * g4 + 1] = pk_bf16(Vn[pt][4 * g4 + 2], Vn[pt][4 * g4 + 3]);
                    sp[2 * g4] = pk_bf16(Vn[pt][4 * g4] * et[0], Vn[pt][4 * g4 + 1] * et[1]); sp[2 * g4 + 1] = pk_bf16(Vn[pt][4 * g4 + 2] * et[2], Vn[pt][4 * g4 + 3] * et[3]); }
#pragma unroll
                for (int s = 0; s < 2; ++s) { u32x4_t a4, b4; a4.x = np[4 * s]; a4.y = np[4 * s + 1]; a4.z = np[4 * s + 2]; a4.w = np[4 * s + 3]; b4.x = sp[4 * s]; b4.y = sp[4 * s + 1]; b4.z = sp[4 * s + 2]; b4.w = sp[4 * s + 3];
                    Vnb[pt][s] = __builtin_bit_cast(bf16x8, a4); Vsb[pt][s] = __builtin_bit_cast(bf16x8, b4); }
            }
            asm volatile("" ::: "memory");
            f32x16 O[2];
#pragma unroll
            for (int i = 0; i < 16; ++i) { O[0][i] = 0.f; O[1][i] = 0.f; }
#pragma unroll
            for (int kc = 0; kc < 8; ++kc) {
                const bf16x8 a0 = *(const LDSP bf16x8*)(Bqn + swz256(r, 2 * kc + hh)), a1 = *(const LDSP bf16x8*)(Bqn + swz256(32 + r, 2 * kc + hh));
                const bf16x8 sb = SCAN_SB(kc); O[0] = MFMA32(a0, sb, O[0]); O[1] = MFMA32(a1, sb, O[1]);
            }
#pragma unroll
            for (int pt = 0; pt < 2; ++pt)
#pragma unroll
                for (int g4 = 0; g4 < 4; ++g4) { const int j0 = 32 * pt + 8 * g4 + 4 * hh; const f32x4 gj = *(const LDSP f32x4*)(tg + j0);
#pragma unroll
                    for (int e = 0; e < 4; ++e) O[pt][4 * g4 + e] *= __expf(gj[e]); }
#pragma unroll
            for (int kc = 0; kc < 4; ++kc) {
                if (kc < 2) { const bf16x8 a0 = *(const LDSP bf16x8*)(Bat + swz128(r, 2 * kc + hh)); O[0] = MFMA32(a0, Vnb[kc >> 1][kc & 1], O[0]); }
                const bf16x8 a1 = *(const LDSP bf16x8*)(Bat + swz128(32 + r, 2 * kc + hh)); O[1] = MFMA32(a1, Vnb[kc >> 1][kc & 1], O[1]);
            }
            {
                bf16_t* orow = orm + ((size_t)bh * SEQ + n * 64 + 4 * hh) * 128 + 32 * w + r;
#pragma unroll
                for (int pt = 0; pt < 2; ++pt)
#pragma unroll
                    for (int i = 0; i < 16; ++i) orow[(size_t)(32 * pt + 8 * (i >> 2) + (i & 3)) * 128] = (bf16_t)(pk_bf16(O[pt][i], 0.f) & 0xFFFFu);
            }
            if (n + 1 < 64) {
#pragma unroll
                for (int pt = 0; pt < 2; ++pt)
#pragma unroll
                    for (int g = 0; g < 2; ++g) vr[pt][g] = *(const u32x4_t*)(vimg + ((((((size_t)chunk + 1) * 4 + w) * 2 + pt) * 2 + g) * 64 + lane) * 8);
            }
            asm volatile("" ::: "memory");
            const float glf = __expf(gl_last);
#pragma unroll
            for (int dt = 0; dt < 4; ++dt) {
#pragma unroll
                for (int i = 0; i < 16; ++i) S[dt][i] *= glf;
#pragma unroll
                for (int kc = 0; kc < 4; ++kc) { const bf16x8 a = *(const LDSP bf16x8*)(BknT + swz128(32 * dt + r, 2 * kc + hh)); S[dt] = MFMA32(a, Vsb[kc >> 1][kc & 1], S[dt]); }
            }
        }
        asm volatile("s_waitcnt vmcnt(0)" ::: "memory");
        __syncthreads();
    }
}

__device__ __forceinline__ void unpack8(const u32x4_t v, float (&f)[8]) { f[0] = bflo(v.x); f[1] = bfhi(v.x); f[2] = bflo(v.y); f[3] = bfhi(v.y); f[4] = bflo(v.z); f[5] = bfhi(v.z); f[6] = bflo(v.w); f[7] = bfhi(v.w); }
__device__ void phase_mix(const Params& p) {
    const bf16_t* odn = (const bf16_t*)(p.ws + OFF_ODN); const bf16_t* zs = (const bf16_t*)(p.ws + OFF_Z); const bf16_t* gate = (const bf16_t*)(p.ws + OFF_GATE);
    const bf16_t* attp = (const bf16_t*)(p.ws + OFF_ATTP); const float* lse = (const float*)(p.ws + OFF_LSE);
    bf16_t* mixed = (bf16_t*)(p.ws + OFF_MIXED);
    const int tid = opaque_tid(), lane = tid & 63, wpb = blockDim.x >> 6, gw = blockIdx.x * wpb + (tid >> 6), nw = gridDim.x * wpb;
    for (int item = gw; item < 2 * MROWS; item += nw) {
        if (item < MROWS) {
            const int row = item, b = row >> 12, t = row & 4095, h = lane >> 4, d8 = (lane & 15) * 8;
            float o[8], z[8];
            unpack8(*(const u32x4_t*)(odn + ((size_t)(b * 4 + h) * SEQ + t) * 128 + d8), o);
            unpack8(*(const u32x4_t*)(zs + (size_t)row * 512 + h * 128 + d8), z);
            float ss = 0.f;
#pragma unroll
            for (int e = 0; e < 8; ++e) ss += o[e] * o[e];
            ss += __shfl_xor(ss, 1); ss += __shfl_xor(ss, 2); ss += __shfl_xor(ss, 4); ss += __shfl_xor(ss, 8);
            const float rstd = rsqrtf(ss * (1.0f / 128.f) + EPS);
            const f32x4 w0 = *(const f32x4*)(p.dn_norm_w + d8), w1 = *(const f32x4*)(p.dn_norm_w + d8 + 4);
            u32x4_t r4;
            r4.x = pk_bf16(o[0] * rstd * w0[0] * z[0], o[1] * rstd * w0[1] * z[1]); r4.y = pk_bf16(o[2] * rstd * w0[2] * z[2], o[3] * rstd * w0[3] * z[3]);
            r4.z = pk_bf16(o[4] * rstd * w1[0] * z[4], o[5] * rstd * w1[1] * z[5]); r4.w = pk_bf16(o[6] * rstd * w1[2] * z[6], o[7] * rstd * w1[3] * z[7]);
            *(u32x4_t*)(mixed + (size_t)row * DM + h * 128 + d8) = r4;
        } else {
            const int g = item - MROWS, bh = g >> 9, t = (g & 511) * 8 + (lane >> 3), d8 = (lane & 7) * 8, b = bh >> 3, h = bh & 7;
            const size_t q = (size_t)bh * SEQ + t, PS = (size_t)MROWS * 8, row = (size_t)b * SEQ + t;
            const float l0 = lse[q], l1 = lse[PS + q], l2 = lse[2 * PS + q], mx = fmaxf(l0, fmaxf(l1, l2));
            float w0 = __expf(l0 - mx), w1 = __expf(l1 - mx), w2 = __expf(l2 - mx); const float inv = 1.0f / (w0 + w1 + w2); w0 *= inv; w1 *= inv; w2 *= inv;
            float a0[8], a1[8], a2[8], gt[8];
            unpack8(*(const u32x4_t*)(attp + q * 64 + d8), a0); unpack8(*(const u32x4_t*)(attp + (PS + q) * 64 + d8), a1); unpack8(*(const u32x4_t*)(attp + (2 * PS + q) * 64 + d8), a2);
            unpack8(*(const u32x4_t*)(gate + row * 512 + h * 64 + d8), gt);
            float o[8];
#pragma unroll
            for (int e = 0; e < 8; ++e) o[e] = (w0 * a0[e] + w1 * a1[e] + w2 * a2[e]) * gt[e];
            u32x4_t r4; r4.x = pk_bf16(o[0], o[1]); r4.y = pk_bf16(o[2], o[3]); r4.z = pk_bf16(o[4], o[5]); r4.w = pk_bf16(o[6], o[7]);
            *(u32x4_t*)(mixed + row * DM + 512 + h * 64 + d8) = r4;
        }
    }
}

__device__ __forceinline__ int t5_bucket_dev(int d) {
    if (d < 16) return d;
    int bkt = 16;
    const int bnd[15] = {22, 30, 40, 54, 73, 99, 134, 182, 246, 332, 450, 609, 825, 1117, 1513};
#pragma unroll
    for (int i = 0; i < 15; ++i) bkt += (d >= bnd[i]) ? 1 : 0;
    return bkt;
}
constexpr int ATT_UNITS = NB * 8 * 48, ATT_VBYTES = 384 * 128, ATT_TAB = ATT_VBYTES + 1024;
typedef short s16x4_t __attribute__((ext_vector_type(4)));
__device__ void phase_attn(const Params& p, unsigned char* smem, int vb, int vg) {
    const bf16_t* aq = (const bf16_t*)(p.ws + OFF_AQ); const bf16_t* ak = (const bf16_t*)(p.ws + OFF_AK); const unsigned char* avb = p.ws + OFF_AV;
    const int tid = opaque_tid(), w = __builtin_amdgcn_readfirstlane(tid >> 6);
    LDSP unsigned char* lds = (LDSP unsigned char*)smem; LDSP float* btab = (LDSP float*)(lds + ATT_TAB);
    for (int unit = vb; unit < ATT_UNITS; unit += vg) {
        int lane = tid; asm volatile("" : "+v"(lane)); lane &= 63;
        const int r = lane & 31, hh = lane >> 5, blk16 = (lane >> 4) & 1, q4 = (lane & 15) >> 2, pp = lane & 3;
        const int bh = unit / 48, u = unit % 48, pat = u >> 4, v = u & 15, h = bh & 7;
        const int rd = pat == 0 ? 1 : (pat == 1 ? 4 : 16), res = pat == 0 ? 0 : (pat == 1 ? (v >> 2) : v), M0 = (pat == 0 ? v : (pat == 1 ? (v & 3) : 0)) * 256;
        const size_t hb = (size_t)bh * SEQ;
        __syncthreads();
        if (tid < 129) btab[tid] = p.rel_bias[h * 32 + t5_bucket_dev(tid * rd)];
#pragma unroll
        for (int i = 0; i < 6; ++i) {
            const int k = w * 6 + i, sl = k * 64 + lane, row = sl >> 3, ch = (sl & 7) ^ (((row >> 1) & 1) << 2);
            int mk = M0 - 128 + row; mk = mk < 0 ? 0 : mk;
            __builtin_amdgcn_global_load_lds((const unsigned*)(avb + (hb + (size_t)(mk * rd + res)) * 128 + ch * 16), (LDSP unsigned*)(lds + k * 1024), 16, 0, 0);
        }
        const int mq = M0 + 32 * w + r; const size_t tq = hb + (size_t)(mq * rd + res);
        bf16x8 qf[4];
#pragma unroll
        for (int s = 0; s < 4; ++s) qf[s] = *(const bf16x8*)(aq + tq * 64 + 16 * s + 8 * hh);
        f32x16 Sc[5];
        bf16x8 kf[2][4];
#define ATT_LOADK(kt_, dst) do { int mk_ = M0 + 32 * w - 128 + 32 * (kt_) + r; mk_ = mk_ < 0 ? 0 : mk_; const bf16_t* kp_ = ak + (hb + (size_t)(mk_ * rd + res)) * 64 + 8 * hh; \
        _Pragma("unroll") for (int s = 0; s < 4; ++s) dst[s] = *(const bf16x8*)(kp_ + 16 * s); } while (0)
        ATT_LOADK(0, kf[0]);
#pragma unroll
        for (int kt = 0; kt < 5; ++kt) {
            if (kt < 4) ATT_LOADK(kt + 1, kf[(kt + 1) & 1]);
            asm volatile("" ::: "memory");
#pragma unroll
            for (int i = 0; i < 16; ++i) Sc[kt][i] = 0.f;
#pragma unroll
            for (int s = 0; s < 4; ++s) Sc[kt] = MFMA32(kf[kt & 1][s], qf[s], Sc[kt]);
        }
#undef ATT_LOADK
        asm volatile("s_waitcnt vmcnt(0)" ::: "memory");
        __syncthreads();
        const int jb = 128 + r - 4 * hh, kb0 = M0 + 32 * w - 128 + 4 * hh;
        float mx = -INFINITY;
#pragma unroll
        for (int kt = 0; kt < 5; ++kt) {
            asm volatile("" ::: "memory");
#pragma unroll
            for (int i = 0; i < 16; ++i) { const int dj = 32 * kt + 8 * (i >> 2) + (i & 3), j = jb - dj;
                const bool ok = (j >= 0) && (j <= 128) && (kb0 + dj >= 0);
                const float sc = ok ? Sc[kt][i] + btab[j] : -INFINITY; Sc[kt][i] = sc; mx = fmaxf(mx, sc); }
        }
        mx = fmaxf(mx, __shfl_xor(mx, 32));
        float lsum = 0.f;
#pragma unroll
        for (int kt = 0; kt < 5; ++kt)
#pragma unroll
            for (int i = 0; i < 16; ++i) { const float e = __expf(Sc[kt][i] - mx); Sc[kt][i] = e; lsum += e; }
        lsum += __shfl_xor(lsum, 32);
        f32x16 O[2];
#pragma unroll
        for (int i = 0; i < 16; ++i) { O[0][i] = 0.f; O[1][i] = 0.f; }
        const int xb = (q4 >> 1) & 1;
        LDSP unsigned char* vl0 = lds + (32 * w + 4 * hh + q4) * 128 + ((2 * blk16 + (pp >> 1)) + 4 * xb) * 16 + 8 * (pp & 1);
        LDSP unsigned char* vl1 = lds + (32 * w + 4 * hh + q4) * 128 + ((2 * blk16 + (pp >> 1)) + 4 * (xb ^ 1)) * 16 + 8 * (pp & 1);
#pragma unroll
        for (int kt = 0; kt < 5; ++kt)
#pragma unroll
            for (int s2 = 0; s2 < 2; ++s2) {
                asm volatile("" ::: "memory");
                u32x4_t pk; pk.x = pk_bf16(Sc[kt][8 * s2], Sc[kt][8 * s2 + 1]); pk.y = pk_bf16(Sc[kt][8 * s2 + 2], Sc[kt][8 * s2 + 3]); pk.z = pk_bf16(Sc[kt][8 * s2 + 4], Sc[kt][8 * s2 + 5]); pk.w = pk_bf16(Sc[kt][8 * s2 + 6], Sc[kt][8 * s2 + 7]);
                const bf16x8 pb = __builtin_bit_cast(bf16x8, pk);
                const int ro = (32 * kt + 16 * s2) * 128;
                const s16x4_t a0l = __builtin_amdgcn_ds_read_tr16_b64_v4i16((LDSP s16x4_t*)(vl0 + ro)), a0h = __builtin_amdgcn_ds_read_tr16_b64_v4i16((LDSP s16x4_t*)(vl0 + ro + 8 * 128));
                const s16x4_t a1l = __builtin_amdgcn_ds_read_tr16_b64_v4i16((LDSP s16x4_t*)(vl1 + ro)), a1h = __builtin_amdgcn_ds_read_tr16_b64_v4i16((LDSP s16x4_t*)(vl1 + ro + 8 * 128));
                O[0] = MFMA32(__builtin_shufflevector(a0l, a0h, 0, 1, 2, 3, 4, 5, 6, 7), pb, O[0]);
                O[1] = MFMA32(__builtin_shufflevector(a1l, a1h, 0, 1, 2, 3, 4, 5, 6, 7), pb, O[1]);
            }
        const float inv = 1.0f / lsum;
        bf16_t* op = (bf16_t*)(p.ws + OFF_ATTP) + ((size_t)pat * MROWS * 8 + tq) * 64;
#pragma unroll
        for (int dt = 0; dt < 2; ++dt)
#pragma unroll
            for (int g4 = 0; g4 < 4; ++g4) { u32x2_t o; o.x = pk_bf16(O[dt][4 * g4] * inv, O[dt][4 * g4 + 1] * inv); o.y = pk_bf16(O[dt][4 * g4 + 2] * inv, O[dt][4 * g4 + 3] * inv);
                *(u32x2_t*)(op + 32 * dt + 8 * g4 + 4 * hh) = o; }
        if (hh == 0) ((float*)(p.ws + OFF_LSE))[(size_t)pat * MROWS * 8 + tq] = mx + __logf(lsum);
    }
}

#define XB_TMO      128
#define XB_XCNT(j)  (256  + 64 * (j))
#define XB_XSUB(j)  (1280 + 64 * (j))
#define XB_XGEN(j)  (2304 + 64 * (j))
#define XB_TOP      3328
#define XB_TOPGEN   3392
#define XCD_BAR_WORDS 3456
#define XB_SPIN_CAP (1u << 18)
#define LAS __attribute__((address_space(3)))

__device__ __forceinline__ unsigned xb_ld(unsigned* p)              { return __hip_atomic_load(p, __ATOMIC_RELAXED, __HIP_MEMORY_SCOPE_AGENT); }
__device__ __forceinline__ unsigned xb_add(unsigned* p, unsigned v) { return __hip_atomic_fetch_add(p, v, __ATOMIC_RELAXED, __HIP_MEMORY_SCOPE_AGENT); }
__device__ __forceinline__ unsigned xb_xcc_id() { return (unsigned)__builtin_amdgcn_s_getreg((3 << 11) | 20) & 0xFu; }
#define XB_SPIN(cond, bar) do { unsigned _sp = 0; while (cond) { __builtin_amdgcn_s_sleep(1); \
    if ((++_sp & 255u) == 0u) { if (xb_ld(&(bar)[XB_TMO])) break; if (_sp > XB_SPIN_CAP) { atomicAdd(&(bar)[XB_TMO], 1u); break; } } } } while (0)

struct XcdBarrier {
    unsigned* bar; unsigned x;
    volatile LAS unsigned* st;
};

__device__ __forceinline__ XcdBarrier xcd_barrier_post(unsigned* bar, volatile LAS unsigned* st) {
    XcdBarrier b; b.bar = bar; b.x = xb_xcc_id(); b.st = st;
    if (threadIdx.x == 0) (void)xb_add(&bar[XB_XCNT(b.x)], 1u);
    return b;
}
__device__ __forceinline__ void xcd_barrier_complete(unsigned* bar, unsigned x, unsigned& nloc, unsigned& nx) {
    const unsigned G = gridDim.x * gridDim.y * gridDim.z;
    unsigned sum, cnt, mine, sp = 0u;
    for (;;) {
        sum = 0u; cnt = 0u; mine = 0u;
#pragma unroll
        for (unsigned j = 0; j < 16; ++j) { const unsigned c = xb_ld(&bar[XB_XCNT(j)]); sum += c; cnt += (c > 0u) ? 1u : 0u; mine = (j == x) ? c : mine; }
        if (sum == G) break;
        __builtin_amdgcn_s_sleep(1);
        if ((++sp & 255u) == 0u) { if (xb_ld(&bar[XB_TMO])) break; if (sp > XB_SPIN_CAP) { atomicAdd(&bar[XB_TMO], 1u); break; } }
    }
    nloc = mine > 0u ? mine : 1u; nx = cnt > 0u ? cnt : 1u;
}

__device__ __forceinline__ void xcd_barrier(const XcdBarrier& b) {
    asm volatile("s_waitcnt vmcnt(0)" ::: "memory");
    __syncthreads();
    if (threadIdx.x == 0) {
        unsigned* bar = b.bar;
        __builtin_amdgcn_s_waitcnt(0);
        unsigned nloc = b.st[0], nx = b.st[1];
        if (nloc == 0u) { xcd_barrier_complete(bar, b.x, nloc, nx); b.st[0] = nloc; b.st[1] = nx; }
        const unsigned old = xb_add(&bar[XB_XSUB(b.x)], 1u);
        const unsigned gen = old / nloc;
        if (old + 1u == (gen + 1u) * nloc) {
            __builtin_amdgcn_fence(__ATOMIC_RELEASE, "agent");
            asm volatile("s_waitcnt vmcnt(0)" ::: "memory");
            const unsigned og = xb_add(&bar[XB_TOP], 1u);
            const unsigned tg = og / nx;
            if (og + 1u == (tg + 1u) * nx) xb_add(&bar[XB_TOPGEN], 1u);
            else XB_SPIN(xb_ld(&bar[XB_TOPGEN]) == tg, bar);
            __builtin_amdgcn_fence(__ATOMIC_ACQUIRE, "agent");
            xb_add(&bar[XB_XGEN(b.x)], 1u);
            asm volatile("s_waitcnt vmcnt(0)" ::: "memory");
        } else {
            XB_SPIN(xb_ld(&bar[XB_XGEN(b.x)]) == gen, bar);
            __builtin_amdgcn_fence(__ATOMIC_ACQUIRE, "agent");
            asm volatile("s_waitcnt vmcnt(0)" ::: "memory");
        }
    }
    __syncthreads();
}

constexpr int NTHREADS = 512;
constexpr size_t DYN_LDS = 147456;
constexpr int SCAN_BLOCKS = 32;
__global__ void __launch_bounds__(NTHREADS, 2) fwd_mega(Params p) {
    cg::grid_group grid = cg::this_grid();
    extern __shared__ __attribute__((aligned(16))) unsigned char smem[];
    float* smf = (float*)smem;
    volatile LAS unsigned* xbst = (volatile LAS unsigned*)((LAS unsigned char*)smem + DYN_LDS - 16);
    if (threadIdx.x < 4) xbst[threadIdx.x] = 0u;
    __syncthreads();
    const XcdBarrier xbar = xcd_barrier_post((unsigned*)(p.ws + OFF_BAR), xbst);
    if (p.ws == nullptr) grid.sync();
#define GRID_SYNC() xcd_barrier(xbar)
#ifndef PROBE_DUP
#define PROBE_DUP 0
#endif
#define DUP(k) for (int rep_ = 0; rep_ < ((PROBE_DUP == (k)) ? 2 : 1); ++rep_)
    DUP(1) { phase_weights(p); phase_norm(p, smf); GRID_SYNC(); }
    DUP(2) { pg8::Gemm g{(const bf16_t*)(p.ws + OFF_XN), (const bf16_t*)(p.ws + OFF_WTIN), MROWS, NPK, DM}; pg8::StaticOrder S; S.init(MROWS, NPK, (int)gridDim.x, (int)blockIdx.x);
      EpiProjSplit E{p.ws, p.q_norm_w, p.k_norm_w};
      pg8::gemm_phase<EpiProjSplit, pg8::StaticOrder, true, true>((PG8_LAS unsigned char*)smem, g, S, E); GRID_SYNC(); }
    DUP(3) { phase_dn_prep(p); GRID_SYNC(); }
    DUP(4) { phase_dn_chunk(p, smem); GRID_SYNC(); }
    DUP(5) { if ((int)blockIdx.x < SCAN_BLOCKS) phase_dn_scan(p, smem, blockIdx.x);
      else phase_attn(p, smem, blockIdx.x - SCAN_BLOCKS, gridDim.x - SCAN_BLOCKS);
      GRID_SYNC(); }
    DUP(6) { phase_mix(p); GRID_SYNC(); }
    DUP(7) { pg8::Gemm g{(const bf16_t*)(p.ws + OFF_MIXED), (const bf16_t*)(p.ws + OFF_WTOUT), MROWS, DM, DM}; pg8::StaticOrder S; S.init(MROWS, DM, (int)gridDim.x, (int)blockIdx.x);
      EpiOutRes E{p.x, p.out}; pg8::gemm_phase<EpiOutRes, pg8::StaticOrder, true, true>((PG8_LAS unsigned char*)smem, g, S, E); if (rep_ == 0 && PROBE_DUP == 7) GRID_SYNC(); }
    if (PROBE_DUP == 8) { GRID_SYNC(); GRID_SYNC(); GRID_SYNC(); GRID_SYNC(); }
}

extern "C" void kernel_launch(void* const* d_in, const int* in_sizes, int n_in, void* d_out, int out_size, void* d_ws, size_t ws_size, hipStream_t stream) {
    (void)in_sizes; (void)n_in; (void)out_size;
    if (ws_size < WS_NEED) { fprintf(stderr, "workspace too small: %zu < %zu\n", ws_size, (size_t)WS_NEED); return; }
    static int grid_blocks = 0;
    if (!grid_blocks) {
        int dev = 0, cus = 0, per_cu = 0;
        (void)hipGetDevice(&dev);
        (void)hipDeviceGetAttribute(&cus, hipDeviceAttributeMultiprocessorCount, dev);
        (void)hipFuncSetAttribute((const void*)fwd_mega, hipFuncAttributeMaxDynamicSharedMemorySize, (int)DYN_LDS);
        (void)hipOccupancyMaxActiveBlocksPerMultiprocessor(&per_cu, fwd_mega, NTHREADS, DYN_LDS);
        if (per_cu > 1) per_cu = 1;
        grid_blocks = cus * per_cu;
        if (grid_blocks <= SCAN_BLOCKS) fprintf(stderr, "grid too small: %d\n", grid_blocks);
    }
    Params p{};
    p.x = (const float*)d_in[0]; p.norm_w = (const float*)d_in[1]; p.w_in = (const float*)d_in[2]; p.conv_w = (const float*)d_in[3]; p.a_log = (const float*)d_in[4];
    p.dt_bias = (const float*)d_in[5]; p.dn_norm_w = (const float*)d_in[6]; p.q_norm_w = (const float*)d_in[7]; p.k_norm_w = (const float*)d_in[8]; p.rel_bias = (const float*)d_in[9];
    p.w_out = (const float*)d_in[10]; p.out = (float*)d_out; p.ws = (unsigned char*)d_ws;
    (void)hipMemsetAsync((unsigned char*)d_ws + OFF_BAR, 0, XCD_BAR_WORDS * 4, stream);
    void* args[] = {&p};
    hipError_t e = hipLaunchCooperativeKernel((const void*)fwd_mega, dim3(grid_blocks), dim3(NTHREADS), args, DYN_LDS, stream);
    if (e != hipSuccess) fprintf(stderr, "cooperative launch failed: %s (grid %d)\n", hipGetErrorString(e), grid_blocks);
}
```

```cpp
#include <hip/hip_runtime.h>
#include <hip/hip_cooperative_groups.h>
#include <cstdint>
#include <cstdio>
namespace cg = cooperative_groups;

typedef unsigned short bf16_t;
typedef short bf16x8 __attribute__((ext_vector_type(8)));
typedef float f32x4 __attribute__((ext_vector_type(4)));
typedef float f32x16 __attribute__((ext_vector_type(16)));
typedef unsigned u32x4_t __attribute__((ext_vector_type(4)));
typedef unsigned u32x2_t __attribute__((ext_vector_type(2)));
typedef __bf16 bf16x2_t __attribute__((ext_vector_type(2)));
typedef float f32x2_t __attribute__((ext_vector_type(2)));
#define LDSP __attribute__((address_space(3)))

constexpr int NB = 8, SEQ = 4096, DM = 1024, MROWS = NB * SEQ;
constexpr int DIN = 4104, NPK = 4096;
constexpr int ATH = 8;
constexpr float EPS = 1e-6f;
constexpr size_t MiB = (size_t)1 << 20;

constexpr size_t OFF_R0 = 0;
constexpr size_t OFF_XN = OFF_R0, OFF_DNQ = OFF_R0, OFF_DNK = OFF_R0 + 32 * MiB;
constexpr size_t OFF_WTIN = 64 * MiB;
constexpr size_t OFF_WTOUT = 72 * MiB;
constexpr size_t OFF_BETA = 74 * MiB;
constexpr size_t OFF_G = OFF_BETA + MiB / 2;
constexpr size_t OFF_GCUM = 75 * MiB;
constexpr size_t OFF_BAR = 75 * MiB + MiB / 2;
constexpr size_t OFF_R3 = 76 * MiB;
constexpr size_t OFF_PROJDN = OFF_R3, OFF_ATTP = OFF_R3  , OFF_LSE = OFF_R3 + 96 * MiB  ;
constexpr size_t OFF_Z = 176 * MiB;
constexpr size_t OFF_MIXED = 208 * MiB;
constexpr size_t OFF_AQ = 208 * MiB;
constexpr size_t OFF_AK = 240 * MiB;
constexpr size_t OFF_AV = 272 * MiB;
constexpr size_t OFF_GATE = 304 * MiB;
constexpr size_t OFF_KNT = 336 * MiB;
constexpr size_t OFF_VIMG = 368 * MiB;
constexpr size_t OFF_T = 400 * MiB;
constexpr size_t OFF_ATTN = 416 * MiB;
constexpr size_t OFF_SCT = 464 * MiB;
constexpr size_t OFF_ODN = 432 * MiB;
constexpr size_t WS_NEED = 466 * MiB;

__device__ __forceinline__ bf16_t f2bf(float f) { unsigned u = __float_as_uint(f); u += 0x7FFFu + ((u >> 16) & 1u); return (bf16_t)(u >> 16); }
__device__ __forceinline__ float bf2f(bf16_t b) { return __uint_as_float(((unsigned)b) << 16); }
__device__ __forceinline__ float wave_sum(float v) {
#pragma unroll
    for (int o = 32; o >= 1; o >>= 1) v += __shfl_xor(v, o);
    return v;
}
__device__ __forceinline__ float wave_max(float v) {
#pragma unroll
    for (int o = 32; o >= 1; o >>= 1) v = fmaxf(v, __shfl_xor(v, o));
    return v;
}
__device__ __forceinline__ float silu_f(float y) { return y / (1.0f + __expf(-y)); }
__device__ __forceinline__ unsigned pk_bf16(float lo, float hi) { f32x2_t v = {lo, hi}; return __builtin_bit_cast(unsigned, __builtin_convertvector(v, bf16x2_t)); }
__device__ __forceinline__ float bflo(unsigned u) { return __uint_as_float(u << 16); }
__device__ __forceinline__ float bfhi(unsigned u) { return __uint_as_float(u & 0xFFFF0000u); }
__device__ __forceinline__ void unpack8(const u32x4_t v, float (&f)[8]) { f[0] = bflo(v.x); f[1] = bfhi(v.x); f[2] = bflo(v.y); f[3] = bfhi(v.y); f[4] = bflo(v.z); f[5] = bfhi(v.z); f[6] = bflo(v.w); f[7] = bfhi(v.w); }
__host__ __device__ __forceinline__ int crow(int i, int hh) { return (i & 3) + 8 * (i >> 2) + 4 * hh; }
__host__ __device__ __forceinline__ int perm16(int x) { return (x & ~12) | ((x & 4) << 1) | ((x & 8) >> 1); }
#define MFMA32(a, b, c) __builtin_amdgcn_mfma_f32_32x32x16_bf16((a), (b), (c), 0, 0, 0)
__host__ __device__ __forceinline__ size_t vimg_index(int chunk, int pos, int dv) {
    const int wsl = dv >> 5, cl = dv & 31, pt = pos >> 5, pr = pos & 31, i = 4 * (pr >> 3) + (pr & 3), hs = (pr >> 2) & 1;
    return (((((size_t)chunk * 4 + wsl) * 2 + pt) * 2 + (i >> 3)) * 64 + cl + 32 * hs) * 8 + (i & 7);
}

__device__ __forceinline__ int opaque_tid() { int t = threadIdx.x; asm volatile("" : "+v"(t)); return t & 511; }
__device__ __forceinline__ unsigned char* opaque_ptr(unsigned char* q) { asm volatile("" : "+s"(q)); return q; }
struct Params {
    const float* x; const float* norm_w; const float* w_in; const float* conv_w; const float* a_log; const float* dt_bias;
    const float* dn_norm_w; const float* q_norm_w; const float* k_norm_w; const float* rel_bias; const float* w_out;
    float* out; unsigned char* ws;
};

namespace pg8 {
#define PG8_LAS __attribute__((address_space(3)))
typedef unsigned short bf16_t;
typedef short bf16x8 __attribute__((ext_vector_type(8)));
typedef float f32x4 __attribute__((ext_vector_type(4)));
typedef unsigned u32x4 __attribute__((ext_vector_type(4)));
constexpr int BM = 256, BK = 64, HALF = 128, HTB = HALF * BK * 2  , STAGE_BYTES = 8 * HTB, NXCD = 8, WGM = 8;

__host__ __device__ __forceinline__ int lds_byte(int r, int c) { const int st = (r >> 4) * 2 + (c >> 5), rr = r & 15, cc = c & 31, ob = rr * 64 + cc * 2; return st * 1024 + (ob ^ (((ob >> 9) & 1) << 5)); }
__host__ __device__ __forceinline__ void stage_rc(int b, int& R, int& C) { const int st = b / 1024, sb = b % 1024, swz = sb ^ (((sb >> 9) & 1) << 5); R = (st >> 1) * 16 + swz / 64; C = (st & 1) * 32 + (swz % 64) / 2; }
__host__ __device__ __forceinline__ int perm32(int rho) { const int n = rho >> 4, i = rho & 15; return 8 * (i >> 2) + 4 * n + (i & 3); }

struct Unit { int pm, pn; };
struct Gemm { const bf16_t* A; const bf16_t* Bt; int M, N, K; };

struct StaticOrder {
    int nM, nN, nwg, G, c;
    __host__ __device__ void init(int M, int N, int G_, int c_) { nM = M / BM; nN = N / BM; nwg = nM * nN; G = G_; c = c_; }
    __host__ __device__ bool next(int i, Unit& u) const {
        const long L = (long)i * G + c; if (L >= nwg) return false;
        int wgid = (int)L; { const int q = nwg / NXCD, r = nwg % NXCD, xcd = wgid % NXCD, off = wgid / NXCD; wgid = (xcd < r ? xcd * (q + 1) : r * (q + 1) + (xcd - r) * q) + off; }
        const int nig = WGM * nN, gid = wgid / nig, fm = gid * WGM, gsz = (nM - fm) < WGM ? (nM - fm) : WGM;
        u.pm = fm + ((wgid % nig) % gsz); u.pn = (wgid % nig) / gsz; return true;
    }
    __device__ __forceinline__ void a_ready(const Unit&) const {}
    __device__ __forceinline__ void done(const Unit&) const {}
};

__device__ __forceinline__ unsigned cvt_pk_bf16(float lo, float hi) { unsigned r; asm volatile("v_cvt_pk_bf16_f32 %0, %1, %2" : "=v"(r) : "v"(lo), "v"(hi)); return r; }
typedef float f32x2 __attribute__((ext_vector_type(2)));
template <class Epi, class Sched, bool ALIGN_EPI = false, bool SP2 = false>
__device__ __forceinline__ void gemm_phase(PG8_LAS unsigned char* lds, const Gemm g, const Sched& S, const Epi& E) {
    const int tid = opaque_tid(), wid = __builtin_amdgcn_readfirstlane(tid >> 6), lane = tid & 63, wr = wid >> 2, wc = wid & 3, fr = lane & 15, fq = lane >> 4;
    const int K = g.K, nt = K / BK;
    unsigned voffA[2], voffB[2];
#pragma unroll
    for (int i = 0; i < 2; ++i) { int R, C; stage_rc(tid * 16 + i * 8192, R, C); const int Rb = Epi::PERM ? ((R & ~31) + perm32(R & 31)) : R;
        voffA[i] = (unsigned)(R * K + C) * 2u; voffB[i] = (unsigned)(Rb * K + C) * 2u; }
    const size_t kstep = (size_t)(BK * 2);
    const size_t hstep = (size_t)HALF * K * 2;
    const size_t tstep = 2 * hstep;
    const unsigned ldsw = (unsigned)wid * 1024u;
    const int aoff = lds_byte(wr * 64 + fr, fq * 8), boff = lds_byte(wc * 32 + fr, fq * 8);
#define PG8_SA(b, h) (((b) * 2 + (h)) * HTB)
#define PG8_SB(b, h) ((4 + (b) * 2 + (h)) * HTB)
#define PG8_STAGE(bufoff, gbase, voff) do { _Pragma("unroll") for (int _i = 0; _i < 2; ++_i) \
        __builtin_amdgcn_global_load_lds((const unsigned*)((const char*)(gbase) + (voff)[_i]), (PG8_LAS unsigned*)(lds + (bufoff) + ldsw + _i * 8192), 16, 0, 0); } while (0)
#define PG8_LDA(dst, b, h) do { _Pragma("unroll") for (int m = 0; m < 4; ++m) _Pragma("unroll") for (int k = 0; k < 2; ++k) dst[m][k] = *(const PG8_LAS bf16x8*)(lds + PG8_SA(b, h) + aoff + m * 2048 + k * 1024); } while (0)
#define PG8_LDB(dst, b, h) do { _Pragma("unroll") for (int n = 0; n < 2; ++n) _Pragma("unroll") for (int k = 0; k < 2; ++k) dst[n][k] = *(const PG8_LAS bf16x8*)(lds + PG8_SB(b, h) + boff + n * 2048 + k * 1024); } while (0)
#define PG8_MMA(ai, bj, At, Bt) do { __builtin_amdgcn_s_setprio(1); _Pragma("unroll") for (int m = 0; m < 4; ++m) _Pragma("unroll") for (int n = 0; n < 2; ++n) _Pragma("unroll") for (int k = 0; k < 2; ++k) \
        acc[ai][bj][m][n] = __builtin_amdgcn_mfma_f32_16x16x32_bf16(Bt[n][k], At[m][k], acc[ai][bj][m][n], 0, 0, 0); __builtin_amdgcn_s_setprio(0); } while (0)
#define PG8_WAIT_V(n) asm volatile("s_waitcnt vmcnt(" #n ")" ::: "memory")
#define PG8_WAIT_L(n) asm volatile("s_waitcnt lgkmcnt(" #n ")" ::: "memory")
#define PG8_BAR __builtin_amdgcn_s_barrier()
#define PG8_SCHED __builtin_amdgcn_sched_barrier(0)
    Unit cur, nxt; int ui = 0;
    if (!S.next(0, cur)) return;
    f32x4 acc[2][2][4][2];
#pragma unroll
    for (int a = 0; a < 2; ++a)
#pragma unroll
        for (int b = 0; b < 2; ++b)
#pragma unroll
            for (int m = 0; m < 4; ++m)
#pragma unroll
                for (int n = 0; n < 2; ++n) acc[a][b][m][n] = (f32x4){0.f, 0.f, 0.f, 0.f};
    bf16x8 At[4][2], B0[2][2], B1[2][2];
    const char* cA = (const char*)g.A + (size_t)cur.pm * tstep; const char* cB = (const char*)g.Bt + (size_t)cur.pn * tstep;
    S.a_ready(cur);
    if constexpr (SP2) {
        PG8_STAGE(PG8_SB(0, 0), cB, voffB); PG8_STAGE(PG8_SB(0, 1), cB + hstep, voffB); PG8_STAGE(PG8_SA(0, 0), cA, voffA); PG8_STAGE(PG8_SA(0, 1), cA + hstep, voffA);
        if (wr == 1) PG8_BAR;
        PG8_WAIT_V(2); PG8_BAR;
        PG8_STAGE(PG8_SB(1, 0), cB + kstep, voffB); PG8_STAGE(PG8_SA(1, 0), cA + kstep, voffA); PG8_STAGE(PG8_SB(1, 1), cB + hstep + kstep, voffB);
        PG8_WAIT_V(6); PG8_BAR;
    } else {
        PG8_STAGE(PG8_SB(0, 0), cB, voffB); PG8_STAGE(PG8_SA(0, 0), cA, voffA); PG8_STAGE(PG8_SB(0, 1), cB + hstep, voffB); PG8_STAGE(PG8_SA(0, 1), cA + hstep, voffA);
        if (wr == 1) PG8_BAR;
        PG8_WAIT_V(4); PG8_BAR;
        PG8_STAGE(PG8_SB(1, 0), cB + kstep, voffB); PG8_STAGE(PG8_SA(1, 0), cA + kstep, voffA); PG8_STAGE(PG8_SB(1, 1), cB + hstep + kstep, voffB);
        PG8_WAIT_V(6); PG8_BAR;
    }
    for (;;) {
        const bool has_next = S.next(ui + 1, nxt);
        const char* nA = has_next ? (const char*)g.A + (size_t)nxt.pm * tstep : cA; const char* nB = has_next ? (const char*)g.Bt + (size_t)nxt.pn * tstep : cB;
        for (int t = 0; t < nt; t += 2) {
            const bool last = (t == nt - 2);
            const char* a1 = cA + (size_t)(t + 1) * kstep;
            const char* a2 = last ? nA : cA + (size_t)(t + 2) * kstep; const char* b2 = last ? nB : cB + (size_t)(t + 2) * kstep;
            const char* a3 = a2 + kstep; const char* b3 = b2 + kstep;
            if (last && has_next) S.a_ready(nxt);
            if constexpr (SP2) {
            PG8_LDB(B0, 0, 0); PG8_LDB(B1, 0, 1); PG8_SCHED; PG8_LDA(At, 0, 0); PG8_STAGE(PG8_SA(1, 1), a1 + hstep, voffA);
            PG8_WAIT_V(8); PG8_WAIT_L(0); PG8_BAR; PG8_MMA(0, 0, At, B0); PG8_MMA(0, 1, At, B1); PG8_BAR; PG8_SCHED;
            PG8_LDA(At, 0, 1); PG8_STAGE(PG8_SB(0, 0), b2, voffB); PG8_STAGE(PG8_SB(0, 1), b2 + hstep, voffB); PG8_STAGE(PG8_SA(0, 0), a2, voffA);
            PG8_WAIT_V(8); PG8_WAIT_L(0); PG8_BAR; PG8_MMA(1, 0, At, B0); PG8_MMA(1, 1, At, B1); PG8_BAR; PG8_SCHED;
            PG8_LDB(B0, 1, 0); PG8_LDB(B1, 1, 1); PG8_SCHED; PG8_LDA(At, 1, 0); PG8_STAGE(PG8_SA(0, 1), a2 + hstep, voffA);
            PG8_WAIT_V(8); PG8_WAIT_L(0); PG8_BAR; PG8_MMA(0, 0, At, B0); PG8_MMA(0, 1, At, B1); PG8_BAR; PG8_SCHED;
            PG8_LDA(At, 1, 1); PG8_STAGE(PG8_SB(1, 0), b3, voffB); PG8_STAGE(PG8_SB(1, 1), b3 + hstep, voffB); PG8_STAGE(PG8_SA(1, 0), a3, voffA);
            PG8_WAIT_V(8); PG8_WAIT_L(0); PG8_BAR; PG8_MMA(1, 0, At, B0); PG8_MMA(1, 1, At, B1); PG8_BAR; PG8_SCHED;
            } else {
            PG8_LDB(B0, 0, 0); PG8_SCHED; PG8_LDA(At, 0, 0); PG8_STAGE(PG8_SA(1, 1), a1 + hstep, voffA);
            PG8_WAIT_L(8); PG8_BAR; PG8_WAIT_L(0); PG8_MMA(0, 0, At, B0); PG8_BAR; PG8_SCHED;
            PG8_LDB(B1, 0, 1); PG8_STAGE(PG8_SB(0, 0), b2, voffB);
            PG8_BAR; PG8_WAIT_L(0); PG8_MMA(0, 1, At, B1); PG8_BAR;
            PG8_LDA(At, 0, 1); PG8_STAGE(PG8_SA(0, 0), a2, voffA);
            PG8_BAR; PG8_WAIT_L(0); PG8_MMA(1, 0, At, B0); PG8_BAR; PG8_SCHED;
            PG8_STAGE(PG8_SB(0, 1), b2 + hstep, voffB);
            PG8_WAIT_V(6); PG8_BAR; PG8_MMA(1, 1, At, B1); PG8_BAR;
            PG8_LDB(B0, 1, 0); PG8_SCHED; PG8_LDA(At, 1, 0); PG8_STAGE(PG8_SA(0, 1), a2 + hstep, voffA);
            PG8_WAIT_L(8); PG8_BAR; PG8_WAIT_L(0); PG8_MMA(0, 0, At, B0); PG8_BAR; PG8_SCHED;
            PG8_LDB(B1, 1, 1); PG8_STAGE(PG8_SB(1, 0), b3, voffB);
            PG8_BAR; PG8_WAIT_L(0); PG8_MMA(0, 1, At, B1); PG8_BAR;
            PG8_LDA(At, 1, 1); PG8_STAGE(PG8_SA(1, 0), a3, voffA);
            PG8_BAR; PG8_WAIT_L(0); PG8_MMA(1, 0, At, B0); PG8_BAR; PG8_SCHED;
            PG8_STAGE(PG8_SB(1, 1), b3 + hstep, voffB);
            PG8_WAIT_V(6); PG8_BAR; PG8_MMA(1, 1, At, B1); PG8_BAR;
            }
        }
        if constexpr (ALIGN_EPI) { if (wr == 0) PG8_BAR; }
        if constexpr (!Epi::AFTER_DRAIN) { E(acc, cur, wr, wc, fr, fq); S.done(cur); }
        if (!has_next) break;
#pragma unroll
        for (int a = 0; a < 2; ++a)
#pragma unroll
            for (int b = 0; b < 2; ++b)
#pragma unroll
                for (int m = 0; m < 4; ++m)
#pragma unroll
                    for (int n = 0; n < 2; ++n) acc[a][b][m][n] = (f32x4){0.f, 0.f, 0.f, 0.f};
        cur = nxt; cA = nA; cB = nB; ++ui;
        if constexpr (ALIGN_EPI) { if (wr == 1) PG8_BAR; }
    }
    PG8_WAIT_V(0);
    if constexpr (!ALIGN_EPI) { if (wr == 0) PG8_BAR; }
    PG8_BAR;
    if constexpr (Epi::AFTER_DRAIN) { E.fused(acc, cur, wr, wc, fr, fq, lds, wid, lane); S.done(cur); }
#undef PG8_SA
#undef PG8_SB
#undef PG8_STAGE
#undef PG8_LDA
#undef PG8_LDB
#undef PG8_MMA
#undef PG8_WAIT_V
#undef PG8_WAIT_L
#undef PG8_BAR
#undef PG8_SCHED
}
}

__host__ __device__ __forceinline__ int wt_src_col(int n) {
    if (n < 2048) return n;
    if (n >= 3584) return n + 8;
    const int pn = n >> 8, vc = n & 255, bj = vc >> 7, wc = (vc >> 5) & 3, i = vc & 31;
    return 2056 + ((pn - 8) >> 1) * 512 + (4 * (pn & 1) + wc) * 64 + 32 * bj + i;
}
__host__ __device__ __forceinline__ int att_perm(int t) { return ((t & 15) << 8) | (t >> 4); }
struct EpiProjSplit {
    static constexpr bool PERM = true, AFTER_DRAIN = false;
    unsigned char* ws; const float *qw, *kw;
    __device__ __forceinline__ static pg8::u32x4 pack8(const f32x4 v0, const f32x4 v1) { pg8::u32x4 w;
        w.x = pg8::cvt_pk_bf16(v0[0], v0[1]); w.y = pg8::cvt_pk_bf16(v0[2], v0[3]); w.z = pg8::cvt_pk_bf16(v1[0], v1[1]); w.w = pg8::cvt_pk_bf16(v1[2], v1[3]); return w; }
    __device__ __forceinline__ void operator()(const f32x4 (&acc)[2][2][4][2], const pg8::Unit& u, int wr, int wc, int fr, int fq) const {
        const int pn = u.pn, row0 = u.pm * 256 + wr * 64 + fr;
        if (pn < 8 || pn >= 14) {
            const size_t boff = pn < 6 ? OFF_PROJDN : (pn < 8 ? OFF_Z : OFF_GATE);
            const int ld = pn < 6 ? 1536 : 512, colt = pn < 6 ? pn * 256 : (pn & 1) * 256; const bool act = pn >= 6;
            bf16_t* base = (bf16_t*)(ws + boff);
            const int col0 = colt + wc * 32 + 8 * fq;
#pragma unroll
            for (int ai = 0; ai < 2; ++ai)
#pragma unroll
                for (int m = 0; m < 4; ++m) { bf16_t* rowp = base + (size_t)(row0 + ai * 128 + m * 16) * ld + col0;
#pragma unroll
                    for (int bj = 0; bj < 2; ++bj) { f32x4 v0 = acc[ai][bj][m][0], v1 = acc[ai][bj][m][1];
                        if (act) {
#pragma unroll
                            for (int e = 0; e < 4; ++e) { v0[e] = silu_f(v0[e]); v1[e] = silu_f(v1[e]); } }
                        *(pg8::u32x4*)(rowp + bj * 128) = pack8(v0, v1); } }
        } else {
            const int grp = (pn - 8) >> 1, head = 4 * (pn & 1) + wc;
            bf16_t* base = (bf16_t*)(ws + OFF_AQ + (size_t)grp * (32 * MiB));
            f32x4 wv[2][2];
            if (grp < 2) { const float* w = grp == 0 ? qw : kw; const float sc = grp == 0 ? 0.125f * 1.4426950408889634f : 1.0f;
#pragma unroll
                for (int bj = 0; bj < 2; ++bj)
#pragma unroll
                    for (int n = 0; n < 2; ++n) wv[bj][n] = *(const f32x4*)(w + 32 * bj + 8 * fq + 4 * n) * sc; }
#pragma unroll
            for (int ai = 0; ai < 2; ++ai)
#pragma unroll
                for (int m = 0; m < 4; ++m) {
                    const int r = row0 + ai * 128 + m * 16, b = r >> 12, t = r & 4095;
                    f32x4 v[2][2];
#pragma unroll
                    for (int bj = 0; bj < 2; ++bj)
#pragma unroll
                        for (int n = 0; n < 2; ++n) v[bj][n] = acc[ai][bj][m][n];
                    if (grp < 2) {
                        float ss = 0.f;
#pragma unroll
                        for (int bj = 0; bj < 2; ++bj)
#pragma unroll
                            for (int n = 0; n < 2; ++n) ss += v[bj][n][0] * v[bj][n][0] + v[bj][n][1] * v[bj][n][1] + v[bj][n][2] * v[bj][n][2] + v[bj][n][3] * v[bj][n][3];
                        ss += __shfl_xor(ss, 16); ss += __shfl_xor(ss, 32);
                        const float rstd = rsqrtf(ss * (1.0f / 64.f) + EPS);
#pragma unroll
                        for (int bj = 0; bj < 2; ++bj)
#pragma unroll
                            for (int n = 0; n < 2; ++n) v[bj][n] = v[bj][n] * rstd * wv[bj][n];
                    }
                    bf16_t* dst = base + ((size_t)(b * 8 + head) * SEQ + att_perm(t)) * 64 + 8 * fq;
                    *(pg8::u32x4*)(dst) = pack8(v[0][0], v[0][1]);
                    *(pg8::u32x4*)(dst + 32) = pack8(v[1][0], v[1][1]);
                }
        }
    }
};
struct EpiOutRes {
    static constexpr bool PERM = false, AFTER_DRAIN = false;
    const float* X; float* C;
    __device__ __forceinline__ void operator()(const f32x4 (&acc)[2][2][4][2], const pg8::Unit& u, int wr, int wc, int fr, int fq) const {
        const int row0 = u.pm * 256 + wr * 64 + fr, col0 = u.pn * 256 + wc * 32 + 4 * fq;
#pragma unroll
        for (int ai = 0; ai < 2; ++ai)
#pragma unroll
            for (int m = 0; m < 4; ++m) { const size_t off = (size_t)(row0 + ai * 128 + m * 16) * DM + col0;
#pragma unroll
                for (int bj = 0; bj < 2; ++bj)
#pragma unroll
                    for (int n = 0; n < 2; ++n) { const size_t o = off + bj * 128 + n * 16; *(f32x4*)(C + o) = *(const f32x4*)(X + o) + acc[ai][bj][m][n]; } }
    }
};

__device__ void phase_weights(const Params& p, float* tile  ) {
    bf16_t* wt_in = (bf16_t*)(p.ws + OFF_WTIN); bf16_t* wt_out = (bf16_t*)(p.ws + OFF_WTOUT);
    const int tid = opaque_tid();
    constexpr int T_IN = (DM / 64) * (NPK / 64), T_OUT = (DM / 64) * (DM / 64);
    for (int t = blockIdx.x; t < T_IN + T_OUT; t += gridDim.x) {
        const bool is_in = t < T_IN; const int tt = is_in ? t : t - T_IN, ntn = is_in ? NPK / 64 : DM / 64, k0 = (tt / ntn) * 64, n0 = (tt % ntn) * 64;
        const float* src = is_in ? p.w_in : p.w_out; const int ld = is_in ? DIN : DM;
        const int n = tid & 63, col = is_in ? wt_src_col(n0 + n) : n0 + n;
        __syncthreads();
#pragma unroll
        for (int rep = 0; rep < 8; ++rep) { const int k = rep * 8 + (tid >> 6); tile[k * 65 + n] = src[(size_t)(k0 + k) * ld + col]; }
        __syncthreads();
        const int nn = tid >> 3, k8 = (tid & 7) * 8;
        u32x4_t o;
        o.x = pk_bf16(tile[(k8 + 0) * 65 + nn], tile[(k8 + 1) * 65 + nn]); o.y = pk_bf16(tile[(k8 + 2) * 65 + nn], tile[(k8 + 3) * 65 + nn]);
        o.z = pk_bf16(tile[(k8 + 4) * 65 + nn], tile[(k8 + 5) * 65 + nn]); o.w = pk_bf16(tile[(k8 + 6) * 65 + nn], tile[(k8 + 7) * 65 + nn]);
        *(u32x4_t*)((is_in ? wt_in : wt_out) + (size_t)(n0 + nn) * DM + k0 + k8) = o;
    }
}

__device__ void phase_norm(const Params& p, float* lds_w8  ) {
    bf16_t* xn = (bf16_t*)(p.ws + OFF_XN); float* beta = (float*)(p.ws + OFF_BETA); float* gdec = (float*)(p.ws + OFF_G);
    const int tid = opaque_tid();
    for (int i = tid; i < 1024 * 8; i += blockDim.x) { const int k = i >> 3, j = i & 7; lds_w8[j * 1024 + k] = p.w_in[(size_t)k * DIN + 2048 + j]; }
    __syncthreads();
    const int lane = tid & 63, wpb = blockDim.x >> 6, gw = blockIdx.x * wpb + (tid >> 6), nw = gridDim.x * wpb;
    f32x4 nw4[4];
#pragma unroll
    for (int i = 0; i < 4; ++i) nw4[i] = *(const f32x4*)(p.norm_w + i * 256 + lane * 4);
    f32x4 xa_[4], xb_[4];
#define NORM_LD(dst, row_) do { _Pragma("unroll") for (int i = 0; i < 4; ++i) dst[i] = *(const f32x4*)(p.x + (size_t)(row_) * DM + i * 256 + lane * 4); } while (0)
    if (gw < MROWS) NORM_LD(xa_, gw);
    if (gw + nw < MROWS) NORM_LD(xb_, gw + nw);
    auto process = [&](f32x4 (&xv)[4], const int row) __attribute__((always_inline)) {
        float ss = 0.f, acc[8];
#pragma unroll
        for (int j = 0; j < 8; ++j) acc[j] = 0.f;
        f32x4 hu[4];
#pragma unroll
        for (int i = 0; i < 4; ++i) {
            ss += xv[i][0] * xv[i][0] + xv[i][1] * xv[i][1] + xv[i][2] * xv[i][2] + xv[i][3] * xv[i][3];
            hu[i] = xv[i] * nw4[i];
#pragma unroll
            for (int j = 0; j < 8; ++j) { const f32x4 wj = *(const f32x4*)(lds_w8 + j * 1024 + i * 256 + lane * 4); acc[j] += hu[i][0] * wj[0] + hu[i][1] * wj[1] + hu[i][2] * wj[2] + hu[i][3] * wj[3]; }
        }
        if (row + 2 * nw < MROWS) NORM_LD(xv, row + 2 * nw);
        ss = wave_sum(ss);
        const float rstd = rsqrtf(ss * (1.0f / DM) + EPS);
#pragma unroll
        for (int i = 0; i < 4; ++i) { const f32x4 h = hu[i] * rstd; uint2 pk; pk.x = pk_bf16(h[0], h[1]); pk.y = pk_bf16(h[2], h[3]); *(uint2*)(xn + (size_t)row * DM + i * 256 + lane * 4) = pk; }
        float a1[4], a2[2], a3;
#pragma unroll
        for (int j = 0; j < 4; ++j) { const bool hi = lane & 1; const float keep = hi ? acc[2 * j + 1] : acc[2 * j], send = hi ? acc[2 * j] : acc[2 * j + 1]; a1[j] = keep + __shfl_xor(send, 1); }
#pragma unroll
        for (int j = 0; j < 2; ++j) { const bool hi = lane & 2; const float keep = hi ? a1[2 * j + 1] : a1[2 * j], send = hi ? a1[2 * j] : a1[2 * j + 1]; a2[j] = keep + __shfl_xor(send, 2); }
        { const bool hi = lane & 4; const float keep = hi ? a2[1] : a2[0], send = hi ? a2[0] : a2[1]; a3 = keep + __shfl_xor(send, 4); }
        a3 += __shfl_xor(a3, 8); a3 += __shfl_xor(a3, 16); a3 += __shfl_xor(a3, 32);
        const int b = row / SEQ, sq = row % SEQ;
        if (lane < 8) {
            const float v = a3 * rstd; const int j = lane & 3;
            if (lane < 4) beta[((size_t)b * 4 + j) * SEQ + sq] = 1.0f / (1.0f + expf(-v));
            else { const float xx = v + p.dt_bias[j]; const float sp = xx > 20.f ? xx : log1pf(expf(xx)); gdec[((size_t)b * 4 + j) * SEQ + sq] = -expf(p.a_log[j]) * sp; }
        }
    };
    for (int row = gw; row < MROWS; row += 2 * nw) { process(xa_, row); if (row + nw < MROWS) process(xb_, row + nw); }
#undef NORM_LD
}

__device__ void phase_dn_prep(const Params& p) {
    const bf16_t* proj = (const bf16_t*)(p.ws + OFF_PROJDN);
    bf16_t* qn = (bf16_t*)(p.ws + OFF_DNQ); bf16_t* kn = (bf16_t*)(p.ws + OFF_DNK); bf16_t* vimg = (bf16_t*)(p.ws + OFF_VIMG);
    const float* gdec = (const float*)(p.ws + OFF_G); float* gcum = (float*)(p.ws + OFF_GCUM);
    const int tid = opaque_tid(), lane = tid & 63, w = tid >> 6, h = lane >> 4, d8 = (lane & 15) * 8;
    constexpr int NIT = NB * 64 * 3;
    u32x4_t rawn[11];
#define PREP_LD(it_) do { const int u_ = (it_) / 3, g_ = (it_) - 3 * u_, b_ = u_ >> 6, t0_ = (u_ & 63) * 64; \
        _Pragma("unroll") for (int rr = 0; rr < 11; ++rr) { const int tt = t0_ + 8 * w - 3 + rr; rawn[rr] = tt >= 0 ? *(const u32x4_t*)(proj + (size_t)(b_ * SEQ + tt) * 1536 + g_ * 512 + 8 * lane) : (u32x4_t){0u, 0u, 0u, 0u}; } } while (0)
    int it = blockIdx.x * 3;
    if (it < NIT) PREP_LD(it);
    for (; it < NIT; it = ((it % 3) == 2) ? it - 2 + 3 * (int)gridDim.x : it + 1) {
        const int unit = it / 3, g = it - 3 * unit, b = unit >> 6, n = unit & 63, t0 = n * 64, chunk = (b * 4 + h) * 64 + n;
        u32x4_t raw[11];
#pragma unroll
        for (int rr = 0; rr < 11; ++rr) raw[rr] = rawn[rr];
        { const int itn = (g == 2) ? it - 2 + 3 * (int)gridDim.x : it + 1; if (itn < NIT) PREP_LD(itn); }
        f32x4 cw[4][2];
#pragma unroll
        for (int i = 0; i < 4; ++i) { cw[i][0] = *(const f32x4*)(p.conv_w + i * 1536 + g * 512 + 8 * lane); cw[i][1] = *(const f32x4*)(p.conv_w + i * 1536 + g * 512 + 8 * lane + 4); }
        float y[8][8];
#pragma unroll
        for (int pp = 0; pp < 8; ++pp) {
            float a[8];
#pragma unroll
            for (int e = 0; e < 8; ++e) a[e] = 0.f;
#pragma unroll
            for (int i = 0; i < 4; ++i) { float x[8]; unpack8(raw[pp + i], x);
#pragma unroll
                for (int e = 0; e < 8; ++e) a[e] += cw[i][e >> 2][e & 3] * x[e]; }
#pragma unroll
            for (int e = 0; e < 8; ++e) y[pp][e] = silu_f(a[e]);
        }
        if (g < 2) {
            bf16_t* dst = g == 0 ? qn : kn; const float sc = g == 0 ? 0.08838834764831845f : 1.0f;
#pragma unroll
            for (int pp = 0; pp < 8; ++pp) {
                float ss = 0.f;
#pragma unroll
                for (int e = 0; e < 8; ++e) ss += y[pp][e] * y[pp][e];
                ss += __shfl_xor(ss, 1); ss += __shfl_xor(ss, 2); ss += __shfl_xor(ss, 4); ss += __shfl_xor(ss, 8);
                const float rs = rsqrtf(ss + EPS) * sc;
                u32x4_t o; o.x = pk_bf16(y[pp][0] * rs, y[pp][1] * rs); o.y = pk_bf16(y[pp][2] * rs, y[pp][3] * rs); o.z = pk_bf16(y[pp][4] * rs, y[pp][5] * rs); o.w = pk_bf16(y[pp][6] * rs, y[pp][7] * rs);
                *(u32x4_t*)(dst + ((size_t)chunk * 64 + 8 * w + pp) * 128 + d8) = o;
            }
        } else {
#pragma unroll
            for (int e = 0; e < 8; ++e)
#pragma unroll
                for (int hs = 0; hs < 2; ++hs) {
                    u32x2_t v; v.x = pk_bf16(y[4 * hs][e], y[4 * hs + 1][e]); v.y = pk_bf16(y[4 * hs + 2][e], y[4 * hs + 3][e]);
                    *(u32x2_t*)(vimg + vimg_index(chunk, 8 * w + 4 * hs, d8 + e)) = v;
                }
        }
        if (g == 0 && w < 4) {
            const int bh = b * 4 + w, c2 = bh * 64 + n;
            float v = gdec[(size_t)bh * SEQ + t0 + lane];
#pragma unroll
            for (int o = 1; o < 64; o <<= 1) { const float t = __shfl_up(v, o); if (lane >= o) v += t; }
            gcum[(size_t)c2 * 64 + lane] = v;
            const float glast = __shfl(v, 63), bt = ((const float*)(p.ws + OFF_BETA))[(size_t)bh * SEQ + t0 + lane], eg = __expf(v);
            float* sct = (float*)(p.ws + OFF_SCT) + (size_t)c2 * 256;
            sct[lane] = eg; sct[64 + lane] = bt * eg; sct[128 + lane] = __expf(glast - v); sct[192 + lane] = bt;
        }
    }
#undef PREP_LD
}

constexpr int D1B_LDS_PER_WAVE = 512;
__device__ void phase_dn_chunk(const Params& p, unsigned char* smem) {
    const bf16_t* qn = (const bf16_t*)(p.ws + OFF_DNQ); const bf16_t* kn = (const bf16_t*)(p.ws + OFF_DNK);
    const float* beta = (const float*)(p.ws + OFF_BETA); const float* gcum = (const float*)(p.ws + OFF_GCUM);
    bf16_t* Tm = (bf16_t*)(p.ws + OFF_T); bf16_t* attn = (bf16_t*)(p.ws + OFF_ATTN);
    const int tid0 = opaque_tid(), w = tid0 >> 6, lane = tid0 & 63, r = lane & 31, hh = lane >> 5;
    LDSP float* tg = (LDSP float*)((LDSP unsigned char*)smem + w * D1B_LDS_PER_WAVE); LDSP float* tb = tg + 64;
    for (int c = blockIdx.x * 8 + w; c < NB * 4 * 64; c += gridDim.x * 8) {
        const int bh = c >> 6, n = c & 63;
        tg[lane] = gcum[(size_t)c * 64 + lane]; tb[lane] = beta[(size_t)bh * SEQ + n * 64 + lane];
        const bf16_t* kp = kn + ((size_t)c * 64 + r) * 128 + 8 * hh; const bf16_t* qp = qn + ((size_t)c * 64 + r) * 128 + 8 * hh;
        f32x16 A00, A10, A11;
#define D1B_TILE_A(tile, rt, ct) do { _Pragma("unroll") for (int i = 0; i < 16; ++i) tile[i] = 0.f; \
        _Pragma("unroll 4") for (int s = 0; s < 8; ++s) { const bf16x8 ka = *(const bf16x8*)(kp + (rt) * 32 * 128 + 16 * s), kb2 = *(const bf16x8*)(kp + (ct) * 32 * 128 + 16 * s); tile = MFMA32(ka, kb2, tile); } \
        const float gcc = tg[32 * (ct) + r]; \
        _Pragma("unroll") for (int g4 = 0; g4 < 4; ++g4) { const int j0 = 32 * (rt) + 8 * g4 + 4 * hh; const f32x4 gj = *(const LDSP f32x4*)(tg + j0), bj = *(const LDSP f32x4*)(tb + j0); \
            _Pragma("unroll") for (int e = 0; e < 4; ++e) tile[4 * g4 + e] *= bj[e] * __expf(fminf(gj[e] - gcc, 0.f)); } } while (0)
        D1B_TILE_A(A00, 0, 0); D1B_TILE_A(A10, 1, 0); D1B_TILE_A(A11, 1, 1);
#undef D1B_TILE_A
        float Tr[64];
        int lane_o = lane; asm volatile("" : "+v"(lane_o));
#pragma unroll
        for (int cc = 63; cc >= 0; --cc) {
            float a0 = (lane_o == cc) ? 1.f : 0.f, a1 = 0.f;
            int z = 0;
            if (cc < 63) asm volatile("" : "+s"(z) : "v"(Tr[cc + 1]));
#pragma unroll
            for (int j = cc + 1; j < 64; ++j) {
                const int rt = j >> 5, ct = cc >> 5, i = 4 * ((j & 31) >> 3) + (j & 3), src = (cc & 31) + 32 * ((j >> 2) & 1);
                const float av = __int_as_float(__builtin_amdgcn_readlane(__float_as_int(rt == 0 ? A00[i] : (ct == 0 ? A10[i] : A11[i])), src + z));
                if (j & 1) a1 = __builtin_fmaf(-Tr[j], av, a1); else a0 = __builtin_fmaf(-Tr[j], av, a0);
            }
            Tr[cc] = a0 + a1;
        }
#pragma unroll
        for (int q = 0; q < 4; ++q)
#pragma unroll
            for (int half = 0; half < 2; ++half) { u32x4_t o;
                const int s0 = 8 * half;
                o.x = pk_bf16(Tr[16 * q + perm16(s0 + 0)], Tr[16 * q + perm16(s0 + 0) + 1]); o.y = pk_bf16(Tr[16 * q + perm16(s0 + 2)], Tr[16 * q + perm16(s0 + 2) + 1]);
                o.z = pk_bf16(Tr[16 * q + perm16(s0 + 4)], Tr[16 * q + perm16(s0 + 4) + 1]); o.w = pk_bf16(Tr[16 * q + perm16(s0 + 6)], Tr[16 * q + perm16(s0 + 6) + 1]);
                *(u32x4_t*)(Tm + ((size_t)c * 64 + lane) * 64 + 16 * q + s0) = o; }
#define D1B_TILE_ATT(jt, it) do { f32x16 tile; _Pragma("unroll") for (int i = 0; i < 16; ++i) tile[i] = 0.f; \
        _Pragma("unroll 4") for (int s = 0; s < 8; ++s) { const bf16x8 ka = *(const bf16x8*)(kp + (jt) * 32 * 128 + 16 * s), qb2 = *(const bf16x8*)(qp + (it) * 32 * 128 + 16 * s); tile = MFMA32(ka, qb2, tile); } \
        const int qi = 32 * (it) + r; const float gi = tg[qi]; \
        _Pragma("unroll") for (int s2 = 0; s2 < 2; ++s2) { float v[8]; \
            _Pragma("unroll") for (int a = 0; a < 2; ++a) { const int j0 = 32 * (jt) + 16 * s2 + 8 * a + 4 * hh; const f32x4 gj = *(const LDSP f32x4*)(tg + j0); \
                _Pragma("unroll") for (int e = 0; e < 4; ++e) v[4 * a + e] = (qi >= j0 + e) ? __expf(fminf(gi - gj[e], 0.f)) * tile[8 * s2 + 4 * a + e] : 0.f; } \
            u32x4_t o; o.x = pk_bf16(v[0], v[1]); o.y = pk_bf16(v[2], v[3]); o.z = pk_bf16(v[4], v[5]); o.w = pk_bf16(v[6], v[7]); \
            *(u32x4_t*)(attn + ((size_t)c * 64 + qi) * 64 + 32 * (jt) + 16 * s2 + 8 * hh) = o; } \
        asm volatile("" ::: "memory"); } while (0)
        D1B_TILE_ATT(0, 0); D1B_TILE_ATT(0, 1); D1B_TILE_ATT(1, 1);
#undef D1B_TILE_ATT
    }
}

typedef short s16x4_tt __attribute__((ext_vector_type(4)));
constexpr int SCAN_BUF = 49152, SCAN_TBL = 3 * SCAN_BUF;
__device__ __forceinline__ int swz256(int row, int ch) { return (row * 16 + (ch ^ (((row & 3) << 2) | ((row >> 2) & 3)))) * 16; }
__device__ __forceinline__ int swz128(int row, int ch) { const int sr = row >> 1; return (sr * 16 + ((((row & 1) << 3) | ch) ^ (sr & 7))) * 16; }
__device__ void phase_dn_scan(const Params& p, unsigned char* smem, int bh) {
    const unsigned char* qnb = p.ws + OFF_DNQ; const unsigned char* knb = p.ws + OFF_DNK;
    const unsigned char* tb_ = p.ws + OFF_T; const unsigned char* atb = p.ws + OFF_ATTN;
    const bf16_t* vimg = (const bf16_t*)(p.ws + OFF_VIMG); bf16_t* orm = (bf16_t*)(p.ws + OFF_ODN);
    const int tid = opaque_tid(), lane = tid & 63, w = __builtin_amdgcn_readfirstlane(tid >> 6), r = lane & 31, hh = lane >> 5;
    LDSP unsigned char* lds = (LDSP unsigned char*)smem;
    auto stage = [&](int n, int bsel) {
        const size_t chunk = (size_t)bh * 64 + n;
        int ln = lane; asm volatile("" : "+v"(ln)); ln &= 63;
#pragma unroll
        for (int i = 0; i < 12; ++i) {
            const int k = (w - 4) * 12 + i; const unsigned char* src;
            if (k < 32) { const int sl = (k & 15) * 64 + ln, row = sl >> 4, ch = (sl & 15) ^ (((row & 3) << 2) | ((row >> 2) & 3)); src = (k < 16 ? knb : qnb) + chunk * 16384 + row * 256 + ch * 16; }
            else { const int sl = (k < 40 ? (k - 32) : (k - 40)) * 64 + ln, sr = sl >> 4, lp = (sl & 15) ^ (sr & 7), row = sr * 2 + (lp >> 3), ch = lp & 7;
                   src = (k < 40 ? tb_ : atb) + chunk * 8192 + row * 128 + ch * 16; }
            __builtin_amdgcn_global_load_lds((const unsigned*)src, (LDSP unsigned*)(lds + bsel * SCAN_BUF + k * 1024), 16, 0, 0);
        }
        if (w == 7) __builtin_amdgcn_global_load_lds((const unsigned*)(p.ws + OFF_SCT + chunk * 1024 + ln * 16), (LDSP unsigned*)(lds + SCAN_TBL + bsel * 1024), 16, 0, 0);
    };
#define SCAN_WAIT_STAGE() do { if (w == 7) asm volatile("s_waitcnt vmcnt(13)" ::: "memory"); else asm volatile("s_waitcnt vmcnt(12)" ::: "memory"); } while (0)
#define SCAN_BAR() do { asm volatile("" ::: "memory"); __builtin_amdgcn_s_barrier(); asm volatile("" ::: "memory"); } while (0)
    f32x16 S[4];
#pragma unroll
    for (int dt = 0; dt < 4; ++dt)
#pragma unroll
        for (int i = 0; i < 16; ++i) S[dt][i] = 0.f;
#define SCAN_SB(kc) __builtin_bit_cast(bf16x8, (u32x4_t){pk_bf16(S[(kc) >> 1][8 * ((kc) & 1)], S[(kc) >> 1][8 * ((kc) & 1) + 1]), pk_bf16(S[(kc) >> 1][8 * ((kc) & 1) + 2], S[(kc) >> 1][8 * ((kc) & 1) + 3]), \
                                                     pk_bf16(S[(kc) >> 1][8 * ((kc) & 1) + 4], S[(kc) >> 1][8 * ((kc) & 1) + 5]), pk_bf16(S[(kc) >> 1][8 * ((kc) & 1) + 6], S[(kc) >> 1][8 * ((kc) & 1) + 7])})
#define SCAN_LDV(dst, ch_) do { _Pragma("unroll") for (int pt = 0; pt < 2; ++pt) _Pragma("unroll") for (int g = 0; g < 2; ++g) dst[pt][g] = *(const u32x4_t*)(vimg + ((((((size_t)bh * 64 + (ch_)) * 4 + w) * 2 + pt) * 2 + g) * 64 + lane) * 8); } while (0)
    u32x4_t vr[2][2], vrn[2][2];
    if (w < 4) { SCAN_LDV(vr, 0); SCAN_LDV(vrn, 1); }
    else { stage(0, 0); stage(1, 1); SCAN_WAIT_STAGE(); }
    SCAN_BAR();
    int bsel = 0;
    for (int n = 0; n < 64; ++n) {
        int bnx = bsel + 2; bnx = bnx >= 3 ? bnx - 3 : bnx;
        if (w >= 4 && n + 2 < 64) stage(n + 2, bnx);
        if (w < 4) {
            const size_t chunk = (size_t)bh * 64 + n;
            u32x4_t vrn2[2][2];
            if (n + 2 < 64) SCAN_LDV(vrn2, n + 2);
            LDSP unsigned char* B = lds + bsel * SCAN_BUF; LDSP float* teg = (LDSP float*)(lds + SCAN_TBL + bsel * 1024); LDSP float* tbeg = teg + 64; LDSP float* tet = teg + 128; LDSP float* tbt = teg + 192;
            LDSP unsigned char* Bkn = B, *Bqn = B + 16384, *BT = B + 32768, *Bat = B + 40960;
            f32x16 X[2], O[2];
#pragma unroll
            for (int i = 0; i < 16; ++i) { X[0][i] = 0.f; X[1][i] = 0.f; O[0][i] = 0.f; O[1][i] = 0.f; }
#pragma unroll
            for (int kc = 0; kc < 8; ++kc) {
                const bf16x8 a0 = *(const LDSP bf16x8*)(Bkn + swz256(r, 2 * kc + hh)), a1 = *(const LDSP bf16x8*)(Bkn + swz256(32 + r, 2 * kc + hh));
                const bf16x8 q0 = *(const LDSP bf16x8*)(Bqn + swz256(r, 2 * kc + hh)), q1 = *(const LDSP bf16x8*)(Bqn + swz256(32 + r, 2 * kc + hh));
                const bf16x8 sb = SCAN_SB(kc); X[0] = MFMA32(a0, sb, X[0]); X[1] = MFMA32(a1, sb, X[1]); O[0] = MFMA32(q0, sb, O[0]); O[1] = MFMA32(q1, sb, O[1]);
            }
            asm volatile("" ::: "memory");
            bf16x8 Yb[2][2];
#pragma unroll
            for (int pt = 0; pt < 2; ++pt) {
                unsigned yp[8];
#pragma unroll
                for (int g4 = 0; g4 < 4; ++g4) { const int j0 = 32 * pt + 8 * g4 + 4 * hh; const f32x4 bg = *(const LDSP f32x4*)(tbeg + j0), bj = *(const LDSP f32x4*)(tbt + j0);
                    float yv[4];
#pragma unroll
                    for (int e = 0; e < 4; ++e) { const int i = 4 * g4 + e;
                        const unsigned vw = vr[pt][i >> 3][(i & 7) >> 1]; const float vv = (i & 1) ? bfhi(vw) : bflo(vw);
                        yv[e] = bj[e] * vv - bg[e] * X[pt][i]; }
                    yp[2 * g4] = pk_bf16(yv[0], yv[1]); yp[2 * g4 + 1] = pk_bf16(yv[2], yv[3]); }
#pragma unroll
                for (int s = 0; s < 2; ++s) { u32x4_t t4; t4.x = yp[4 * s]; t4.y = yp[4 * s + 1]; t4.z = yp[4 * s + 2]; t4.w = yp[4 * s + 3]; Yb[pt][s] = __builtin_bit_cast(bf16x8, t4); }
            }
            asm volatile("" ::: "memory");
            f32x16 Vn[2];
#pragma unroll
            for (int i = 0; i < 16; ++i) { Vn[0][i] = 0.f; Vn[1][i] = 0.f; }
#pragma unroll
            for (int kc = 0; kc < 4; ++kc) {
                if (kc < 2) { const bf16x8 a0 = *(const LDSP bf16x8*)(BT + swz128(r, 2 * kc + hh)); Vn[0] = MFMA32(a0, Yb[kc >> 1][kc & 1], Vn[0]); }
                const bf16x8 a1 = *(const LDSP bf16x8*)(BT + swz128(32 + r, 2 * kc + hh)); Vn[1] = MFMA32(a1, Yb[kc >> 1][kc & 1], Vn[1]);
            }
            asm volatile("" ::: "memory");
            bf16x8 Vnb[2][2], Vsb[2][2];
#pragma unroll
            for (int pt = 0; pt < 2; ++pt) {
                unsigned np[8], sp[8];
#pragma unroll
                for (int g4 = 0; g4 < 4; ++g4) { const int j0 = 32 * pt + 8 * g4 + 4 * hh; const f32x4 et = *(const LDSP f32x4*)(tet + j0);
                    np[2 * g4] = pk_bf16(Vn[pt][4 * g4], Vn[pt][4 * g4 + 1]); np[2 * g4 + 1] = pk_bf16(Vn[pt][4 * g4 + 2], Vn[pt][4 * g4 + 3]);
                    sp[2 * g4] = pk_bf16(Vn[pt][4 * g4] * et[0], Vn[pt][4 * g4 + 1] * et[1]); sp[2 * g4 + 1] = pk_bf16(Vn[pt][4 * g4 + 2] * et[2], Vn[pt][4 * g4 + 3] * et[3]); }
#pragma unroll
                for (int s = 0; s < 2; ++s) { u32x4_t a4, b4; a4.x = np[4 * s]; a4.y = np[4 * s + 1]; a4.z = np[4 * s + 2]; a4.w = np[4 * s + 3]; b4.x = sp[4 * s]; b4.y = sp[4 * s + 1]; b4.z = sp[4 * s + 2]; b4.w = sp[4 * s + 3];
                    Vnb[pt][s] = __builtin_bit_cast(bf16x8, a4); Vsb[pt][s] = __builtin_bit_cast(bf16x8, b4); }
            }
            asm volatile("" ::: "memory");
#pragma unroll
            for (int pt = 0; pt < 2; ++pt)
#pragma unroll
                for (int g4 = 0; g4 < 4; ++g4) { const int j0 = 32 * pt + 8 * g4 + 4 * hh; const f32x4 eg = *(const LDSP f32x4*)(teg + j0);
#pragma unroll
                    for (int e = 0; e < 4; ++e) O[pt][4 * g4 + e] *= eg[e]; }
#pragma unroll
            for (int kc = 0; kc < 4; ++kc) {
                if (kc < 2) { const bf16x8 a0 = *(const LDSP bf16x8*)(Bat + swz128(r, 2 * kc + hh)); O[0] = MFMA32(a0, Vnb[kc >> 1][kc & 1], O[0]); }
                const bf16x8 a1 = *(const LDSP bf16x8*)(Bat + swz128(32 + r, 2 * kc + hh)); O[1] = MFMA32(a1, Vnb[kc >> 1][kc & 1], O[1]);
            }
#pragma unroll
            for (int pt = 0; pt < 2; ++pt)
#pragma unroll
                for (int g = 0; g < 2; ++g) { u32x4_t o; o.x = pk_bf16(O[pt][8 * g], O[pt][8 * g + 1]); o.y = pk_bf16(O[pt][8 * g + 2], O[pt][8 * g + 3]); o.z = pk_bf16(O[pt][8 * g + 4], O[pt][8 * g + 5]); o.w = pk_bf16(O[pt][8 * g + 6], O[pt][8 * g + 7]);
                    *(u32x4_t*)(orm + (((((size_t)chunk * 4 + w) * 2 + pt) * 2 + g) * 64 + lane) * 8) = o; }
            const float glf = teg[63];
            const int blk16 = (lane >> 4) & 1, q4 = (lane & 15) >> 2, pp = lane & 3;
#pragma unroll
            for (int dt = 0; dt < 4; ++dt) {
#pragma unroll
                for (int i = 0; i < 16; ++i) S[dt][i] *= glf;
#pragma unroll
                for (int kc = 0; kc < 4; ++kc) {
                    const int row0 = 16 * kc + 4 * hh + q4, ch = 4 * dt + 2 * blk16 + (pp & 1), sub = 8 * (pp >> 1);
                    const s16x4_tt lo = __builtin_amdgcn_ds_read_tr16_b64_v4i16((LDSP s16x4_tt*)(Bkn + swz256(row0, ch) + sub)), hi = __builtin_amdgcn_ds_read_tr16_b64_v4i16((LDSP s16x4_tt*)(Bkn + swz256(row0 + 8, ch) + sub));
                    S[dt] = MFMA32(__builtin_shufflevector(lo, hi, 0, 1, 2, 3, 4, 5, 6, 7), Vsb[kc >> 1][kc & 1], S[dt]);
                }
            }
#pragma unroll
            for (int pt = 0; pt < 2; ++pt)
#pragma unroll
                for (int g = 0; g < 2; ++g) { vr[pt][g] = vrn[pt][g]; if (n + 2 < 64) vrn[pt][g] = vrn2[pt][g]; }
            asm volatile("s_waitcnt lgkmcnt(0)" ::: "memory");
        } else {
            if (n + 2 < 64) SCAN_WAIT_STAGE(); else asm volatile("s_waitcnt vmcnt(0)" ::: "memory");
        }
        SCAN_BAR();
        bsel = bsel + 1 >= 3 ? 0 : bsel + 1;
    }
#undef SCAN_WAIT_STAGE
#undef SCAN_BAR
#undef SCAN_LDV
}

__device__ void phase_mix(const Params& p, unsigned char* smem) {
    const bf16_t* odn = (const bf16_t*)(p.ws + OFF_ODN); const bf16_t* zs = (const bf16_t*)(p.ws + OFF_Z);
    bf16_t* mixed = (bf16_t*)(p.ws + OFF_MIXED);
    const int tid = opaque_tid(), lane = tid & 63, w8 = tid >> 6;
    LDSP bf16_t* ot = (LDSP bf16_t*)smem;
    constexpr int OTS = 136;
    const int prow = tid >> 3, d16 = (tid & 7) * 16;
    f32x4 wv[4];
#pragma unroll
    for (int i = 0; i < 4; ++i) wv[i] = *(const f32x4*)(p.dn_norm_w + d16 + 4 * i);
    u32x4_t im[2], zn[2];
#define MIXD_LD(c_) do { const int bh_ = (c_) >> 6, n_ = (c_) & 63; const size_t row_ = (size_t)(bh_ >> 2) * SEQ + n_ * 64 + prow; \
        im[0] = *(const u32x4_t*)(odn + (size_t)(c_) * 8192 + (size_t)tid * 8); im[1] = *(const u32x4_t*)(odn + (size_t)(c_) * 8192 + (size_t)(tid + 512) * 8); \
        zn[0] = *(const u32x4_t*)(zs + row_ * 512 + (bh_ & 3) * 128 + d16); zn[1] = *(const u32x4_t*)(zs + row_ * 512 + (bh_ & 3) * 128 + d16 + 8); } while (0)
    int c = blockIdx.x;
    if (c < NB * 4 * 64) MIXD_LD(c);
    for (; c < NB * 4 * 64; c += gridDim.x) {
        const int bh = c >> 6, n = c & 63, h = bh & 3; const size_t row = (size_t)(bh >> 2) * SEQ + n * 64 + prow;
        __syncthreads();
#pragma unroll
        for (int q = 0; q < 2; ++q) { const int pc = tid + 512 * q, lp = pc & 63, g = (pc >> 6) & 1, pt = (pc >> 7) & 1, ws_ = pc >> 8, dv = 32 * ws_ + (lp & 31), p0 = 32 * pt + 16 * g + 4 * (lp >> 5);
            const unsigned vv[4] = {im[q].x, im[q].y, im[q].z, im[q].w};
#pragma unroll
            for (int jj = 0; jj < 8; ++jj) ot[(p0 + 8 * (jj >> 2) + (jj & 3)) * OTS + dv] = (bf16_t)((jj & 1) ? (vv[jj >> 1] >> 16) : (vv[jj >> 1] & 0xFFFFu)); }
        float z[16]; { float t8[8]; unpack8(zn[0], t8);
#pragma unroll
            for (int e = 0; e < 8; ++e) z[e] = t8[e];
            unpack8(zn[1], t8);
#pragma unroll
            for (int e = 0; e < 8; ++e) z[8 + e] = t8[e]; }
        if (c + (int)gridDim.x < NB * 4 * 64) MIXD_LD(c + (int)gridDim.x);
        __syncthreads();
        float o[16]; { float t8[8]; unpack8(*(const LDSP u32x4_t*)(ot + prow * OTS + d16), t8);
#pragma unroll
            for (int e = 0; e < 8; ++e) o[e] = t8[e];
            unpack8(*(const LDSP u32x4_t*)(ot + prow * OTS + d16 + 8), t8);
#pragma unroll
            for (int e = 0; e < 8; ++e) o[8 + e] = t8[e]; }
        float ss = 0.f;
#pragma unroll
        for (int e = 0; e < 16; ++e) ss += o[e] * o[e];
        ss += __shfl_xor(ss, 1); ss += __shfl_xor(ss, 2); ss += __shfl_xor(ss, 4);
        const float rstd = rsqrtf(ss * (1.0f / 128.f) + EPS);
        u32x4_t r4[2];
#pragma unroll
        for (int q = 0; q < 2; ++q) {
            r4[q].x = pk_bf16(o[8 * q + 0] * rstd * wv[2 * q][0] * z[8 * q + 0], o[8 * q + 1] * rstd * wv[2 * q][1] * z[8 * q + 1]); r4[q].y = pk_bf16(o[8 * q + 2] * rstd * wv[2 * q][2] * z[8 * q + 2], o[8 * q + 3] * rstd * wv[2 * q][3] * z[8 * q + 3]);
            r4[q].z = pk_bf16(o[8 * q + 4] * rstd * wv[2 * q + 1][0] * z[8 * q + 4], o[8 * q + 5] * rstd * wv[2 * q + 1][1] * z[8 * q + 5]); r4[q].w = pk_bf16(o[8 * q + 6] * rstd * wv[2 * q + 1][2] * z[8 * q + 6], o[8 * q + 7] * rstd * wv[2 * q + 1][3] * z[8 * q + 7]);
            *(u32x4_t*)(mixed + row * DM + h * 128 + d16 + 8 * q) = r4[q];
        }
    }
#undef MIXD_LD
    (void)lane; (void)w8;
}

__device__ void phase_att_combine(const Params& p, int vb, int vg) {
    const bf16_t* gate = (const bf16_t*)(p.ws + OFF_GATE); const bf16_t* attp = (const bf16_t*)(p.ws + OFF_ATTP); const float* lse = (const float*)(p.ws + OFF_LSE);
    bf16_t* mixed = (bf16_t*)(p.ws + OFF_MIXED);
    const int tid = opaque_tid(), lane = tid & 63, wpb = blockDim.x >> 6, gw = vb * wpb + (tid >> 6), nw = vg * wpb;
    {
        const int d8 = (lane & 7) * 8; const size_t PS = (size_t)MROWS * 8;
        u32x4_t a0n = {0, 0, 0, 0}, a1n = a0n, a2n = a0n, gtn = a0n; float l0n = 0.f, l1n = 0.f, l2n = 0.f;
#define MIX_LD_AT(g_) do { const int bh_ = (g_) >> 9, t_ = ((g_) & 511) * 8 + (lane >> 3); const size_t q_ = (size_t)bh_ * SEQ + t_, row_ = (size_t)(bh_ >> 3) * SEQ + t_; \
        l0n = lse[q_]; l1n = lse[PS + q_]; l2n = lse[2 * PS + q_]; a0n = *(const u32x4_t*)(attp + q_ * 64 + d8); a1n = *(const u32x4_t*)(attp + (PS + q_) * 64 + d8); a2n = *(const u32x4_t*)(attp + (2 * PS + q_) * 64 + d8); \
        gtn = *(const u32x4_t*)(gate + row_ * 512 + (bh_ & 7) * 64 + d8); } while (0)
        if (gw < MROWS) MIX_LD_AT(gw);
        for (int g = gw; g < MROWS; g += nw) {
            const int bh = g >> 9, t = (g & 511) * 8 + (lane >> 3), b = bh >> 3, h = bh & 7; const size_t row = (size_t)b * SEQ + t;
            const float l0 = l0n, l1 = l1n, l2 = l2n;
            float a0[8], a1[8], a2[8], gt[8];
            unpack8(a0n, a0); unpack8(a1n, a1); unpack8(a2n, a2); unpack8(gtn, gt);
            if (g + nw < MROWS) MIX_LD_AT(g + nw);
            const float mx = fmaxf(l0, fmaxf(l1, l2));
            float w0 = __builtin_amdgcn_exp2f(l0 - mx), w1 = __builtin_amdgcn_exp2f(l1 - mx), w2 = __builtin_amdgcn_exp2f(l2 - mx); const float inv = 1.0f / (w0 + w1 + w2); w0 *= inv; w1 *= inv; w2 *= inv;
            float o[8];
#pragma unroll
            for (int e = 0; e < 8; ++e) o[e] = (w0 * a0[e] + w1 * a1[e] + w2 * a2[e]) * gt[e];
            u32x4_t r4; r4.x = pk_bf16(o[0], o[1]); r4.y = pk_bf16(o[2], o[3]); r4.z = pk_bf16(o[4], o[5]); r4.w = pk_bf16(o[6], o[7]);
            *(u32x4_t*)(mixed + row * DM + 512 + h * 64 + d8) = r4;
        }
#undef MIX_LD_AT
    }
}

__device__ __forceinline__ int t5_bucket_dev(int d) {
    if (d < 16) return d;
    int bkt = 16;
    const int bnd[15] = {22, 30, 40, 54, 73, 99, 134, 182, 246, 332, 450, 609, 825, 1117, 1513};
#pragma unroll
    for (int i = 0; i < 15; ++i) bkt += (d >= bnd[i]) ? 1 : 0;
    return bkt;
}
constexpr int ATT_UNITS = NB * 8 * 48;
constexpr int ATT_K = 0, ATT_V = 49152, ATT_Q = 98304, ATT_RB = 131072, ATT_TAB = ATT_RB + 1024 + 1024;
typedef short s16x4_t __attribute__((ext_vector_type(4)));
struct AttUnit { int pat, rd, res, M0, h; size_t hb; };
__device__ __forceinline__ AttUnit att_decode(int unit) {
    AttUnit a; const int bh = unit / 48, u = unit % 48, v = u & 15; a.pat = u >> 4; a.h = bh & 7; a.hb = (size_t)bh * SEQ;
    a.rd = a.pat == 0 ? 1 : (a.pat == 1 ? 4 : 16); a.res = a.pat == 0 ? 0 : (a.pat == 1 ? (v >> 2) : v); a.M0 = (a.pat == 0 ? v : (a.pat == 1 ? (v & 3) : 0)) * 256; return a;
}
#define ATT_WAITV(n) asm volatile("s_waitcnt vmcnt(" #n ")" ::: "memory")
#define ATT_WAITL() asm volatile("s_waitcnt lgkmcnt(0)" ::: "memory")
#define ATT_BAR() do { asm volatile("" ::: "memory"); __builtin_amdgcn_s_barrier(); asm volatile("" ::: "memory"); } while (0)
#define LDS_RD128(dst, addr) asm volatile("ds_read_b128 %0, %1" : "=v"(dst) : "v"(addr))
#define LDS_RDTR(dst, addr, off) asm volatile("ds_read_b64_tr_b16 %0, %1 offset:%2" : "=v"(dst) : "v"(addr), "i"(off))
#define LDS_RD32(dst, addr) asm volatile("ds_read_b32 %0, %1" : "=v"(dst) : "v"(addr))
#define LDS_WR32(addr, val) asm volatile("ds_write_b32 %0, %1" :: "v"(addr), "v"(val) : "memory")
#define LDS_WAIT4(n, a, b, c, d) asm volatile("s_waitcnt lgkmcnt(" #n ")" : "+v"(a), "+v"(b), "+v"(c), "+v"(d))
__device__ void phase_attn(const Params& p, unsigned char* smem, int vb, int vg) {
    const unsigned char* aqb = p.ws + OFF_AQ; const unsigned char* akb = p.ws + OFF_AK; const unsigned char* avb = p.ws + OFF_AV;
    const int tid = opaque_tid(), w = __builtin_amdgcn_readfirstlane(tid >> 6);
    LDSP unsigned char* lds = (LDSP unsigned char*)smem; const unsigned ldsb = (unsigned)(size_t)lds;
    const bool xcd_map = (vg % 8 == 0) && ((NB * 8) % 8 == 0);
    const int cls = vb & 7, rank = vb >> 3, per_cls = vg >> 3, n_cls_units = (NB * 8 / 8) * 48;
    auto unit_of = [&](int j) -> int { return xcd_map ? ((cls + 8 * (j / 48)) * 48 + (j % 48)) : j; };
    int jj = xcd_map ? rank : vb; const int jstep = xcd_map ? per_cls : vg, jend = xcd_map ? n_cls_units : ATT_UNITS;
    if (jj >= jend) return;
    int unit = unit_of(jj);
    if (tid < 256) ((LDSP float*)(lds + ATT_RB))[tid] = p.rel_bias[tid];
    asm volatile("s_waitcnt vmcnt(0) lgkmcnt(0)" ::: "memory");
    auto issue_kq = [&](const AttUnit& a) {
        int ln = tid; asm volatile("" : "+v"(ln)); ln &= 63;
#pragma unroll
        for (int i = 0; i < 6; ++i) { const int k = w * 6 + i, sl = k * 64 + ln, row = sl >> 3, ch = (sl & 7) ^ ((row >> 1) & 7); int mk = a.M0 - 128 + row; mk = mk < 0 ? 0 : mk;
            __builtin_amdgcn_global_load_lds((const unsigned*)(akb + (a.hb + (size_t)att_perm(mk * a.rd + a.res)) * 128 + ch * 16), (LDSP unsigned*)(lds + ATT_K + k * 1024), 16, 0, 0); }
#pragma unroll
        for (int i = 0; i < 4; ++i) { const int k = w * 4 + i, sl = k * 64 + ln, row = sl >> 3, ch = (sl & 7) ^ ((row >> 1) & 7);
            __builtin_amdgcn_global_load_lds((const unsigned*)(aqb + (a.hb + (size_t)att_perm((a.M0 + row) * a.rd + a.res)) * 128 + ch * 16), (LDSP unsigned*)(lds + ATT_Q + k * 1024), 16, 0, 0); }
    };
    auto issue_v = [&](const AttUnit& a) {
        int ln = tid; asm volatile("" : "+v"(ln)); ln &= 63;
#pragma unroll
        for (int i = 0; i < 6; ++i) { const int k = w * 6 + i, sl = k * 64 + ln, row = sl >> 3, ch = (sl & 7) ^ (((row >> 1) & 1) << 2); int mk = a.M0 - 128 + row; mk = mk < 0 ? 0 : mk;
            __builtin_amdgcn_global_load_lds((const unsigned*)(avb + (a.hb + (size_t)att_perm(mk * a.rd + a.res)) * 128 + ch * 16), (LDSP unsigned*)(lds + ATT_V + k * 1024), 16, 0, 0); }
    };
    AttUnit cur = att_decode(unit);
    issue_kq(cur); issue_v(cur);
    for (;;) {
        const int jn = jj + jstep; const bool has_next = jn < jend; const int nxt = has_next ? unit_of(jn) : unit;
        int lane = tid; asm volatile("" : "+v"(lane)); lane &= 63;
        const int r = lane & 31, hh = lane >> 5, blk16 = (lane >> 4) & 1, q4 = (lane & 15) >> 2, pp = lane & 3;
        if (tid < 129) { float bv; LDS_RD32(bv, ldsb + ATT_RB + (cur.h * 32 + t5_bucket_dev(tid * cur.rd)) * 4); asm volatile("s_waitcnt lgkmcnt(0)" : "+v"(bv)); bv *= 1.4426950408889634f; LDS_WR32(ldsb + ATT_TAB + tid * 4, bv); }
        ATT_WAITV(6); ATT_WAITL(); ATT_BAR();
        const int M0 = cur.M0;
        f32x16 Sc[5];
        {
            const int qrow = 32 * w + r, qsw = (qrow >> 1) & 7;
            bf16x8 qf[4], kf[2][4];
#pragma unroll
            for (int s = 0; s < 4; ++s) LDS_RD128(qf[s], ldsb + ATT_Q + qrow * 128 + (((2 * s + hh) ^ qsw) << 4));
#define ATT_RDK(kt_, dst) do { const int krow_ = 32 * w + 32 * (kt_) + r, ksw_ = (krow_ >> 1) & 7; \
            _Pragma("unroll") for (int s = 0; s < 4; ++s) LDS_RD128(dst[s], ldsb + ATT_K + krow_ * 128 + (((2 * s + hh) ^ ksw_) << 4)); } while (0)
            ATT_RDK(0, kf[0]);
#pragma unroll
            for (int kt = 0; kt < 5; ++kt) {
                if (kt < 4) { ATT_RDK(kt + 1, kf[(kt + 1) & 1]); LDS_WAIT4(4, kf[kt & 1][0], kf[kt & 1][1], kf[kt & 1][2], kf[kt & 1][3]); }
                else LDS_WAIT4(0, kf[kt & 1][0], kf[kt & 1][1], kf[kt & 1][2], kf[kt & 1][3]);
                if (kt == 0) asm volatile("" : "+v"(qf[0]), "+v"(qf[1]), "+v"(qf[2]), "+v"(qf[3]));
#pragma unroll
                for (int i = 0; i < 16; ++i) Sc[kt][i] = 0.f;
                if (kt == 4 || M0 > 0 || w + kt >= 4) {
#pragma unroll
                    for (int s = 0; s < 4; ++s) Sc[kt] = MFMA32(kf[kt & 1][s], qf[s], Sc[kt]);
                }
            }
#undef ATT_RDK
        }
        ATT_WAITL(); ATT_BAR();
        AttUnit nx = cur;
        if (has_next) { nx = att_decode(nxt); issue_kq(nx); }
        const int rr = r - 4 * hh;
        const unsigned bta = ldsb + ATT_TAB + (128 + rr - 159) * 4;
        float mx = -INFINITY;
#pragma unroll
        for (int kt = 0; kt < 5; ++kt) {
            if (kt == 4 || M0 > 0 || w + kt >= 4) {
                float bb[16];
#pragma unroll
                for (int i = 0; i < 16; ++i) asm volatile("ds_read_b32 %0, %1 offset:%2" : "=v"(bb[i]) : "v"(bta), "i"((159 - (32 * kt + 8 * (i >> 2) + (i & 3))) * 4));
                asm volatile("s_waitcnt lgkmcnt(0)" : "+v"(bb[0]), "+v"(bb[1]), "+v"(bb[2]), "+v"(bb[3]), "+v"(bb[4]), "+v"(bb[5]), "+v"(bb[6]), "+v"(bb[7]), "+v"(bb[8]), "+v"(bb[9]), "+v"(bb[10]), "+v"(bb[11]), "+v"(bb[12]), "+v"(bb[13]), "+v"(bb[14]), "+v"(bb[15]));
#pragma unroll
                for (int i = 0; i < 16; ++i) { const int cr = 8 * (i >> 2) + (i & 3);
                    float sc = Sc[kt][i] + bb[i];
                    if (kt == 0) sc = (rr <= cr) ? sc : -INFINITY;
                    if (kt == 4) sc = (rr >= cr) ? sc : -INFINITY;
                    Sc[kt][i] = sc; mx = fmaxf(mx, sc); }
            } else {
#pragma unroll
                for (int i = 0; i < 16; ++i) Sc[kt][i] = -INFINITY;
            }
        }
        mx = fmaxf(mx, __shfl_xor(mx, 32));
        float lsum = 0.f;
#pragma unroll
        for (int kt = 0; kt < 5; ++kt)
#pragma unroll
            for (int i = 0; i < 16; ++i) { const float e = __builtin_amdgcn_exp2f(Sc[kt][i] - mx); Sc[kt][i] = e; lsum += e; }
        lsum += __shfl_xor(lsum, 32);
        if (has_next) ATT_WAITV(10); else ATT_WAITV(0);
        ATT_WAITL(); ATT_BAR();
        f32x16 O[2];
#pragma unroll
        for (int i = 0; i < 16; ++i) { O[0][i] = 0.f; O[1][i] = 0.f; }
        const int xb = (q4 >> 1) & 1;
        const unsigned vl0 = ldsb + ATT_V + (32 * w + 4 * hh + q4) * 128 + ((2 * blk16 + (pp >> 1)) + 4 * xb) * 16 + 8 * (pp & 1);
        const unsigned vl1 = ldsb + ATT_V + (32 * w + 4 * hh + q4) * 128 + ((2 * blk16 + (pp >> 1)) + 4 * (xb ^ 1)) * 16 + 8 * (pp & 1);
        s16x4_t va[2][4];
#define ATT_RDV(it_, dst) do { LDS_RDTR(dst[0], vl0, (it_) * 2048); LDS_RDTR(dst[1], vl0, (it_) * 2048 + 1024); LDS_RDTR(dst[2], vl1, (it_) * 2048); LDS_RDTR(dst[3], vl1, (it_) * 2048 + 1024); } while (0)
        ATT_RDV(0, va[0]);
#pragma unroll
        for (int it = 0; it < 10; ++it) {
            const int kt = it >> 1, s2 = it & 1;
            u32x4_t pk; pk.x = pk_bf16(Sc[kt][8 * s2], Sc[kt][8 * s2 + 1]); pk.y = pk_bf16(Sc[kt][8 * s2 + 2], Sc[kt][8 * s2 + 3]); pk.z = pk_bf16(Sc[kt][8 * s2 + 4], Sc[kt][8 * s2 + 5]); pk.w = pk_bf16(Sc[kt][8 * s2 + 6], Sc[kt][8 * s2 + 7]);
            const bf16x8 pb = __builtin_bit_cast(bf16x8, pk);
            if (it < 9) { ATT_RDV(it + 1, va[(it + 1) & 1]); LDS_WAIT4(4, va[it & 1][0], va[it & 1][1], va[it & 1][2], va[it & 1][3]); }
            else LDS_WAIT4(0, va[it & 1][0], va[it & 1][1], va[it & 1][2], va[it & 1][3]);
            O[0] = MFMA32(__builtin_shufflevector(va[it & 1][0], va[it & 1][1], 0, 1, 2, 3, 4, 5, 6, 7), pb, O[0]);
            O[1] = MFMA32(__builtin_shufflevector(va[it & 1][2], va[it & 1][3], 0, 1, 2, 3, 4, 5, 6, 7), pb, O[1]);
        }
#undef ATT_RDV
        ATT_WAITL(); ATT_BAR();
        const int mq = M0 + 32 * w + r; const size_t tq = cur.hb + (size_t)(mq * cur.rd + cur.res);
        const float inv = 1.0f / lsum;
        bf16_t* op = (bf16_t*)(p.ws + OFF_ATTP) + ((size_t)cur.pat * MROWS * 8 + tq) * 64;
#pragma unroll
        for (int dt = 0; dt < 2; ++dt)
#pragma unroll
            for (int g4 = 0; g4 < 4; ++g4) { u32x2_t o; o.x = pk_bf16(O[dt][4 * g4] * inv, O[dt][4 * g4 + 1] * inv); o.y = pk_bf16(O[dt][4 * g4 + 2] * inv, O[dt][4 * g4 + 3] * inv);
                *(u32x2_t*)(op + 32 * dt + 8 * g4 + 4 * hh) = o; }
        if (hh == 0) ((float*)(p.ws + OFF_LSE))[(size_t)cur.pat * MROWS * 8 + tq] = mx + __log2f(lsum);
        if (!has_next) break;
        issue_v(nx);
        cur = nx; unit = nxt; jj = jn;
    }
    asm volatile("s_waitcnt vmcnt(0)" ::: "memory");
}
#undef ATT_WAITV
#undef ATT_WAITL
#undef ATT_BAR
#undef LDS_RD128
#undef LDS_RDTR
#undef LDS_RD32
#undef LDS_WR32
#undef LDS_WAIT4

#define XB_TMO      128
#define XB_XCNT(j)  (256  + 64 * (j))
#define XB_XSUB(j)  (1280 + 64 * (j))
#define XB_XGEN(j)  (2304 + 64 * (j))
#define XB_TOP      3328
#define XB_TOPGEN   3392
#define XCD_BAR_WORDS 3456
#define XB_SPIN_CAP (1u << 18)
#define LAS __attribute__((address_space(3)))

__device__ __forceinline__ unsigned xb_ld(unsigned* p)              { return __hip_atomic_load(p, __ATOMIC_RELAXED, __HIP_MEMORY_SCOPE_AGENT); }
__device__ __forceinline__ unsigned xb_add(unsigned* p, unsigned v) { return __hip_atomic_fetch_add(p, v, __ATOMIC_RELAXED, __HIP_MEMORY_SCOPE_AGENT); }
__device__ __forceinline__ unsigned xb_xcc_id() { return (unsigned)__builtin_amdgcn_s_getreg((3 << 11) | 20) & 0xFu; }
#define XB_SPIN(cond, bar) do { unsigned _sp = 0; while (cond) { __builtin_amdgcn_s_sleep(1); \
    if ((++_sp & 255u) == 0u) { if (xb_ld(&(bar)[XB_TMO])) break; if (_sp > XB_SPIN_CAP) { atomicAdd(&(bar)[XB_TMO], 1u); break; } } } } while (0)

struct XcdBarrier {
    unsigned* bar; unsigned x;
    volatile LAS unsigned* st;
};

__device__ __forceinline__ XcdBarrier xcd_barrier_post(unsigned* bar, volatile LAS unsigned* st) {
    XcdBarrier b; b.bar = bar; b.x = xb_xcc_id(); b.st = st;
    if (threadIdx.x == 0) (void)xb_add(&bar[XB_XCNT(b.x)], 1u);
    return b;
}
__device__ __forceinline__ void xcd_barrier_complete(unsigned* bar, unsigned x, unsigned& nloc, unsigned& nx) {
    const unsigned G = gridDim.x * gridDim.y * gridDim.z;
    unsigned sum, cnt, mine, sp = 0u;
    for (;;) {
        sum = 0u; cnt = 0u; mine = 0u;
#pragma unroll
        for (unsigned j = 0; j < 16; ++j) { const unsigned c = xb_ld(&bar[XB_XCNT(j)]); sum += c; cnt += (c > 0u) ? 1u : 0u; mine = (j == x) ? c : mine; }
        if (sum == G) break;
        __builtin_amdgcn_s_sleep(1);
        if ((++sp & 255u) == 0u) { if (xb_ld(&bar[XB_TMO])) break; if (sp > XB_SPIN_CAP) { atomicAdd(&bar[XB_TMO], 1u); break; } }
    }
    nloc = mine > 0u ? mine : 1u; nx = cnt > 0u ? cnt : 1u;
}

__device__ __forceinline__ void xcd_barrier(const XcdBarrier& b) {
    asm volatile("s_waitcnt vmcnt(0)" ::: "memory");
    __syncthreads();
    if (threadIdx.x == 0) {
        unsigned* bar = b.bar;
        __builtin_amdgcn_s_waitcnt(0);
        unsigned nloc = b.st[0], nx = b.st[1];
        if (nloc == 0u) { xcd_barrier_complete(bar, b.x, nloc, nx); b.st[0] = nloc; b.st[1] = nx; }
        const unsigned old = xb_add(&bar[XB_XSUB(b.x)], 1u);
        const unsigned gen = old / nloc;
        if (old + 1u == (gen + 1u) * nloc) {
            __builtin_amdgcn_fence(__ATOMIC_RELEASE, "agent");
            asm volatile("s_waitcnt vmcnt(0)" ::: "memory");
            const unsigned og = xb_add(&bar[XB_TOP], 1u);
            const unsigned tg = og / nx;
            if (og + 1u == (tg + 1u) * nx) xb_add(&bar[XB_TOPGEN], 1u);
            else XB_SPIN(xb_ld(&bar[XB_TOPGEN]) == tg, bar);
            __builtin_amdgcn_fence(__ATOMIC_ACQUIRE, "agent");
            xb_add(&bar[XB_XGEN(b.x)], 1u);
            asm volatile("s_waitcnt vmcnt(0)" ::: "memory");
        } else {
            XB_SPIN(xb_ld(&bar[XB_XGEN(b.x)]) == gen, bar);
            __builtin_amdgcn_fence(__ATOMIC_ACQUIRE, "agent");
            asm volatile("s_waitcnt vmcnt(0)" ::: "memory");
        }
    }
    __syncthreads();
}

constexpr int NTHREADS = 512;
constexpr size_t DYN_LDS = 155648;
constexpr int SCAN_BLOCKS = 32;
__global__ void __launch_bounds__(NTHREADS, 2) fwd_mega(Params p) {
    cg::grid_group grid = cg::this_grid();
    extern __shared__ __attribute__((aligned(16))) unsigned char smem[];
    float* smf = (float*)smem;
    volatile LAS unsigned* xbst = (volatile LAS unsigned*)((LAS unsigned char*)smem + DYN_LDS - 16);
    if (threadIdx.x < 4) xbst[threadIdx.x] = 0u;
    __syncthreads();
    const XcdBarrier xbar = xcd_barrier_post((unsigned*)(p.ws + OFF_BAR), xbst);
    if (p.ws == nullptr) grid.sync();
#define GRID_SYNC() xcd_barrier(xbar)
#ifndef PROBE_SPIN
#define PROBE_SPIN -1
#endif
    unsigned long long ts_[9];
#define STAMP(i) do { if (PROBE_SPIN >= 0) ts_[i] = __builtin_amdgcn_s_memrealtime(); } while (0)
    STAMP(0);
#ifndef PROBE_DUP
#define PROBE_DUP 0
#endif
#define PH_P0()    do { phase_weights(p, smf + 8192); phase_norm(p, smf); GRID_SYNC(); } while (0)
#define PH_GEMM1() do { pg8::Gemm g{(const bf16_t*)(p.ws + OFF_XN), (const bf16_t*)(p.ws + OFF_WTIN), MROWS, NPK, DM}; pg8::StaticOrder S; S.init(MROWS, NPK, (int)gridDim.x, (int)blockIdx.x); \
      EpiProjSplit E{p.ws, p.q_norm_w, p.k_norm_w}; pg8::gemm_phase<EpiProjSplit, pg8::StaticOrder, true, true>((PG8_LAS unsigned char*)smem, g, S, E); GRID_SYNC(); } while (0)
#define PH_PREP()  do { phase_dn_prep(p); GRID_SYNC(); } while (0)
#define PH_CHUNK() do { phase_dn_chunk(p, smem); GRID_SYNC(); } while (0)
#define PH_SCAN()  do { if ((int)blockIdx.x < SCAN_BLOCKS) phase_dn_scan(p, smem, blockIdx.x); else { const int na_ = (int)gridDim.x - SCAN_BLOCKS; phase_attn(p, smem, blockIdx.x - SCAN_BLOCKS, na_); \
          \
        asm volatile("s_waitcnt vmcnt(0)" ::: "memory"); __syncthreads(); \
        if (threadIdx.x == 0) { unsigned* cnt_ = (unsigned*)(p.ws + OFF_BAR); __builtin_amdgcn_fence(__ATOMIC_RELEASE, "agent"); asm volatile("s_waitcnt vmcnt(0)" ::: "memory"); \
            __hip_atomic_fetch_add(cnt_, 1u, __ATOMIC_RELAXED, __HIP_MEMORY_SCOPE_AGENT); unsigned spins_ = 0; \
            while (__hip_atomic_load(cnt_, __ATOMIC_RELAXED, __HIP_MEMORY_SCOPE_AGENT) < (unsigned)na_) { __builtin_amdgcn_s_sleep(8); if (++spins_ > (1u << 22)) break; } \
            __builtin_amdgcn_fence(__ATOMIC_ACQUIRE, "agent"); asm volatile("s_waitcnt vmcnt(0)" ::: "memory"); } \
        __syncthreads(); phase_att_combine(p, blockIdx.x - SCAN_BLOCKS, na_); } GRID_SYNC(); } while (0)
#define PH_MIX()   do { phase_mix(p, smem); GRID_SYNC(); } while (0)
#define PH_GEMM2() do { pg8::Gemm g{(const bf16_t*)(p.ws + OFF_MIXED), (const bf16_t*)(p.ws + OFF_WTOUT), MROWS, DM, DM}; pg8::StaticOrder S; S.init(MROWS, DM, (int)gridDim.x, (int)blockIdx.x); \
      EpiOutRes E{p.x, p.out}; pg8::gemm_phase<EpiOutRes, pg8::StaticOrder, true, true>((PG8_LAS unsigned char*)smem, g, S, E); } while (0)
    PH_P0();    STAMP(1);
    PH_GEMM1(); STAMP(2);
    PH_PREP();  STAMP(3);
    PH_CHUNK(); STAMP(4);
    PH_SCAN();  STAMP(5);
    PH_MIX();   STAMP(6);
    PH_GEMM2(); STAMP(7);
    if (PROBE_SPIN >= 0 && blockIdx.x == 0 && threadIdx.x == 0) {
        const unsigned long long d = ts_[PROBE_SPIN + 1 > 7 ? 7 : PROBE_SPIN + 1] - ts_[PROBE_SPIN > 7 ? 7 : (PROBE_SPIN < 0 ? 0 : PROBE_SPIN)], t0 = __builtin_amdgcn_s_memrealtime();
        while (__builtin_amdgcn_s_memrealtime() - t0 < d) __builtin_amdgcn_s_sleep(4);
    }
}

extern "C" void kernel_launch(void* const* d_in, const int* in_sizes, int n_in, void* d_out, int out_size, void* d_ws, size_t ws_size, hipStream_t stream) {
    (void)in_sizes; (void)n_in; (void)out_size;
    if (ws_size < WS_NEED) { fprintf(stderr, "workspace too small: %zu < %zu\n", ws_size, (size_t)WS_NEED); return; }
    static int grid_blocks = 0;
    if (!grid_blocks) {
        int dev = 0, cus = 0, per_cu = 0;
        (void)hipGetDevice(&dev);
        (void)hipDeviceGetAttribute(&cus, hipDeviceAttributeMultiprocessorCount, dev);
        (void)hipFuncSetAttribute((const void*)fwd_mega, hipFuncAttributeMaxDynamicSharedMemorySize, (int)DYN_LDS);
        (void)hipOccupancyMaxActiveBlocksPerMultiprocessor(&per_cu, fwd_mega, NTHREADS, DYN_LDS);
        if (per_cu > 1) per_cu = 1;
        grid_blocks = cus * per_cu;
        if (grid_blocks <= SCAN_BLOCKS) fprintf(stderr, "grid too small: %d\n", grid_blocks);
    }
    Params p{};
    p.x = (const float*)d_in[0]; p.norm_w = (const float*)d_in[1]; p.w_in = (const float*)d_in[2]; p.conv_w = (const float*)d_in[3]; p.a_log = (const float*)d_in[4];
    p.dt_bias = (const float*)d_in[5]; p.dn_norm_w = (const float*)d_in[6]; p.q_norm_w = (const float*)d_in[7]; p.k_norm_w = (const float*)d_in[8]; p.rel_bias = (const float*)d_in[9];
    p.w_out = (const float*)d_in[10]; p.out = (float*)d_out; p.ws = (unsigned char*)d_ws;
    (void)hipMemsetAsync((unsigned char*)d_ws + OFF_BAR, 0, XCD_BAR_WORDS * 4, stream);
    void* args[] = {&p};
    hipError_t e = hipLaunchCooperativeKernel((const void*)fwd_mega, dim3(grid_blocks), dim3(NTHREADS), args, DYN_LDS, stream);
    if (e != hipSuccess) fprintf(stderr, "cooperative launch failed: %s (grid %d)\n", hipGetErrorString(e), grid_blocks);
}
```

```cpp
#include <hip/hip_runtime.h>
#include <hip/hip_cooperative_groups.h>
#include <cstdint>
#include <cstdio>
namespace cg = cooperative_groups;

typedef unsigned short bf16_t;
typedef short bf16x8 __attribute__((ext_vector_type(8)));
typedef float f32x4 __attribute__((ext_vector_type(4)));
typedef float f32x16 __attribute__((ext_vector_type(16)));
typedef unsigned u32x4_t __attribute__((ext_vector_type(4)));
typedef unsigned u32x2_t __attribute__((ext_vector_type(2)));
typedef __bf16 bf16x2_t __attribute__((ext_vector_type(2)));
typedef float f32x2_t __attribute__((ext_vector_type(2)));
#define LDSP __attribute__((address_space(3)))

constexpr int NB = 8, SEQ = 4096, DM = 1024, MROWS = NB * SEQ;
constexpr int DIN = 4104, NPK = 4096;
constexpr int ATH = 8;
constexpr float EPS = 1e-6f;
constexpr size_t MiB = (size_t)1 << 20;

constexpr size_t OFF_R0 = 0;
constexpr size_t OFF_XN = OFF_R0, OFF_DNQ = OFF_R0, OFF_DNK = OFF_R0 + 32 * MiB;
constexpr size_t OFF_WTIN = 64 * MiB;
constexpr size_t OFF_WTOUT = 72 * MiB;
constexpr size_t OFF_BETA = 74 * MiB;
constexpr size_t OFF_G = OFF_BETA + MiB / 2;
constexpr size_t OFF_GCUM = 75 * MiB;
constexpr size_t OFF_BAR = 75 * MiB + MiB / 2;
constexpr size_t OFF_R3 = 76 * MiB;
constexpr size_t OFF_PROJDN = OFF_R3, OFF_ATTP = OFF_R3  , OFF_LSE = OFF_R3 + 96 * MiB  ;
constexpr size_t OFF_Z = 176 * MiB;
constexpr size_t OFF_MIXED = 208 * MiB;
constexpr size_t OFF_AQ = 208 * MiB;
constexpr size_t OFF_AK = 240 * MiB;
constexpr size_t OFF_AV = 272 * MiB;
constexpr size_t OFF_GATE = 304 * MiB;
constexpr size_t OFF_KNT = 336 * MiB;
constexpr size_t OFF_VIMG = 368 * MiB;
constexpr size_t OFF_T = 400 * MiB;
constexpr size_t OFF_ATTN = 416 * MiB;
constexpr size_t OFF_SCT = 464 * MiB;
constexpr size_t OFF_ODN = 432 * MiB;
constexpr size_t OFF_CONVP = 466 * MiB;
constexpr size_t WS_NEED = 467 * MiB;

__device__ __forceinline__ bf16_t f2bf(float f) { unsigned u = __float_as_uint(f); u += 0x7FFFu + ((u >> 16) & 1u); return (bf16_t)(u >> 16); }
__device__ __forceinline__ float bf2f(bf16_t b) { return __uint_as_float(((unsigned)b) << 16); }
__device__ __forceinline__ float wave_sum(float v) {
#pragma unroll
    for (int o = 32; o >= 1; o >>= 1) v += __shfl_xor(v, o);
    return v;
}
__device__ __forceinline__ float wave_max(float v) {
#pragma unroll
    for (int o = 32; o >= 1; o >>= 1) v = fmaxf(v, __shfl_xor(v, o));
    return v;
}
__device__ __forceinline__ float silu_f(float y) { return y / (1.0f + __expf(-y)); }
__device__ __forceinline__ unsigned pk_bf16(float lo, float hi) { f32x2_t v = {lo, hi}; return __builtin_bit_cast(unsigned, __builtin_convertvector(v, bf16x2_t)); }
__device__ __forceinline__ float bflo(unsigned u) { return __uint_as_float(u << 16); }
__device__ __forceinline__ float bfhi(unsigned u) { return __uint_as_float(u & 0xFFFF0000u); }
__device__ __forceinline__ void unpack8(const u32x4_t v, float (&f)[8]) { f[0] = bflo(v.x); f[1] = bfhi(v.x); f[2] = bflo(v.y); f[3] = bfhi(v.y); f[4] = bflo(v.z); f[5] = bfhi(v.z); f[6] = bflo(v.w); f[7] = bfhi(v.w); }
__host__ __device__ __forceinline__ int crow(int i, int hh) { return (i & 3) + 8 * (i >> 2) + 4 * hh; }
__host__ __device__ __forceinline__ int perm16(int x) { return (x & ~12) | ((x & 4) << 1) | ((x & 8) >> 1); }
#define MFMA32(a, b, c) __builtin_amdgcn_mfma_f32_32x32x16_bf16((a), (b), (c), 0, 0, 0)
__host__ __device__ __forceinline__ size_t vimg_index(int chunk, int pos, int dv) {
    const int wsl = dv >> 5, cl = dv & 31, pt = pos >> 5, pr = pos & 31, i = 4 * (pr >> 3) + (pr & 3), hs = (pr >> 2) & 1;
    return (((((size_t)chunk * 4 + wsl) * 2 + pt) * 2 + (i >> 3)) * 64 + cl + 32 * hs) * 8 + (i & 7);
}

__device__ __forceinline__ int opaque_tid() { int t = threadIdx.x; asm volatile("" : "+v"(t)); return t & 511; }
__device__ __forceinline__ unsigned char* opaque_ptr(unsigned char* q) { asm volatile("" : "+s"(q)); return q; }
struct Params {
    const float* x; const float* norm_w; const float* w_in; const float* conv_w; const float* a_log; const float* dt_bias;
    const float* dn_norm_w; const float* q_norm_w; const float* k_norm_w; const float* rel_bias; const float* w_out;
    float* out; unsigned char* ws;
};

namespace pg8 {
#define PG8_LAS __attribute__((address_space(3)))
typedef unsigned short bf16_t;
typedef short bf16x8 __attribute__((ext_vector_type(8)));
typedef float f32x4 __attribute__((ext_vector_type(4)));
typedef unsigned u32x4 __attribute__((ext_vector_type(4)));
constexpr int BM = 256, BK = 64, HALF = 128, HTB = HALF * BK * 2  , STAGE_BYTES = 8 * HTB, NXCD = 8, WGM = 8;

__host__ __device__ __forceinline__ int lds_byte(int r, int c) { const int st = (r >> 4) * 2 + (c >> 5), rr = r & 15, cc = c & 31, ob = rr * 64 + cc * 2; return st * 1024 + (ob ^ (((ob >> 9) & 1) << 5)); }
__host__ __device__ __forceinline__ void stage_rc(int b, int& R, int& C) { const int st = b / 1024, sb = b % 1024, swz = sb ^ (((sb >> 9) & 1) << 5); R = (st >> 1) * 16 + swz / 64; C = (st & 1) * 32 + (swz % 64) / 2; }
__host__ __device__ __forceinline__ int perm32(int rho) { const int n = rho >> 4, i = rho & 15; return 8 * (i >> 2) + 4 * n + (i & 3); }

struct Unit { int pm, pn; };
struct Gemm { const bf16_t* A; const bf16_t* Bt; int M, N, K; };

struct StaticOrder {
    int nM, nN, nwg, G, c;
    __host__ __device__ void init(int M, int N, int G_, int c_) { nM = M / BM; nN = N / BM; nwg = nM * nN; G = G_; c = c_; }
    __host__ __device__ bool next(int i, Unit& u) const {
        const long L = (long)i * G + c; if (L >= nwg) return false;
        int wgid = (int)L; { const int q = nwg / NXCD, r = nwg % NXCD, xcd = wgid % NXCD, off = wgid / NXCD; wgid = (xcd < r ? xcd * (q + 1) : r * (q + 1) + (xcd - r) * q) + off; }
        const int nig = WGM * nN, gid = wgid / nig, fm = gid * WGM, gsz = (nM - fm) < WGM ? (nM - fm) : WGM;
        u.pm = fm + ((wgid % nig) % gsz); u.pn = (wgid % nig) / gsz; return true;
    }
    __device__ __forceinline__ void a_ready(const Unit&) const {}
    __device__ __forceinline__ void done(const Unit&) const {}
};

__device__ __forceinline__ unsigned cvt_pk_bf16(float lo, float hi) { unsigned r; asm volatile("v_cvt_pk_bf16_f32 %0, %1, %2" : "=v"(r) : "v"(lo), "v"(hi)); return r; }
typedef float f32x2 __attribute__((ext_vector_type(2)));
template <class Epi, class Sched, bool ALIGN_EPI = false, bool SP2 = false>
__device__ __forceinline__ void gemm_phase(PG8_LAS unsigned char* lds, const Gemm g, const Sched& S, const Epi& E) {
    const int tid = opaque_tid(), wid = __builtin_amdgcn_readfirstlane(tid >> 6), lane = tid & 63, wr = wid >> 2, wc = wid & 3, fr = lane & 15, fq = lane >> 4;
    const int K = g.K, nt = K / BK;
    unsigned voffA[2], voffB[2];
#pragma unroll
    for (int i = 0; i < 2; ++i) { int R, C; stage_rc(tid * 16 + i * 8192, R, C); const int Rb = Epi::PERM ? ((R & ~31) + perm32(R & 31)) : R;
        voffA[i] = (unsigned)(R * K + C) * 2u; voffB[i] = (unsigned)(Rb * K + C) * 2u; }
    const size_t kstep = (size_t)(BK * 2);
    const size_t hstep = (size_t)HALF * K * 2;
    const size_t tstep = 2 * hstep;
    const unsigned ldsw = (unsigned)wid * 1024u;
    const int aoff = lds_byte(wr * 64 + fr, fq * 8), boff = lds_byte(wc * 32 + fr, fq * 8);
#define PG8_SA(b, h) (((b) * 2 + (h)) * HTB)
#define PG8_SB(b, h) ((4 + (b) * 2 + (h)) * HTB)
#define PG8_STAGE(bufoff, gbase, voff) do { _Pragma("unroll") for (int _i = 0; _i < 2; ++_i) \
        __builtin_amdgcn_global_load_lds((const unsigned*)((const char*)(gbase) + (voff)[_i]), (PG8_LAS unsigned*)(lds + (bufoff) + ldsw + _i * 8192), 16, 0, 0); } while (0)
#define PG8_LDA(dst, b, h) do { _Pragma("unroll") for (int m = 0; m < 4; ++m) _Pragma("unroll") for (int k = 0; k < 2; ++k) dst[m][k] = *(const PG8_LAS bf16x8*)(lds + PG8_SA(b, h) + aoff + m * 2048 + k * 1024); } while (0)
#define PG8_LDB(dst, b, h) do { _Pragma("unroll") for (int n = 0; n < 2; ++n) _Pragma("unroll") for (int k = 0; k < 2; ++k) dst[n][k] = *(const PG8_LAS bf16x8*)(lds + PG8_SB(b, h) + boff + n * 2048 + k * 1024); } while (0)
#define PG8_MMA(ai, bj, At, Bt) do { __builtin_amdgcn_s_setprio(1); _Pragma("unroll") for (int m = 0; m < 4; ++m) _Pragma("unroll") for (int n = 0; n < 2; ++n) _Pragma("unroll") for (int k = 0; k < 2; ++k) \
        acc[ai][bj][m][n] = __builtin_amdgcn_mfma_f32_16x16x32_bf16(Bt[n][k], At[m][k], acc[ai][bj][m][n], 0, 0, 0); __builtin_amdgcn_s_setprio(0); } while (0)
#define PG8_WAIT_V(n) asm volatile("s_waitcnt vmcnt(" #n ")" ::: "memory")
#define PG8_WAIT_L(n) asm volatile("s_waitcnt lgkmcnt(" #n ")" ::: "memory")
#define PG8_BAR __builtin_amdgcn_s_barrier()
#define PG8_SCHED __builtin_amdgcn_sched_barrier(0)
    Unit cur, nxt; int ui = 0;
    if (!S.next(0, cur)) return;
    f32x4 acc[2][2][4][2];
#pragma unroll
    for (int a = 0; a < 2; ++a)
#pragma unroll
        for (int b = 0; b < 2; ++b)
#pragma unroll
            for (int m = 0; m < 4; ++m)
#pragma unroll
                for (int n = 0; n < 2; ++n) acc[a][b][m][n] = (f32x4){0.f, 0.f, 0.f, 0.f};
    bf16x8 At[4][2], B0[2][2], B1[2][2];
    const char* cA = (const char*)g.A + (size_t)cur.pm * tstep; const char* cB = (const char*)g.Bt + (size_t)cur.pn * tstep;
    S.a_ready(cur);
    if constexpr (SP2) {
        PG8_STAGE(PG8_SB(0, 0), cB, voffB); PG8_STAGE(PG8_SB(0, 1), cB + hstep, voffB); PG8_STAGE(PG8_SA(0, 0), cA, voffA); PG8_STAGE(PG8_SA(0, 1), cA + hstep, voffA);
        if (wr == 1) PG8_BAR;
        PG8_WAIT_V(2); PG8_BAR;
        PG8_STAGE(PG8_SB(1, 0), cB + kstep, voffB); PG8_STAGE(PG8_SA(1, 0), cA + kstep, voffA); PG8_STAGE(PG8_SB(1, 1), cB + hstep + kstep, voffB);
        PG8_WAIT_V(6); PG8_BAR;
    } else {
        PG8_STAGE(PG8_SB(0, 0), cB, voffB); PG8_STAGE(PG8_SA(0, 0), cA, voffA); PG8_STAGE(PG8_SB(0, 1), cB + hstep, voffB); PG8_STAGE(PG8_SA(0, 1), cA + hstep, voffA);
        if (wr == 1) PG8_BAR;
        PG8_WAIT_V(4); PG8_BAR;
        PG8_STAGE(PG8_SB(1, 0), cB + kstep, voffB); PG8_STAGE(PG8_SA(1, 0), cA + kstep, voffA); PG8_STAGE(PG8_SB(1, 1), cB + hstep + kstep, voffB);
        PG8_WAIT_V(6); PG8_BAR;
    }
    for (;;) {
        const bool has_next = S.next(ui + 1, nxt);
        const char* nA = has_next ? (const char*)g.A + (size_t)nxt.pm * tstep : cA; const char* nB = has_next ? (const char*)g.Bt + (size_t)nxt.pn * tstep : cB;
        for (int t = 0; t < nt; t += 2) {
            const bool last = (t == nt - 2);
            const char* a1 = cA + (size_t)(t + 1) * kstep;
            const char* a2 = last ? nA : cA + (size_t)(t + 2) * kstep; const char* b2 = last ? nB : cB + (size_t)(t + 2) * kstep;
            const char* a3 = a2 + kstep; const char* b3 = b2 + kstep;
            if (last && has_next) S.a_ready(nxt);
            if constexpr (SP2) {
            PG8_LDB(B0, 0, 0); PG8_LDB(B1, 0, 1); PG8_SCHED; PG8_LDA(At, 0, 0); PG8_STAGE(PG8_SA(1, 1), a1 + hstep, voffA);
            PG8_WAIT_V(8); PG8_WAIT_L(0); PG8_BAR; PG8_MMA(0, 0, At, B0); PG8_MMA(0, 1, At, B1); PG8_BAR; PG8_SCHED;
            PG8_LDA(At, 0, 1); PG8_STAGE(PG8_SB(0, 0), b2, voffB); PG8_STAGE(PG8_SB(0, 1), b2 + hstep, voffB); PG8_STAGE(PG8_SA(0, 0), a2, voffA);
            PG8_WAIT_V(8); PG8_WAIT_L(0); PG8_BAR; PG8_MMA(1, 0, At, B0); PG8_MMA(1, 1, At, B1); PG8_BAR; PG8_SCHED;
            PG8_LDB(B0, 1, 0); PG8_LDB(B1, 1, 1); PG8_SCHED; PG8_LDA(At, 1, 0); PG8_STAGE(PG8_SA(0, 1), a2 + hstep, voffA);
            PG8_WAIT_V(8); PG8_WAIT_L(0); PG8_BAR; PG8_MMA(0, 0, At, B0); PG8_MMA(0, 1, At, B1); PG8_BAR; PG8_SCHED;
            PG8_LDA(At, 1, 1); PG8_STAGE(PG8_SB(1, 0), b3, voffB); PG8_STAGE(PG8_SB(1, 1), b3 + hstep, voffB); PG8_STAGE(PG8_SA(1, 0), a3, voffA);
            PG8_WAIT_V(8); PG8_WAIT_L(0); PG8_BAR; PG8_MMA(1, 0, At, B0); PG8_MMA(1, 1, At, B1); PG8_BAR; PG8_SCHED;
            } else {
            PG8_LDB(B0, 0, 0); PG8_SCHED; PG8_LDA(At, 0, 0); PG8_STAGE(PG8_SA(1, 1), a1 + hstep, voffA);
            PG8_WAIT_L(8); PG8_BAR; PG8_WAIT_L(0); PG8_MMA(0, 0, At, B0); PG8_BAR; PG8_SCHED;
            PG8_LDB(B1, 0, 1); PG8_STAGE(PG8_SB(0, 0), b2, voffB);
            PG8_BAR; PG8_WAIT_L(0); PG8_MMA(0, 1, At, B1); PG8_BAR;
            PG8_LDA(At, 0, 1); PG8_STAGE(PG8_SA(0, 0), a2, voffA);
            PG8_BAR; PG8_WAIT_L(0); PG8_MMA(1, 0, At, B0); PG8_BAR; PG8_SCHED;
            PG8_STAGE(PG8_SB(0, 1), b2 + hstep, voffB);
            PG8_WAIT_V(6); PG8_BAR; PG8_MMA(1, 1, At, B1); PG8_BAR;
            PG8_LDB(B0, 1, 0); PG8_SCHED; PG8_LDA(At, 1, 0); PG8_STAGE(PG8_SA(0, 1), a2 + hstep, voffA);
            PG8_WAIT_L(8); PG8_BAR; PG8_WAIT_L(0); PG8_MMA(0, 0, At, B0); PG8_BAR; PG8_SCHED;
            PG8_LDB(B1, 1, 1); PG8_STAGE(PG8_SB(1, 0), b3, voffB);
            PG8_BAR; PG8_WAIT_L(0); PG8_MMA(0, 1, At, B1); PG8_BAR;
            PG8_LDA(At, 1, 1); PG8_STAGE(PG8_SA(1, 0), a3, voffA);
            PG8_BAR; PG8_WAIT_L(0); PG8_MMA(1, 0, At, B0); PG8_BAR; PG8_SCHED;
            PG8_STAGE(PG8_SB(1, 1), b3 + hstep, voffB);
            PG8_WAIT_V(6); PG8_BAR; PG8_MMA(1, 1, At, B1); PG8_BAR;
            }
        }
        if constexpr (ALIGN_EPI) { if (wr == 0) PG8_BAR; }
        if constexpr (!Epi::AFTER_DRAIN) { E(acc, cur, wr, wc, fr, fq); S.done(cur); }
        if (!has_next) break;
#pragma unroll
        for (int a = 0; a < 2; ++a)
#pragma unroll
            for (int b = 0; b < 2; ++b)
#pragma unroll
                for (int m = 0; m < 4; ++m)
#pragma unroll
                    for (int n = 0; n < 2; ++n) acc[a][b][m][n] = (f32x4){0.f, 0.f, 0.f, 0.f};
        cur = nxt; cA = nA; cB = nB; ++ui;
        if constexpr (ALIGN_EPI) { if (wr == 1) PG8_BAR; }
    }
    PG8_WAIT_V(0);
    if constexpr (!ALIGN_EPI) { if (wr == 0) PG8_BAR; }
    PG8_BAR;
    if constexpr (Epi::AFTER_DRAIN) { E.fused(acc, cur, wr, wc, fr, fq, lds, wid, lane); S.done(cur); }
#undef PG8_SA
#undef PG8_SB
#undef PG8_STAGE
#undef PG8_LDA
#undef PG8_LDB
#undef PG8_MMA
#undef PG8_WAIT_V
#undef PG8_WAIT_L
#undef PG8_BAR
#undef PG8_SCHED
}
}

__host__ __device__ __forceinline__ int wt_src_col(int n) {
    if (n >= 1024 && n < 1536) return (n & ~127) + ((n & 127) >> 3) + 16 * (n & 7);
    if (n < 2048) return n;
    if (n >= 3584) return n + 8;
    const int pn = n >> 8, vc = n & 255, bj = vc >> 7, wc = (vc >> 5) & 3, i = vc & 31;
    return 2056 + ((pn - 8) >> 1) * 512 + (4 * (pn & 1) + wc) * 64 + 32 * bj + i;
}
__host__ __device__ __forceinline__ int att_perm(int t) { return ((t & 15) << 8) | (t >> 4); }
struct EpiProjSplit {
    static constexpr bool PERM = true, AFTER_DRAIN = false;
    unsigned char* ws; const float *qw, *kw;
    __device__ __forceinline__ static pg8::u32x4 pack8(const f32x4 v0, const f32x4 v1) { pg8::u32x4 w;
        w.x = pg8::cvt_pk_bf16(v0[0], v0[1]); w.y = pg8::cvt_pk_bf16(v0[2], v0[3]); w.z = pg8::cvt_pk_bf16(v1[0], v1[1]); w.w = pg8::cvt_pk_bf16(v1[2], v1[3]); return w; }
    __device__ __forceinline__ void operator()(const f32x4 (&acc)[2][2][4][2], const pg8::Unit& u, int wr, int wc, int fr, int fq) const {
        const int pn = u.pn, row0 = u.pm * 256 + wr * 64 + fr;
        if (pn < 8 || pn >= 14) {
            const size_t boff = pn < 6 ? OFF_PROJDN : (pn < 8 ? OFF_Z : OFF_GATE);
            const int ld = pn < 6 ? 1536 : 512, colt = pn < 6 ? pn * 256 : (pn & 1) * 256; const bool act = pn >= 6;
            bf16_t* base = (bf16_t*)(ws + boff);
            const int col0 = colt + wc * 32 + 8 * fq;
#pragma unroll
            for (int ai = 0; ai < 2; ++ai)
#pragma unroll
                for (int m = 0; m < 4; ++m) { bf16_t* rowp = base + (size_t)(row0 + ai * 128 + m * 16) * ld + col0;
#pragma unroll
                    for (int bj = 0; bj < 2; ++bj) { f32x4 v0 = acc[ai][bj][m][0], v1 = acc[ai][bj][m][1];
                        if (act) {
#pragma unroll
                            for (int e = 0; e < 4; ++e) { v0[e] = silu_f(v0[e]); v1[e] = silu_f(v1[e]); } }
                        *(pg8::u32x4*)(rowp + bj * 128) = pack8(v0, v1); } }
        } else {
            const int grp = (pn - 8) >> 1, head = 4 * (pn & 1) + wc;
            bf16_t* base = (bf16_t*)(ws + OFF_AQ + (size_t)grp * (32 * MiB));
            f32x4 wv[2][2];
            if (grp < 2) { const float* w = grp == 0 ? qw : kw; const float sc = grp == 0 ? 0.125f * 1.4426950408889634f : 1.0f;
#pragma unroll
                for (int bj = 0; bj < 2; ++bj)
#pragma unroll
                    for (int n = 0; n < 2; ++n) wv[bj][n] = *(const f32x4*)(w + 32 * bj + 8 * fq + 4 * n) * sc; }
#pragma unroll
            for (int ai = 0; ai < 2; ++ai)
#pragma unroll
                for (int m = 0; m < 4; ++m) {
                    const int r = row0 + ai * 128 + m * 16, b = r >> 12, t = r & 4095;
                    f32x4 v[2][2];
#pragma unroll
                    for (int bj = 0; bj < 2; ++bj)
#pragma unroll
                        for (int n = 0; n < 2; ++n) v[bj][n] = acc[ai][bj][m][n];
                    if (grp < 2) {
                        float ss = 0.f;
#pragma unroll
                        for (int bj = 0; bj < 2; ++bj)
#pragma unroll
                            for (int n = 0; n < 2; ++n) ss += v[bj][n][0] * v[bj][n][0] + v[bj][n][1] * v[bj][n][1] + v[bj][n][2] * v[bj][n][2] + v[bj][n][3] * v[bj][n][3];
                        ss += __shfl_xor(ss, 16); ss += __shfl_xor(ss, 32);
                        const float rstd = rsqrtf(ss * (1.0f / 64.f) + EPS);
#pragma unroll
                        for (int bj = 0; bj < 2; ++bj)
#pragma unroll
                            for (int n = 0; n < 2; ++n) v[bj][n] = v[bj][n] * rstd * wv[bj][n];
                    }
                    bf16_t* dst = base + ((size_t)(b * 8 + head) * SEQ + att_perm(t)) * 64 + 8 * fq;
                    *(pg8::u32x4*)(dst) = pack8(v[0][0], v[0][1]);
                    *(pg8::u32x4*)(dst + 32) = pack8(v[1][0], v[1][1]);
                }
        }
    }
};
struct EpiOutRes {
    static constexpr bool PERM = false, AFTER_DRAIN = false;
    const float* X; float* C;
    __device__ __forceinline__ void operator()(const f32x4 (&acc)[2][2][4][2], const pg8::Unit& u, int wr, int wc, int fr, int fq) const {
        const int row0 = u.pm * 256 + wr * 64 + fr, col0 = u.pn * 256 + wc * 32 + 4 * fq;
#pragma unroll
        for (int ai = 0; ai < 2; ++ai)
#pragma unroll
            for (int m = 0; m < 4; ++m) { const size_t off = (size_t)(row0 + ai * 128 + m * 16) * DM + col0;
#pragma unroll
                for (int bj = 0; bj < 2; ++bj)
#pragma unroll
                    for (int n = 0; n < 2; ++n) { const size_t o = off + bj * 128 + n * 16; *(f32x4*)(C + o) = *(const f32x4*)(X + o) + acc[ai][bj][m][n]; } }
    }
};

__device__ void phase_weights(const Params& p, float* tile  ) {
    bf16_t* wt_in = (bf16_t*)(p.ws + OFF_WTIN); bf16_t* wt_out = (bf16_t*)(p.ws + OFF_WTOUT);
    const int tid = opaque_tid();
    constexpr int T_IN = (DM / 64) * (NPK / 64), T_OUT = (DM / 64) * (DM / 64);
    for (int i = blockIdx.x * 512 + tid; i < 4 * 1536; i += gridDim.x * 512) { const int tap = i / 1536, c = i - tap * 1536; ((float*)(p.ws + OFF_CONVP))[i] = p.conv_w[tap * 1536 + wt_src_col(c)]; }
    for (int t = blockIdx.x; t < T_IN + T_OUT; t += gridDim.x) {
        const bool is_in = t < T_IN; const int tt = is_in ? t : t - T_IN, ntn = is_in ? NPK / 64 : DM / 64, k0 = (tt / ntn) * 64, n0 = (tt % ntn) * 64;
        const float* src = is_in ? p.w_in : p.w_out; const int ld = is_in ? DIN : DM;
        const int n = tid & 63, col = is_in ? wt_src_col(n0 + n) : n0 + n;
        __syncthreads();
#pragma unroll
        for (int rep = 0; rep < 8; ++rep) { const int k = rep * 8 + (tid >> 6); tile[k * 65 + n] = src[(size_t)(k0 + k) * ld + col]; }
        __syncthreads();
        const int nn = tid >> 3, k8 = (tid & 7) * 8;
        u32x4_t o;
        o.x = pk_bf16(tile[(k8 + 0) * 65 + nn], tile[(k8 + 1) * 65 + nn]); o.y = pk_bf16(tile[(k8 + 2) * 65 + nn], tile[(k8 + 3) * 65 + nn]);
        o.z = pk_bf16(tile[(k8 + 4) * 65 + nn], tile[(k8 + 5) * 65 + nn]); o.w = pk_bf16(tile[(k8 + 6) * 65 + nn], tile[(k8 + 7) * 65 + nn]);
        *(u32x4_t*)((is_in ? wt_in : wt_out) + (size_t)(n0 + nn) * DM + k0 + k8) = o;
    }
}

__device__ void phase_norm(const Params& p, float* lds_w8  ) {
    bf16_t* xn = (bf16_t*)(p.ws + OFF_XN); float* beta = (float*)(p.ws + OFF_BETA); float* gdec = (float*)(p.ws + OFF_G);
    const int tid = opaque_tid();
    for (int i = tid; i < 1024 * 8; i += blockDim.x) { const int k = i >> 3, j = i & 7; lds_w8[j * 1024 + k] = p.w_in[(size_t)k * DIN + 2048 + j]; }
    __syncthreads();
    const int lane = tid & 63, wpb = blockDim.x >> 6, gw = blockIdx.x * wpb + (tid >> 6), nw = gridDim.x * wpb;
    f32x4 nw4[4];
#pragma unroll
    for (int i = 0; i < 4; ++i) nw4[i] = *(const f32x4*)(p.norm_w + i * 256 + lane * 4);
    f32x4 xa_[4], xb_[4];
#define NORM_LD(dst, row_) do { _Pragma("unroll") for (int i = 0; i < 4; ++i) dst[i] = *(const f32x4*)(p.x + (size_t)(row_) * DM + i * 256 + lane * 4); } while (0)
    if (gw < MROWS) NORM_LD(xa_, gw);
    if (gw + nw < MROWS) NORM_LD(xb_, gw + nw);
    auto process = [&](f32x4 (&xv)[4], const int row) __attribute__((always_inline)) {
        float ss = 0.f, acc[8];
#pragma unroll
        for (int j = 0; j < 8; ++j) acc[j] = 0.f;
        f32x4 hu[4];
#pragma unroll
        for (int i = 0; i < 4; ++i) {
            ss += xv[i][0] * xv[i][0] + xv[i][1] * xv[i][1] + xv[i][2] * xv[i][2] + xv[i][3] * xv[i][3];
            hu[i] = xv[i] * nw4[i];
#pragma unroll
            for (int j = 0; j < 8; ++j) { const f32x4 wj = *(const f32x4*)(lds_w8 + j * 1024 + i * 256 + lane * 4); acc[j] += hu[i][0] * wj[0] + hu[i][1] * wj[1] + hu[i][2] * wj[2] + hu[i][3] * wj[3]; }
        }
        if (row + 2 * nw < MROWS) NORM_LD(xv, row + 2 * nw);
        ss = wave_sum(ss);
        const float rstd = rsqrtf(ss * (1.0f / DM) + EPS);
#pragma unroll
        for (int i = 0; i < 4; ++i) { const f32x4 h = hu[i] * rstd; uint2 pk; pk.x = pk_bf16(h[0], h[1]); pk.y = pk_bf16(h[2], h[3]); *(uint2*)(xn + (size_t)row * DM + i * 256 + lane * 4) = pk; }
        float a1[4], a2[2], a3;
#pragma unroll
        for (int j = 0; j < 4; ++j) { const bool hi = lane & 1; const float keep = hi ? acc[2 * j + 1] : acc[2 * j], send = hi ? acc[2 * j] : acc[2 * j + 1]; a1[j] = keep + __shfl_xor(send, 1); }
#pragma unroll
        for (int j = 0; j < 2; ++j) { const bool hi = lane & 2; const float keep = hi ? a1[2 * j + 1] : a1[2 * j], send = hi ? a1[2 * j] : a1[2 * j + 1]; a2[j] = keep + __shfl_xor(send, 2); }
        { const bool hi = lane & 4; const float keep = hi ? a2[1] : a2[0], send = hi ? a2[0] : a2[1]; a3 = keep + __shfl_xor(send, 4); }
        a3 += __shfl_xor(a3, 8); a3 += __shfl_xor(a3, 16); a3 += __shfl_xor(a3, 32);
        const int b = row / SEQ, sq = row % SEQ;
        if (lane < 8) {
            const float v = a3 * rstd; const int j = lane & 3;
            if (lane < 4) beta[((size_t)b * 4 + j) * SEQ + sq] = 1.0f / (1.0f + expf(-v));
            else { const float xx = v + p.dt_bias[j]; const float sp = xx > 20.f ? xx : log1pf(expf(xx)); gdec[((size_t)b * 4 + j) * SEQ + sq] = -expf(p.a_log[j]) * sp; }
        }
    };
    for (int row = gw; row < MROWS; row += 2 * nw) { process(xa_, row); if (row + nw < MROWS) process(xb_, row + nw); }
#undef NORM_LD
}

__device__ void phase_dn_prep(const Params& p, unsigned char* smem) {
    const bf16_t* proj = (const bf16_t*)(p.ws + OFF_PROJDN);
    bf16_t* qn = (bf16_t*)(p.ws + OFF_DNQ); bf16_t* kn = (bf16_t*)(p.ws + OFF_DNK); bf16_t* vimg = (bf16_t*)(p.ws + OFF_VIMG);
    const float* gdec = (const float*)(p.ws + OFF_G); float* gcum = (float*)(p.ws + OFF_GCUM); const float* convp = (const float*)(p.ws + OFF_CONVP);
    const int tid = opaque_tid(), lane = tid & 63, w = tid >> 6, h = lane >> 4, d8 = (lane & 15) * 8;
    constexpr int NIT = NB * 64 * 3;
    u32x4_t rawn[11];
#define PREP_LD(it_) do { const int u_ = (it_) / 3, g_ = (it_) - 3 * u_, b_ = u_ >> 6, t0_ = (u_ & 63) * 64; \
        _Pragma("unroll") for (int rr = 0; rr < 11; ++rr) { const int tt = t0_ + 8 * w - 3 + rr; rawn[rr] = tt >= 0 ? *(const u32x4_t*)(proj + (size_t)(b_ * SEQ + tt) * 1536 + g_ * 512 + 8 * lane) : (u32x4_t){0u, 0u, 0u, 0u}; } } while (0)
    int it = blockIdx.x * 3, vpar = 0;
    if (it < NIT) PREP_LD(it);
    for (; it < NIT; it = ((it % 3) == 2) ? it - 2 + 3 * (int)gridDim.x : it + 1) {
        const int unit = it / 3, g = it - 3 * unit, b = unit >> 6, n = unit & 63, t0 = n * 64, chunk = (b * 4 + h) * 64 + n;
        u32x4_t raw[11];
#pragma unroll
        for (int rr = 0; rr < 11; ++rr) raw[rr] = rawn[rr];
        { const int itn = (g == 2) ? it - 2 + 3 * (int)gridDim.x : it + 1; if (itn < NIT) PREP_LD(itn); }
        f32x4 cw[4][2];
#pragma unroll
        for (int i = 0; i < 4; ++i) { cw[i][0] = *(const f32x4*)(convp + i * 1536 + g * 512 + 8 * lane); cw[i][1] = *(const f32x4*)(convp + i * 1536 + g * 512 + 8 * lane + 4); }
        float y[8][8];
#pragma unroll
        for (int pp = 0; pp < 8; ++pp) {
            float a[8];
#pragma unroll
            for (int e = 0; e < 8; ++e) a[e] = 0.f;
#pragma unroll
            for (int i = 0; i < 4; ++i) { float x[8]; unpack8(raw[pp + i], x);
#pragma unroll
                for (int e = 0; e < 8; ++e) a[e] += cw[i][e >> 2][e & 3] * x[e]; }
#pragma unroll
            for (int e = 0; e < 8; ++e) y[pp][e] = silu_f(a[e]);
        }
        if (g < 2) {
            bf16_t* dst = g == 0 ? qn : kn; const float sc = g == 0 ? 0.08838834764831845f : 1.0f;
#pragma unroll
            for (int pp = 0; pp < 8; ++pp) {
                float ss = 0.f;
#pragma unroll
                for (int e = 0; e < 8; ++e) ss += y[pp][e] * y[pp][e];
                ss += __shfl_xor(ss, 1); ss += __shfl_xor(ss, 2); ss += __shfl_xor(ss, 4); ss += __shfl_xor(ss, 8);
                const float rs = rsqrtf(ss + EPS) * sc;
                u32x4_t o; o.x = pk_bf16(y[pp][0] * rs, y[pp][1] * rs); o.y = pk_bf16(y[pp][2] * rs, y[pp][3] * rs); o.z = pk_bf16(y[pp][4] * rs, y[pp][5] * rs); o.w = pk_bf16(y[pp][6] * rs, y[pp][7] * rs);
                *(u32x4_t*)(dst + ((size_t)chunk * 64 + 8 * w + pp) * 128 + d8) = o;
            }
        } else {
            LDSP u32x2_t* xch = (LDSP u32x2_t*)smem + (size_t)(vpar & 1) * 4096;
            const int odd = w & 1;
            u32x2_t own[8];
#pragma unroll
            for (int e = 0; e < 8; ++e) { u32x2_t p0, p1; p0.x = pk_bf16(y[0][e], y[1][e]); p0.y = pk_bf16(y[2][e], y[3][e]); p1.x = pk_bf16(y[4][e], y[5][e]); p1.y = pk_bf16(y[6][e], y[7][e]);
                u32x2_t give; give.x = odd ? p0.x : p1.x; give.y = odd ? p0.y : p1.y; own[e].x = odd ? p1.x : p0.x; own[e].y = odd ? p1.y : p0.y;
                xch[(w * 8 + e) * 64 + lane] = give; }
            __syncthreads();
#pragma unroll
            for (int e = 0; e < 8; ++e) { const u32x2_t got = xch[((w ^ 1) * 8 + e) * 64 + lane];
                u32x4_t o; o.x = odd ? got.x : own[e].x; o.y = odd ? got.y : own[e].y; o.z = odd ? own[e].x : got.x; o.w = odd ? own[e].y : got.y;
                *(u32x4_t*)(vimg + vimg_index(chunk, 16 * (w >> 1) + 4 * odd, (lane & 15) + 16 * e)) = o; }
            ++vpar;
        }
        if (g == 0 && w < 4) {
            const int bh = b * 4 + w, c2 = bh * 64 + n;
            float v = gdec[(size_t)bh * SEQ + t0 + lane];
#pragma unroll
            for (int o = 1; o < 64; o <<= 1) { const float t = __shfl_up(v, o); if (lane >= o) v += t; }
            gcum[(size_t)c2 * 64 + lane] = v;
            const float glast = __shfl(v, 63), bt = ((const float*)(p.ws + OFF_BETA))[(size_t)bh * SEQ + t0 + lane], eg = __expf(v);
            float* sct = (float*)(p.ws + OFF_SCT) + (size_t)c2 * 256;
            sct[lane] = eg; sct[64 + lane] = bt * eg; sct[128 + lane] = __expf(glast - v); sct[192 + lane] = bt;
        }
    }
#undef PREP_LD
}

constexpr int D1B_LDS_PER_WAVE = 512;
__device__ void phase_dn_chunk(const Params& p, unsigned char* smem) {
    const bf16_t* qn = (const bf16_t*)(p.ws + OFF_DNQ); const bf16_t* kn = (const bf16_t*)(p.ws + OFF_DNK);
    const float* beta = (const float*)(p.ws + OFF_BETA); const float* gcum = (const float*)(p.ws + OFF_GCUM);
    bf16_t* Tm = (bf16_t*)(p.ws + OFF_T); bf16_t* attn = (bf16_t*)(p.ws + OFF_ATTN);
    const int tid0 = opaque_tid(), w = tid0 >> 6, lane = tid0 & 63, r = lane & 31, hh = lane >> 5;
    LDSP float* tg = (LDSP float*)((LDSP unsigned char*)smem + w * D1B_LDS_PER_WAVE); LDSP float* tb = tg + 64;
    for (int c = blockIdx.x * 8 + w; c < NB * 4 * 64; c += gridDim.x * 8) {
        const int bh = c >> 6, n = c & 63;
        tg[lane] = gcum[(size_t)c * 64 + lane]; tb[lane] = beta[(size_t)bh * SEQ + n * 64 + lane];
        const bf16_t* kp = kn + ((size_t)c * 64 + r) * 128 + 8 * hh; const bf16_t* qp = qn + ((size_t)c * 64 + r) * 128 + 8 * hh;
        f32x16 A00, A10, A11;
#define D1B_TILE_A(tile, rt, ct) do { _Pragma("unroll") for (int i = 0; i < 16; ++i) tile[i] = 0.f; \
        _Pragma("unroll 4") for (int s = 0; s < 8; ++s) { const bf16x8 ka = *(const bf16x8*)(kp + (rt) * 32 * 128 + 16 * s), kb2 = *(const bf16x8*)(kp + (ct) * 32 * 128 + 16 * s); tile = MFMA32(ka, kb2, tile); } \
        const float gcc = tg[32 * (ct) + r]; \
        _Pragma("unroll") for (int g4 = 0; g4 < 4; ++g4) { const int j0 = 32 * (rt) + 8 * g4 + 4 * hh; const f32x4 gj = *(const LDSP f32x4*)(tg + j0), bj = *(const LDSP f32x4*)(tb + j0); \
            _Pragma("unroll") for (int e = 0; e < 4; ++e) tile[4 * g4 + e] *= bj[e] * __expf(fminf(gj[e] - gcc, 0.f)); } } while (0)
        D1B_TILE_A(A00, 0, 0); D1B_TILE_A(A10, 1, 0); D1B_TILE_A(A11, 1, 1);
#undef D1B_TILE_A
        float Tr[64];
        int lane_o = lane; asm volatile("" : "+v"(lane_o));
#pragma unroll
        for (int cc = 63; cc >= 0; --cc) {
            float a0 = (lane_o == cc) ? 1.f : 0.f, a1 = 0.f;
            int z = 0;
            if (cc < 63) asm volatile("" : "+s"(z) : "v"(Tr[cc + 1]));
#pragma unroll
            for (int j = cc + 1; j < 64; ++j) {
                const int rt = j >> 5, ct = cc >> 5, i = 4 * ((j & 31) >> 3) + (j & 3), src = (cc & 31) + 32 * ((j >> 2) & 1);
                const float av = __int_as_float(__builtin_amdgcn_readlane(__float_as_int(rt == 0 ? A00[i] : (ct == 0 ? A10[i] : A11[i])), src + z));
                if (j & 1) a1 = __builtin_fmaf(-Tr[j], av, a1); else a0 = __builtin_fmaf(-Tr[j], av, a0);
            }
            Tr[cc] = a0 + a1;
        }
#pragma unroll
        for (int q = 0; q < 4; ++q)
#pragma unroll
            for (int half = 0; half < 2; ++half) { u32x4_t o;
                const int s0 = 8 * half;
                o.x = pk_bf16(Tr[16 * q + perm16(s0 + 0)], Tr[16 * q + perm16(s0 + 0) + 1]); o.y = pk_bf16(Tr[16 * q + perm16(s0 + 2)], Tr[16 * q + perm16(s0 + 2) + 1]);
                o.z = pk_bf16(Tr[16 * q + perm16(s0 + 4)], Tr[16 * q + perm16(s0 + 4) + 1]); o.w = pk_bf16(Tr[16 * q + perm16(s0 + 6)], Tr[16 * q + perm16(s0 + 6) + 1]);
                *(u32x4_t*)(Tm + ((size_t)c * 64 + lane) * 64 + 16 * q + s0) = o; }
#define D1B_TILE_ATT(jt, it) do { f32x16 tile; _Pragma("unroll") for (int i = 0; i < 16; ++i) tile[i] = 0.f; \
        _Pragma("unroll 4") for (int s = 0; s < 8; ++s) { const bf16x8 ka = *(const bf16x8*)(kp + (jt) * 32 * 128 + 16 * s), qb2 = *(const bf16x8*)(qp + (it) * 32 * 128 + 16 * s); tile = MFMA32(ka, qb2, tile); } \
        const int qi = 32 * (it) + r; const float gi = tg[qi]; \
        _Pragma("unroll") for (int s2 = 0; s2 < 2; ++s2) { float v[8]; \
            _Pragma("unroll") for (int a = 0; a < 2; ++a) { const int j0 = 32 * (jt) + 16 * s2 + 8 * a + 4 * hh; const f32x4 gj = *(const LDSP f32x4*)(tg + j0); \
                _Pragma("unroll") for (int e = 0; e < 4; ++e) v[4 * a + e] = (qi >= j0 + e) ? __expf(fminf(gi - gj[e], 0.f)) * tile[8 * s2 + 4 * a + e] : 0.f; } \
            u32x4_t o; o.x = pk_bf16(v[0], v[1]); o.y = pk_bf16(v[2], v[3]); o.z = pk_bf16(v[4], v[5]); o.w = pk_bf16(v[6], v[7]); \
            *(u32x4_t*)(attn + ((size_t)c * 64 + qi) * 64 + 32 * (jt) + 16 * s2 + 8 * hh) = o; } \
        asm volatile("" ::: "memory"); } while (0)
        D1B_TILE_ATT(0, 0); D1B_TILE_ATT(0, 1); D1B_TILE_ATT(1, 1);
#undef D1B_TILE_ATT
    }
}

typedef short s16x4_tt __attribute__((ext_vector_type(4)));
constexpr int SCAN_BUF = 49152, SCAN_TBL = 3 * SCAN_BUF;
__device__ __forceinline__ int swz256(int row, int ch) { return (row * 16 + (ch ^ (((row & 3) << 2) | ((row >> 2) & 3)))) * 16; }
__device__ __forceinline__ int swz128(int row, int ch) { const int sr = row >> 1; return (sr * 16 + ((((row & 1) << 3) | ch) ^ (sr & 7))) * 16; }
__device__ void phase_dn_scan(const Params& p, unsigned char* smem, int bh) {
    const unsigned char* qnb = p.ws + OFF_DNQ; const unsigned char* knb = p.ws + OFF_DNK;
    const unsigned char* tb_ = p.ws + OFF_T; const unsigned char* atb = p.ws + OFF_ATTN;
    const bf16_t* vimg = (const bf16_t*)(p.ws + OFF_VIMG); bf16_t* orm = (bf16_t*)(p.ws + OFF_ODN);
    const int tid = opaque_tid(), lane = tid & 63, w = __builtin_amdgcn_readfirstlane(tid >> 6), r = lane & 31, hh = lane >> 5;
    LDSP unsigned char* lds = (LDSP unsigned char*)smem;
    auto stage = [&](int n, int bsel) {
        const size_t chunk = (size_t)bh * 64 + n;
        int ln = lane; asm volatile("" : "+v"(ln)); ln &= 63;
#pragma unroll
        for (int i = 0; i < 12; ++i) {
            const int k = (w - 4) * 12 + i; const unsigned char* src;
            if (k < 32) { const int sl = (k & 15) * 64 + ln, row = sl >> 4, ch = (sl & 15) ^ (((row & 3) << 2) | ((row >> 2) & 3)); src = (k < 16 ? knb : qnb) + chunk * 16384 + row * 256 + ch * 16; }
            else { const int sl = (k < 40 ? (k - 32) : (k - 40)) * 64 + ln, sr = sl >> 4, lp = (sl & 15) ^ (sr & 7), row = sr * 2 + (lp >> 3), ch = lp & 7;
                   src = (k < 40 ? tb_ : atb) + chunk * 8192 + row * 128 + ch * 16; }
            __builtin_amdgcn_global_load_lds((const unsigned*)src, (LDSP unsigned*)(lds + bsel * SCAN_BUF + k * 1024), 16, 0, 0);
        }
        if (w == 7) __builtin_amdgcn_global_load_lds((const unsigned*)(p.ws + OFF_SCT + chunk * 1024 + ln * 16), (LDSP unsigned*)(lds + SCAN_TBL + bsel * 1024), 16, 0, 0);
    };
#define SCAN_WAIT_STAGE() do { if (w == 7) asm volatile("s_waitcnt vmcnt(13)" ::: "memory"); else asm volatile("s_waitcnt vmcnt(12)" ::: "memory"); } while (0)
#define SCAN_BAR() do { asm volatile("" ::: "memory"); __builtin_amdgcn_s_barrier(); asm volatile("" ::: "memory"); } while (0)
    f32x16 S[4];
#pragma unroll
    for (int dt = 0; dt < 4; ++dt)
#pragma unroll
        for (int i = 0; i < 16; ++i) S[dt][i] = 0.f;
#define SCAN_SB(kc) __builtin_bit_cast(bf16x8, (u32x4_t){pk_bf16(S[(kc) >> 1][8 * ((kc) & 1)], S[(kc) >> 1][8 * ((kc) & 1) + 1]), pk_bf16(S[(kc) >> 1][8 * ((kc) & 1) + 2], S[(kc) >> 1][8 * ((kc) & 1) + 3]), \
                                                     pk_bf16(S[(kc) >> 1][8 * ((kc) & 1) + 4], S[(kc) >> 1][8 * ((kc) & 1) + 5]), pk_bf16(S[(kc) >> 1][8 * ((kc) & 1) + 6], S[(kc) >> 1][8 * ((kc) & 1) + 7])})
#define SCAN_LDV(dst, ch_) do { _Pragma("unroll") for (int pt = 0; pt < 2; ++pt) _Pragma("unroll") for (int g = 0; g < 2; ++g) dst[pt][g] = *(const u32x4_t*)(vimg + ((((((size_t)bh * 64 + (ch_)) * 4 + w) * 2 + pt) * 2 + g) * 64 + lane) * 8); } while (0)
    u32x4_t vr[2][2], vrn[2][2];
    if (w < 4) { SCAN_LDV(vr, 0); SCAN_LDV(vrn, 1); }
    else { stage(0, 0); stage(1, 1); SCAN_WAIT_STAGE(); }
    SCAN_BAR();
    int bsel = 0;
    for (int n = 0; n < 64; ++n) {
        int bnx = bsel + 2; bnx = bnx >= 3 ? bnx - 3 : bnx;
        if (w >= 4 && n + 2 < 64) stage(n + 2, bnx);
        if (w < 4) {
            const size_t chunk = (size_t)bh * 64 + n;
            u32x4_t vrn2[2][2];
            if (n + 2 < 64) SCAN_LDV(vrn2, n + 2);
            LDSP unsigned char* B = lds + bsel * SCAN_BUF; LDSP float* teg = (LDSP float*)(lds + SCAN_TBL + bsel * 1024); LDSP float* tbeg = teg + 64; LDSP float* tet = teg + 128; LDSP float* tbt = teg + 192;
            LDSP unsigned char* Bkn = B, *Bqn = B + 16384, *BT = B + 32768, *Bat = B + 40960;
            f32x16 X[2], O[2];
#pragma unroll
            for (int i = 0; i < 16; ++i) { X[0][i] = 0.f; X[1][i] = 0.f; O[0][i] = 0.f; O[1][i] = 0.f; }
#pragma unroll
            for (int kc = 0; kc < 8; ++kc) {
                const bf16x8 a0 = *(const LDSP bf16x8*)(Bkn + swz256(r, 2 * kc + hh)), a1 = *(const LDSP bf16x8*)(Bkn + swz256(32 + r, 2 * kc + hh));
                const bf16x8 q0 = *(const LDSP bf16x8*)(Bqn + swz256(r, 2 * kc + hh)), q1 = *(const LDSP bf16x8*)(Bqn + swz256(32 + r, 2 * kc + hh));
                const bf16x8 sb = SCAN_SB(kc); X[0] = MFMA32(a0, sb, X[0]); X[1] = MFMA32(a1, sb, X[1]); O[0] = MFMA32(q0, sb, O[0]); O[1] = MFMA32(q1, sb, O[1]);
            }
            asm volatile("" ::: "memory");
            bf16x8 Yb[2][2];
#pragma unroll
            for (int pt = 0; pt < 2; ++pt) {
                unsigned yp[8];
#pragma unroll
                for (int g4 = 0; g4 < 4; ++g4) { const int j0 = 32 * pt + 8 * g4 + 4 * hh; const f32x4 bg = *(const LDSP f32x4*)(tbeg + j0), bj = *(const LDSP f32x4*)(tbt + j0);
                    float yv[4];
#pragma unroll
                    for (int e = 0; e < 4; ++e) { const int i = 4 * g4 + e;
                        const unsigned vw = vr[pt][i >> 3][(i & 7) >> 1]; const float vv = (i & 1) ? bfhi(vw) : bflo(vw);
                        yv[e] = bj[e] * vv - bg[e] * X[pt][i]; }
                    yp[2 * g4] = pk_bf16(yv[0], yv[1]); yp[2 * g4 + 1] = pk_bf16(yv[2], yv[3]); }
#pragma unroll
                for (int s = 0; s < 2; ++s) { u32x4_t t4; t4.x = yp[4 * s]; t4.y = yp[4 * s + 1]; t4.z = yp[4 * s + 2]; t4.w = yp[4 * s + 3]; Yb[pt][s] = __builtin_bit_cast(bf16x8, t4); }
            }
            asm volatile("" ::: "memory");
            f32x16 Vn[2];
#pragma unroll
            for (int i = 0; i < 16; ++i) { Vn[0][i] = 0.f; Vn[1][i] = 0.f; }
#pragma unroll
            for (int kc = 0; kc < 4; ++kc) {
                if (kc < 2) { const bf16x8 a0 = *(const LDSP bf16x8*)(BT + swz128(r, 2 * kc + hh)); Vn[0] = MFMA32(a0, Yb[kc >> 1][kc & 1], Vn[0]); }
                const bf16x8 a1 = *(const LDSP bf16x8*)(BT + swz128(32 + r, 2 * kc + hh)); Vn[1] = MFMA32(a1, Yb[kc >> 1][kc & 1], Vn[1]);
            }
            asm volatile("" ::: "memory");
            bf16x8 Vnb[2][2], Vsb[2][2];
#pragma unroll
            for (int pt = 0; pt < 2; ++pt) {
                unsigned np[8], sp[8];
#pragma unroll
                for (int g4 = 0; g4 < 4; ++g4) { const int j0 = 32 * pt + 8 * g4 + 4 * hh; const f32x4 et = *(const LDSP f32x4*)(tet + j0);
                    np[2 * g4] = pk_bf16(Vn[pt][4 * g4], Vn[pt][4 * g4 + 1]); np[2 * g4 + 1] = pk_bf16(Vn[pt][4 * g4 + 2], Vn[pt][4 * g4 + 3]);
                    sp[2 * g4] = pk_bf16(Vn[pt][4 * g4] * et[0], Vn[pt][4 * g4 + 1] * et[1]); sp[2 * g4 + 1] = pk_bf16(Vn[pt][4 * g4 + 2] * et[2], Vn[pt][4 * g4 + 3] * et[3]); }
#pragma unroll
                for (int s = 0; s < 2; ++s) { u32x4_t a4, b4; a4.x = np[4 * s]; a4.y = np[4 * s + 1]; a4.z = np[4 * s + 2]; a4.w = np[4 * s + 3]; b4.x = sp[4 * s]; b4.y = sp[4 * s + 1]; b4.z = sp[4 * s + 2]; b4.w = sp[4 * s + 3];
                    Vnb[pt][s] = __builtin_bit_cast(bf16x8, a4); Vsb[pt][s] = __builtin_bit_cast(bf16x8, b4); }
            }
            asm volatile("" ::: "memory");
#pragma unroll
            for (int pt = 0; pt < 2; ++pt)
#pragma unroll
                for (int g4 = 0; g4 < 4; ++g4) { const int j0 = 32 * pt + 8 * g4 + 4 * hh; const f32x4 eg = *(const LDSP f32x4*)(teg + j0);
#pragma unroll
                    for (int e = 0; e < 4; ++e) O[pt][4 * g4 + e] *= eg[e]; }
#pragma unroll
            for (int kc = 0; kc < 4; ++kc) {
                if (kc < 2) { const bf16x8 a0 = *(const LDSP bf16x8*)(Bat + swz128(r, 2 * kc + hh)); O[0] = MFMA32(a0, Vnb[kc >> 1][kc & 1], O[0]); }
                const bf16x8 a1 = *(const LDSP bf16x8*)(Bat + swz128(32 + r, 2 * kc + hh)); O[1] = MFMA32(a1, Vnb[kc >> 1][kc & 1], O[1]);
            }
#pragma unroll
            for (int pt = 0; pt < 2; ++pt)
#pragma unroll
                for (int g = 0; g < 2; ++g) { u32x4_t o; o.x = pk_bf16(O[pt][8 * g], O[pt][8 * g + 1]); o.y = pk_bf16(O[pt][8 * g + 2], O[pt][8 * g + 3]); o.z = pk_bf16(O[pt][8 * g + 4], O[pt][8 * g + 5]); o.w = pk_bf16(O[pt][8 * g + 6], O[pt][8 * g + 7]);
                    *(u32x4_t*)(orm + (((((size_t)chunk * 4 + w) * 2 + pt) * 2 + g) * 64 + lane) * 8) = o; }
            const float glf = teg[63];
            const int blk16 = (lane >> 4) & 1, q4 = (lane & 15) >> 2, pp = lane & 3;
#pragma unroll
            for (int dt = 0; dt < 4; ++dt) {
#pragma unroll
                for (int i = 0; i < 16; ++i) S[dt][i] *= glf;
#pragma unroll
                for (int kc = 0; kc < 4; ++kc) {
                    const int row0 = 16 * kc + 4 * hh + q4, ch = 4 * dt + 2 * blk16 + (pp & 1), sub = 8 * (pp >> 1);
                    const s16x4_tt lo = __builtin_amdgcn_ds_read_tr16_b64_v4i16((LDSP s16x4_tt*)(Bkn + swz256(row0, ch) + sub)), hi = __builtin_amdgcn_ds_read_tr16_b64_v4i16((LDSP s16x4_tt*)(Bkn + swz256(row0 + 8, ch) + sub));
                    S[dt] = MFMA32(__builtin_shufflevector(lo, hi, 0, 1, 2, 3, 4, 5, 6, 7), Vsb[kc >> 1][kc & 1], S[dt]);
                }
            }
#pragma unroll
            for (int pt = 0; pt < 2; ++pt)
#pragma unroll
                for (int g = 0; g < 2; ++g) { vr[pt][g] = vrn[pt][g]; if (n + 2 < 64) vrn[pt][g] = vrn2[pt][g]; }
            asm volatile("s_waitcnt lgkmcnt(0)" ::: "memory");
        } else {
            if (n + 2 < 64) SCAN_WAIT_STAGE(); else asm volatile("s_waitcnt vmcnt(0)" ::: "memory");
        }
        SCAN_BAR();
        bsel = bsel + 1 >= 3 ? 0 : bsel + 1;
    }
#undef SCAN_WAIT_STAGE
#undef SCAN_BAR
#undef SCAN_LDV
}

__device__ void phase_mix(const Params& p, unsigned char* smem) {
    const bf16_t* odn = (const bf16_t*)(p.ws + OFF_ODN); const bf16_t* zs = (const bf16_t*)(p.ws + OFF_Z);
    bf16_t* mixed = (bf16_t*)(p.ws + OFF_MIXED);
    const int tid = opaque_tid(), lane = tid & 63, w8 = tid >> 6;
    LDSP bf16_t* ot = (LDSP bf16_t*)smem;
    constexpr int OTS = 136;
    const int prow = tid >> 3, d16 = (tid & 7) * 16;
    f32x4 wv[4];
#pragma unroll
    for (int i = 0; i < 4; ++i) wv[i] = *(const f32x4*)(p.dn_norm_w + d16 + 4 * i);
    u32x4_t im[2], zn[2];
#define MIXD_LD(c_) do { const int bh_ = (c_) >> 6, n_ = (c_) & 63; const size_t row_ = (size_t)(bh_ >> 2) * SEQ + n_ * 64 + prow; \
        im[0] = *(const u32x4_t*)(odn + (size_t)(c_) * 8192 + (size_t)tid * 8); im[1] = *(const u32x4_t*)(odn + (size_t)(c_) * 8192 + (size_t)(tid + 512) * 8); \
        zn[0] = *(const u32x4_t*)(zs + row_ * 512 + (bh_ & 3) * 128 + d16); zn[1] = *(const u32x4_t*)(zs + row_ * 512 + (bh_ & 3) * 128 + d16 + 8); } while (0)
    int c = blockIdx.x;
    if (c < NB * 4 * 64) MIXD_LD(c);
    for (; c < NB * 4 * 64; c += gridDim.x) {
        const int bh = c >> 6, n = c & 63, h = bh & 3; const size_t row = (size_t)(bh >> 2) * SEQ + n * 64 + prow;
        __syncthreads();
#pragma unroll
        for (int q = 0; q < 2; ++q) { const int pc = tid + 512 * q, lp = pc & 63, g = (pc >> 6) & 1, pt = (pc >> 7) & 1, ws_ = pc >> 8, dv = 32 * ws_ + (lp & 31), p0 = 32 * pt + 16 * g + 4 * (lp >> 5);
            const unsigned vv[4] = {im[q].x, im[q].y, im[q].z, im[q].w};
#pragma unroll
            for (int jj = 0; jj < 8; ++jj) ot[(p0 + 8 * (jj >> 2) + (jj & 3)) * OTS + dv] = (bf16_t)((jj & 1) ? (vv[jj >> 1] >> 16) : (vv[jj >> 1] & 0xFFFFu)); }
        float z[16]; { float t8[8]; unpack8(zn[0], t8);
#pragma unroll
            for (int e = 0; e < 8; ++e) z[e] = t8[e];
            unpack8(zn[1], t8);
#pragma unroll
            for (int e = 0; e < 8; ++e) z[8 + e] = t8[e]; }
        if (c + (int)gridDim.x < NB * 4 * 64) MIXD_LD(c + (int)gridDim.x);
        __syncthreads();
        float o[16]; { float t8[8]; unpack8(*(const LDSP u32x4_t*)(ot + prow * OTS + d16), t8);
#pragma unroll
            for (int e = 0; e < 8; ++e) o[e] = t8[e];
            unpack8(*(const LDSP u32x4_t*)(ot + prow * OTS + d16 + 8), t8);
#pragma unroll
            for (int e = 0; e < 8; ++e) o[8 + e] = t8[e]; }
        float ss = 0.f;
#pragma unroll
        for (int e = 0; e < 16; ++e) ss += o[e] * o[e];
        ss += __shfl_xor(ss, 1); ss += __shfl_xor(ss, 2); ss += __shfl_xor(ss, 4);
        const float rstd = rsqrtf(ss * (1.0f / 128.f) + EPS);
        u32x4_t r4[2];
#pragma unroll
        for (int q = 0; q < 2; ++q) {
            r4[q].x = pk_bf16(o[8 * q + 0] * rstd * wv[2 * q][0] * z[8 * q + 0], o[8 * q + 1] * rstd * wv[2 * q][1] * z[8 * q + 1]); r4[q].y = pk_bf16(o[8 * q + 2] * rstd * wv[2 * q][2] * z[8 * q + 2], o[8 * q + 3] * rstd * wv[2 * q][3] * z[8 * q + 3]);
            r4[q].z = pk_bf16(o[8 * q + 4] * rstd * wv[2 * q + 1][0] * z[8 * q + 4], o[8 * q + 5] * rstd * wv[2 * q + 1][1] * z[8 * q + 5]); r4[q].w = pk_bf16(o[8 * q + 6] * rstd * wv[2 * q + 1][2] * z[8 * q + 6], o[8 * q + 7] * rstd * wv[2 * q + 1][3] * z[8 * q + 7]);
            *(u32x4_t*)(mixed + row * DM + h * 128 + d16 + 8 * q) = r4[q];
        }
    }
#undef MIXD_LD
    (void)lane; (void)w8;
}

__device__ void phase_att_combine(const Params& p, int vb, int vg) {
    const bf16_t* gate = (const bf16_t*)(p.ws + OFF_GATE); const bf16_t* attp = (const bf16_t*)(p.ws + OFF_ATTP); const float* lse = (const float*)(p.ws + OFF_LSE);
    bf16_t* mixed = (bf16_t*)(p.ws + OFF_MIXED);
    const int tid = opaque_tid(), lane = tid & 63, wpb = blockDim.x >> 6, gw = vb * wpb + (tid >> 6), nw = vg * wpb;
    {
        const int d8 = (lane & 7) * 8; const size_t PS = (size_t)MROWS * 8;
        u32x4_t a0n = {0, 0, 0, 0}, a1n = a0n, a2n = a0n, gtn = a0n; float l0n = 0.f, l1n = 0.f, l2n = 0.f;
#define MIX_LD_AT(g_) do { const int bh_ = (g_) >> 9, t_ = ((g_) & 511) * 8 + (lane >> 3); const size_t q_ = (size_t)bh_ * SEQ + t_, row_ = (size_t)(bh_ >> 3) * SEQ + t_; \
        l0n = lse[q_]; l1n = lse[PS + q_]; l2n = lse[2 * PS + q_]; a0n = *(const u32x4_t*)(attp + q_ * 64 + d8); a1n = *(const u32x4_t*)(attp + (PS + q_) * 64 + d8); a2n = *(const u32x4_t*)(attp + (2 * PS + q_) * 64 + d8); \
        gtn = *(const u32x4_t*)(gate + row_ * 512 + (bh_ & 7) * 64 + d8); } while (0)
        if (gw < MROWS) MIX_LD_AT(gw);
        for (int g = gw; g < MROWS; g += nw) {
            const int bh = g >> 9, t = (g & 511) * 8 + (lane >> 3), b = bh >> 3, h = bh & 7; const size_t row = (size_t)b * SEQ + t;
            const float l0 = l0n, l1 = l1n, l2 = l2n;
            float a0[8], a1[8], a2[8], gt[8];
            unpack8(a0n, a0); unpack8(a1n, a1); unpack8(a2n, a2); unpack8(gtn, gt);
            if (g + nw < MROWS) MIX_LD_AT(g + nw);
            const float mx = fmaxf(l0, fmaxf(l1, l2));
            float w0 = __builtin_amdgcn_exp2f(l0 - mx), w1 = __builtin_amdgcn_exp2f(l1 - mx), w2 = __builtin_amdgcn_exp2f(l2 - mx); const float inv = 1.0f / (w0 + w1 + w2); w0 *= inv; w1 *= inv; w2 *= inv;
            float o[8];
#pragma unroll
            for (int e = 0; e < 8; ++e) o[e] = (w0 * a0[e] + w1 * a1[e] + w2 * a2[e]) * gt[e];
            u32x4_t r4; r4.x = pk_bf16(o[0], o[1]); r4.y = pk_bf16(o[2], o[3]); r4.z = pk_bf16(o[4], o[5]); r4.w = pk_bf16(o[6], o[7]);
            *(u32x4_t*)(mixed + row * DM + 512 + h * 64 + d8) = r4;
        }
#undef MIX_LD_AT
    }
}

__device__ __forceinline__ int t5_bucket_dev(int d) {
    if (d < 16) return d;
    int bkt = 16;
    const int bnd[15] = {22, 30, 40, 54, 73, 99, 134, 182, 246, 332, 450, 609, 825, 1117, 1513};
#pragma unroll
    for (int i = 0; i < 15; ++i) bkt += (d >= bnd[i]) ? 1 : 0;
    return bkt;
}
constexpr int ATT_UNITS = NB * 8 * 48;
constexpr int ATT_K = 0, ATT_V = 49152, ATT_Q = 98304, ATT_RB = 131072, ATT_TAB = ATT_RB + 1024 + 1024;
typedef short s16x4_t __attribute__((ext_vector_type(4)));
struct AttUnit { int pat, rd, res, M0, h; size_t hb; };
__device__ __forceinline__ AttUnit att_decode(int unit) {
    AttUnit a; const int bh = unit / 48, u = unit % 48, v = u & 15; a.pat = u >> 4; a.h = bh & 7; a.hb = (size_t)bh * SEQ;
    a.rd = a.pat == 0 ? 1 : (a.pat == 1 ? 4 : 16); a.res = a.pat == 0 ? 0 : (a.pat == 1 ? (v >> 2) : v); a.M0 = (a.pat == 0 ? v : (a.pat == 1 ? (v & 3) : 0)) * 256; return a;
}
#define ATT_WAITV(n) asm volatile("s_waitcnt vmcnt(" #n ")" ::: "memory")
#define ATT_WAITL() asm volatile("s_waitcnt lgkmcnt(0)" ::: "memory")
#define ATT_BAR() do { asm volatile("" ::: "memory"); __builtin_amdgcn_s_barrier(); asm volatile("" ::: "memory"); } while (0)
#define LDS_RD128(dst, addr) asm volatile("ds_read_b128 %0, %1" : "=v"(dst) : "v"(addr))
#define LDS_RDTR(dst, addr, off) asm volatile("ds_read_b64_tr_b16 %0, %1 offset:%2" : "=v"(dst) : "v"(addr), "i"(off))
#define LDS_RD32(dst, addr) asm volatile("ds_read_b32 %0, %1" : "=v"(dst) : "v"(addr))
#define LDS_WR32(addr, val) asm volatile("ds_write_b32 %0, %1" :: "v"(addr), "v"(val) : "memory")
#define LDS_WAIT4(n, a, b, c, d) asm volatile("s_waitcnt lgkmcnt(" #n ")" : "+v"(a), "+v"(b), "+v"(c), "+v"(d))
__device__ void phase_attn(const Params& p, unsigned char* smem, int vb, int vg) {
    const unsigned char* aqb = p.ws + OFF_AQ; const unsigned char* akb = p.ws + OFF_AK; const unsigned char* avb = p.ws + OFF_AV;
    const int tid = opaque_tid(), w = __builtin_amdgcn_readfirstlane(tid >> 6);
    LDSP unsigned char* lds = (LDSP unsigned char*)smem; const unsigned ldsb = (unsigned)(size_t)lds;
    const bool xcd_map = (vg % 8 == 0) && ((NB * 8) % 8 == 0);
    const int cls = vb & 7, rank = vb >> 3, per_cls = vg >> 3, n_cls_units = (NB * 8 / 8) * 48;
    auto unit_of = [&](int j) -> int { return xcd_map ? ((cls + 8 * (j / 48)) * 48 + (j % 48)) : j; };
    int jj = xcd_map ? rank : vb; const int jstep = xcd_map ? per_cls : vg, jend = xcd_map ? n_cls_units : ATT_UNITS;
    if (jj >= jend) return;
    int unit = unit_of(jj);
    if (tid < 256) ((LDSP float*)(lds + ATT_RB))[tid] = p.rel_bias[tid];
    asm volatile("s_waitcnt vmcnt(0) lgkmcnt(0)" ::: "memory");
    auto issue_kq = [&](const AttUnit& a) {
        int ln = tid; asm volatile("" : "+v"(ln)); ln &= 63;
#pragma unroll
        for (int i = 0; i < 6; ++i) { const int k = w * 6 + i, sl = k * 64 + ln, row = sl >> 3, ch = (sl & 7) ^ ((row >> 1) & 7); int mk = a.M0 - 128 + row; mk = mk < 0 ? 0 : mk;
            __builtin_amdgcn_global_load_lds((const unsigned*)(akb + (a.hb + (size_t)att_perm(mk * a.rd + a.res)) * 128 + ch * 16), (LDSP unsigned*)(lds + ATT_K + k * 1024), 16, 0, 0); }
#pragma unroll
        for (int i = 0; i < 4; ++i) { const int k = w * 4 + i, sl = k * 64 + ln, row = sl >> 3, ch = (sl & 7) ^ ((row >> 1) & 7);
            __builtin_amdgcn_global_load_lds((const unsigned*)(aqb + (a.hb + (size_t)att_perm((a.M0 + row) * a.rd + a.res)) * 128 + ch * 16), (LDSP unsigned*)(lds + ATT_Q + k * 1024), 16, 0, 0); }
    };
    auto issue_v = [&](const AttUnit& a) {
        int ln = tid; asm volatile("" : "+v"(ln)); ln &= 63;
#pragma unroll
        for (int i = 0; i < 6; ++i) { const int k = w * 6 + i, sl = k * 64 + ln, row = sl >> 3, ch = (sl & 7) ^ (((row >> 1) & 1) << 2); int mk = a.M0 - 128 + row; mk = mk < 0 ? 0 : mk;
            __builtin_amdgcn_global_load_lds((const unsigned*)(avb + (a.hb + (size_t)att_perm(mk * a.rd + a.res)) * 128 + ch * 16), (LDSP unsigned*)(lds + ATT_V + k * 1024), 16, 0, 0); }
    };
    AttUnit cur = att_decode(unit);
    issue_kq(cur); issue_v(cur);
    for (;;) {
        const int jn = jj + jstep; const bool has_next = jn < jend; const int nxt = has_next ? unit_of(jn) : unit;
        int lane = tid; asm volatile("" : "+v"(lane)); lane &= 63;
        const int r = lane & 31, hh = lane >> 5, blk16 = (lane >> 4) & 1, q4 = (lane & 15) >> 2, pp = lane & 3;
        if (tid < 129) { float bv; LDS_RD32(bv, ldsb + ATT_RB + (cur.h * 32 + t5_bucket_dev(tid * cur.rd)) * 4); asm volatile("s_waitcnt lgkmcnt(0)" : "+v"(bv)); bv *= 1.4426950408889634f; LDS_WR32(ldsb + ATT_TAB + tid * 4, bv); }
        ATT_WAITV(6); ATT_WAITL(); ATT_BAR();
        const int M0 = cur.M0;
        f32x16 Sc[5];
        {
            const int qrow = 32 * w + r, qsw = (qrow >> 1) & 7;
            bf16x8 qf[4], kf[2][4];
#pragma unroll
            for (int s = 0; s < 4; ++s) LDS_RD128(qf[s], ldsb + ATT_Q + qrow * 128 + (((2 * s + hh) ^ qsw) << 4));
#define ATT_RDK(kt_, dst) do { const int krow_ = 32 * w + 32 * (kt_) + r, ksw_ = (krow_ >> 1) & 7; \
            _Pragma("unroll") for (int s = 0; s < 4; ++s) LDS_RD128(dst[s], ldsb + ATT_K + krow_ * 128 + (((2 * s + hh) ^ ksw_) << 4)); } while (0)
            ATT_RDK(0, kf[0]);
#pragma unroll
            for (int kt = 0; kt < 5; ++kt) {
                if (kt < 4) { ATT_RDK(kt + 1, kf[(kt + 1) & 1]); LDS_WAIT4(4, kf[kt & 1][0], kf[kt & 1][1], kf[kt & 1][2], kf[kt & 1][3]); }
                else LDS_WAIT4(0, kf[kt & 1][0], kf[kt & 1][1], kf[kt & 1][2], kf[kt & 1][3]);
                if (kt == 0) asm volatile("" : "+v"(qf[0]), "+v"(qf[1]), "+v"(qf[2]), "+v"(qf[3]));
#pragma unroll
                for (int i = 0; i < 16; ++i) Sc[kt][i] = 0.f;
                if (kt == 4 || M0 > 0 || w + kt >= 4) {
#pragma unroll
                    for (int s = 0; s < 4; ++s) Sc[kt] = MFMA32(kf[kt & 1][s], qf[s], Sc[kt]);
                }
            }
#undef ATT_RDK
        }
        ATT_WAITL(); ATT_BAR();
        AttUnit nx = cur;
        if (has_next) { nx = att_decode(nxt); issue_kq(nx); }
        const int rr = r - 4 * hh;
        const unsigned bta = ldsb + ATT_TAB + (128 + rr - 159) * 4;
        float mx = -INFINITY;
#pragma unroll
        for (int kt = 0; kt < 5; ++kt) {
            if (kt == 4 || M0 > 0 || w + kt >= 4) {
                float bb[16];
#pragma unroll
                for (int i = 0; i < 16; ++i) asm volatile("ds_read_b32 %0, %1 offset:%2" : "=v"(bb[i]) : "v"(bta), "i"((159 - (32 * kt + 8 * (i >> 2) + (i & 3))) * 4));
                asm volatile("s_waitcnt lgkmcnt(0)" : "+v"(bb[0]), "+v"(bb[1]), "+v"(bb[2]), "+v"(bb[3]), "+v"(bb[4]), "+v"(bb[5]), "+v"(bb[6]), "+v"(bb[7]), "+v"(bb[8]), "+v"(bb[9]), "+v"(bb[10]), "+v"(bb[11]), "+v"(bb[12]), "+v"(bb[13]), "+v"(bb[14]), "+v"(bb[15]));
#pragma unroll
                for (int i = 0; i < 16; ++i) { const int cr = 8 * (i >> 2) + (i & 3);
                    float sc = Sc[kt][i] + bb[i];
                    if (kt == 0) sc = (rr <= cr) ? sc : -INFINITY;
                    if (kt == 4) sc = (rr >= cr) ? sc : -INFINITY;
                    Sc[kt][i] = sc; mx = fmaxf(mx, sc); }
            } else {
#pragma unroll
                for (int i = 0; i < 16; ++i) Sc[kt][i] = -INFINITY;
            }
        }
        mx = fmaxf(mx, __shfl_xor(mx, 32));
        float lsum = 0.f;
#pragma unroll
        for (int kt = 0; kt < 5; ++kt)
#pragma unroll
            for (int i = 0; i < 16; ++i) { const float e = __builtin_amdgcn_exp2f(Sc[kt][i] - mx); Sc[kt][i] = e; lsum += e; }
        lsum += __shfl_xor(lsum, 32);
        if (has_next) ATT_WAITV(10); else ATT_WAITV(0);
        ATT_WAITL(); ATT_BAR();
        f32x16 O[2];
#pragma unroll
        for (int i = 0; i < 16; ++i) { O[0][i] = 0.f; O[1][i] = 0.f; }
        const int xb = (q4 >> 1) & 1;
        const unsigned vl0 = ldsb + ATT_V + (32 * w + 4 * hh + q4) * 128 + ((2 * blk16 + (pp >> 1)) + 4 * xb) * 16 + 8 * (pp & 1);
        const unsigned vl1 = ldsb + ATT_V + (32 * w + 4 * hh + q4) * 128 + ((2 * blk16 + (pp >> 1)) + 4 * (xb ^ 1)) * 16 + 8 * (pp & 1);
        s16x4_t va[2][4];
#define ATT_RDV(it_, dst) do { LDS_RDTR(dst[0], vl0, (it_) * 2048); LDS_RDTR(dst[1], vl0, (it_) * 2048 + 1024); LDS_RDTR(dst[2], vl1, (it_) * 2048); LDS_RDTR(dst[3], vl1, (it_) * 2048 + 1024); } while (0)
        ATT_RDV(0, va[0]);
#pragma unroll
        for (int it = 0; it < 10; ++it) {
            const int kt = it >> 1, s2 = it & 1;
            u32x4_t pk; pk.x = pk_bf16(Sc[kt][8 * s2], Sc[kt][8 * s2 + 1]); pk.y = pk_bf16(Sc[kt][8 * s2 + 2], Sc[kt][8 * s2 + 3]); pk.z = pk_bf16(Sc[kt][8 * s2 + 4], Sc[kt][8 * s2 + 5]); pk.w = pk_bf16(Sc[kt][8 * s2 + 6], Sc[kt][8 * s2 + 7]);
            const bf16x8 pb = __builtin_bit_cast(bf16x8, pk);
            if (it < 9) { ATT_RDV(it + 1, va[(it + 1) & 1]); LDS_WAIT4(4, va[it & 1][0], va[it & 1][1], va[it & 1][2], va[it & 1][3]); }
            else LDS_WAIT4(0, va[it & 1][0], va[it & 1][1], va[it & 1][2], va[it & 1][3]);
            O[0] = MFMA32(__builtin_shufflevector(va[it & 1][0], va[it & 1][1], 0, 1, 2, 3, 4, 5, 6, 7), pb, O[0]);
            O[1] = MFMA32(__builtin_shufflevector(va[it & 1][2], va[it & 1][3], 0, 1, 2, 3, 4, 5, 6, 7), pb, O[1]);
        }
#undef ATT_RDV
        ATT_WAITL(); ATT_BAR();
        const int mq = M0 + 32 * w + r; const size_t tq = cur.hb + (size_t)(mq * cur.rd + cur.res);
        const float inv = 1.0f / lsum;
        bf16_t* op = (bf16_t*)(p.ws + OFF_ATTP) + ((size_t)cur.pat * MROWS * 8 + tq) * 64;
#pragma unroll
        for (int dt = 0; dt < 2; ++dt)
#pragma unroll
            for (int g4 = 0; g4 < 4; ++g4) { u32x2_t o; o.x = pk_bf16(O[dt][4 * g4] * inv, O[dt][4 * g4 + 1] * inv); o.y = pk_bf16(O[dt][4 * g4 + 2] * inv, O[dt][4 * g4 + 3] * inv);
                *(u32x2_t*)(op + 32 * dt + 8 * g4 + 4 * hh) = o; }
        if (hh == 0) ((float*)(p.ws + OFF_LSE))[(size_t)cur.pat * MROWS * 8 + tq] = mx + __log2f(lsum);
        if (!has_next) break;
        issue_v(nx);
        cur = nx; unit = nxt; jj = jn;
    }
    asm volatile("s_waitcnt vmcnt(0)" ::: "memory");
}
#undef ATT_WAITV
#undef ATT_WAITL
#undef ATT_BAR
#undef LDS_RD128
#undef LDS_RDTR
#undef LDS_RD32
#undef LDS_WR32
#undef LDS_WAIT4

#define XB_TMO      128
#define XB_XCNT(j)  (256  + 64 * (j))
#define XB_XSUB(j)  (1280 + 64 * (j))
#define XB_XGEN(j)  (2304 + 64 * (j))
#define XB_TOP      3328
#define XB_TOPGEN   3392
#define XCD_BAR_WORDS 3456
#define XB_SPIN_CAP (1u << 18)
#define LAS __attribute__((address_space(3)))

__device__ __forceinline__ unsigned xb_ld(unsigned* p)              { return __hip_atomic_load(p, __ATOMIC_RELAXED, __HIP_MEMORY_SCOPE_AGENT); }
__device__ __forceinline__ unsigned xb_add(unsigned* p, unsigned v) { return __hip_atomic_fetch_add(p, v, __ATOMIC_RELAXED, __HIP_MEMORY_SCOPE_AGENT); }
__device__ __forceinline__ unsigned xb_xcc_id() { return (unsigned)__builtin_amdgcn_s_getreg((3 << 11) | 20) & 0xFu; }
#define XB_SPIN(cond, bar) do { unsigned _sp = 0; while (cond) { __builtin_amdgcn_s_sleep(1); \
    if ((++_sp & 255u) == 0u) { if (xb_ld(&(bar)[XB_TMO])) break; if (_sp > XB_SPIN_CAP) { atomicAdd(&(bar)[XB_TMO], 1u); break; } } } } while (0)

struct XcdBarrier {
    unsigned* bar; unsigned x;
    volatile LAS unsigned* st;
};

__device__ __forceinline__ XcdBarrier xcd_barrier_post(unsigned* bar, volatile LAS unsigned* st) {
    XcdBarrier b; b.bar = bar; b.x = xb_xcc_id(); b.st = st;
    if (threadIdx.x == 0) (void)xb_add(&bar[XB_XCNT(b.x)], 1u);
    return b;
}
__device__ __forceinline__ void xcd_barrier_complete(unsigned* bar, unsigned x, unsigned& nloc, unsigned& nx) {
    const unsigned G = gridDim.x * gridDim.y * gridDim.z;
    unsigned sum, cnt, mine, sp = 0u;
    for (;;) {
        sum = 0u; cnt = 0u; mine = 0u;
#pragma unroll
        for (unsigned j = 0; j < 16; ++j) { const unsigned c = xb_ld(&bar[XB_XCNT(j)]); sum += c; cnt += (c > 0u) ? 1u : 0u; mine = (j == x) ? c : mine; }
        if (sum == G) break;
        __builtin_amdgcn_s_sleep(1);
        if ((++sp & 255u) == 0u) { if (xb_ld(&bar[XB_TMO])) break; if (sp > XB_SPIN_CAP) { atomicAdd(&bar[XB_TMO], 1u); break; } }
    }
    nloc = mine > 0u ? mine : 1u; nx = cnt > 0u ? cnt : 1u;
}

__device__ __forceinline__ void xcd_barrier(const XcdBarrier& b) {
    asm volatile("s_waitcnt vmcnt(0)" ::: "memory");
    __syncthreads();
    if (threadIdx.x == 0) {
        unsigned* bar = b.bar;
        __builtin_amdgcn_s_waitcnt(0);
        unsigned nloc = b.st[0], nx = b.st[1];
        if (nloc == 0u) { xcd_barrier_complete(bar, b.x, nloc, nx); b.st[0] = nloc; b.st[1] = nx; }
        const unsigned old = xb_add(&bar[XB_XSUB(b.x)], 1u);
        const unsigned gen = old / nloc;
        if (old + 1u == (gen + 1u) * nloc) {
            __builtin_amdgcn_fence(__ATOMIC_RELEASE, "agent");
            asm volatile("s_waitcnt vmcnt(0)" ::: "memory");
            const unsigned og = xb_add(&bar[XB_TOP], 1u);
            const unsigned tg = og / nx;
            if (og + 1u == (tg + 1u) * nx) xb_add(&bar[XB_TOPGEN], 1u);
            else XB_SPIN(xb_ld(&bar[XB_TOPGEN]) == tg, bar);
            __builtin_amdgcn_fence(__ATOMIC_ACQUIRE, "agent");
            xb_add(&bar[XB_XGEN(b.x)], 1u);
            asm volatile("s_waitcnt vmcnt(0)" ::: "memory");
        } else {
            XB_SPIN(xb_ld(&bar[XB_XGEN(b.x)]) == gen, bar);
            __builtin_amdgcn_fence(__ATOMIC_ACQUIRE, "agent");
            asm volatile("s_waitcnt vmcnt(0)" ::: "memory");
        }
    }
    __syncthreads();
}

constexpr int NTHREADS = 512;
constexpr size_t DYN_LDS = 155648;
constexpr int SCAN_BLOCKS = 32;
__global__ void __launch_bounds__(NTHREADS, 2) fwd_mega(Params p) {
    cg::grid_group grid = cg::this_grid();
    extern __shared__ __attribute__((aligned(16))) unsigned char smem[];
    float* smf = (float*)smem;
    volatile LAS unsigned* xbst = (volatile LAS unsigned*)((LAS unsigned char*)smem + DYN_LDS - 16);
    if (threadIdx.x < 4) xbst[threadIdx.x] = 0u;
    __syncthreads();
    const XcdBarrier xbar = xcd_barrier_post((unsigned*)(p.ws + OFF_BAR), xbst);
    if (p.ws == nullptr) grid.sync();
#define GRID_SYNC() xcd_barrier(xbar)
#ifndef PROBE_SPIN
#define PROBE_SPIN -1
#endif
    unsigned long long ts_[9];
#define STAMP(i) do { if (PROBE_SPIN >= 0) ts_[i] = __builtin_amdgcn_s_memrealtime(); } while (0)
    STAMP(0);
#ifndef PROBE_DUP
#define PROBE_DUP 0
#endif
#define PH_P0()    do { phase_weights(p, smf + 8192); phase_norm(p, smf); GRID_SYNC(); } while (0)
#define PH_GEMM1() do { pg8::Gemm g{(const bf16_t*)(p.ws + OFF_XN), (const bf16_t*)(p.ws + OFF_WTIN), MROWS, NPK, DM}; pg8::StaticOrder S; S.init(MROWS, NPK, (int)gridDim.x, (int)blockIdx.x); \
      EpiProjSplit E{p.ws, p.q_norm_w, p.k_norm_w}; pg8::gemm_phase<EpiProjSplit, pg8::StaticOrder, true, true>((PG8_LAS unsigned char*)smem, g, S, E); GRID_SYNC(); } while (0)
#define PH_PREP()  do { phase_dn_prep(p, smem); GRID_SYNC(); } while (0)
#define PH_CHUNK() do { phase_dn_chunk(p, smem); GRID_SYNC(); } while (0)
#define PH_SCAN()  do { if ((int)blockIdx.x < SCAN_BLOCKS) phase_dn_scan(p, smem, blockIdx.x); else { const int na_ = (int)gridDim.x - SCAN_BLOCKS; phase_attn(p, smem, blockIdx.x - SCAN_BLOCKS, na_); \
          \
        asm volatile("s_waitcnt vmcnt(0)" ::: "memory"); __syncthreads(); \
        if (threadIdx.x == 0) { unsigned* cnt_ = (unsigned*)(p.ws + OFF_BAR); __builtin_amdgcn_fence(__ATOMIC_RELEASE, "agent"); asm volatile("s_waitcnt vmcnt(0)" ::: "memory"); \
            __hip_atomic_fetch_add(cnt_, 1u, __ATOMIC_RELAXED, __HIP_MEMORY_SCOPE_AGENT); unsigned spins_ = 0; \
            while (__hip_atomic_load(cnt_, __ATOMIC_RELAXED, __HIP_MEMORY_SCOPE_AGENT) < (unsigned)na_) { __builtin_amdgcn_s_sleep(8); if (++spins_ > (1u << 22)) break; } \
            __builtin_amdgcn_fence(__ATOMIC_ACQUIRE, "agent"); asm volatile("s_waitcnt vmcnt(0)" ::: "memory"); } \
        __syncthreads(); phase_att_combine(p, blockIdx.x - SCAN_BLOCKS, na_); } GRID_SYNC(); } while (0)
#define PH_MIX()   do { phase_mix(p, smem); GRID_SYNC(); } while (0)
#define PH_GEMM2() do { pg8::Gemm g{(const bf16_t*)(p.ws + OFF_MIXED), (const bf16_t*)(p.ws + OFF_WTOUT), MROWS, DM, DM}; pg8::StaticOrder S; S.init(MROWS, DM, (int)gridDim.x, (int)blockIdx.x); \
      EpiOutRes E{p.x, p.out}; pg8::gemm_phase<EpiOutRes, pg8::StaticOrder, true, true>((PG8_LAS unsigned char*)smem, g, S, E); } while (0)
    PH_P0();    STAMP(1);
    PH_GEMM1(); STAMP(2);
    PH_PREP();  STAMP(3);
    PH_CHUNK(); STAMP(4);
    PH_SCAN();  STAMP(5);
    PH_MIX();   STAMP(6);
    PH_GEMM2(); STAMP(7);
    if (PROBE_SPIN >= 0 && blockIdx.x == 0 && threadIdx.x == 0) {
        const unsigned long long d = ts_[PROBE_SPIN + 1 > 7 ? 7 : PROBE_SPIN + 1] - ts_[PROBE_SPIN > 7 ? 7 : (PROBE_SPIN < 0 ? 0 : PROBE_SPIN)], t0 = __builtin_amdgcn_s_memrealtime();
        while (__builtin_amdgcn_s_memrealtime() - t0 < d) __builtin_amdgcn_s_sleep(4);
    }
}

extern "C" void kernel_launch(void* const* d_in, const int* in_sizes, int n_in, void* d_out, int out_size, void* d_ws, size_t ws_size, hipStream_t stream) {
    (void)in_sizes; (void)n_in; (void)out_size;
    if (ws_size < WS_NEED) { fprintf(stderr, "workspace too small: %zu < %zu\n", ws_size, (size_t)WS_NEED); return; }
    static int grid_blocks = 0;
    if (!grid_blocks) {
        int dev = 0, cus = 0, per_cu = 0;
        (void)hipGetDevice(&dev);
        (void)hipDeviceGetAttribute(&cus, hipDeviceAttributeMultiprocessorCount, dev);
        (void)hipFuncSetAttribute((const void*)fwd_mega, hipFuncAttributeMaxDynamicSharedMemorySize, (int)DYN_LDS);
        (void)hipOccupancyMaxActiveBlocksPerMultiprocessor(&per_cu, fwd_mega, NTHREADS, DYN_LDS);
        if (per_cu > 1) per_cu = 1;
        grid_blocks = cus * per_cu;
        if (grid_blocks <= SCAN_BLOCKS) fprintf(stderr, "grid too small: %d\n", grid_blocks);
    }
    Params p{};
    p.x = (const float*)d_in[0]; p.norm_w = (const float*)d_in[1]; p.w_in = (const float*)d_in[2]; p.conv_w = (const float*)d_in[3]; p.a_log = (const float*)d_in[4];
    p.dt_bias = (const float*)d_in[5]; p.dn_norm_w = (const float*)d_in[6]; p.q_norm_w = (const float*)d_in[7]; p.k_norm_w = (const float*)d_in[8]; p.rel_bias = (const float*)d_in[9];
    p.w_out = (const float*)d_in[10]; p.out = (float*)d_out; p.ws = (unsigned char*)d_ws;
    (void)hipMemsetAsync((unsigned char*)d_ws + OFF_BAR, 0, XCD_BAR_WORDS * 4, stream);
    void* args[] = {&p};
    hipError_t e = hipLaunchCooperativeKernel((const void*)fwd_mega, dim3(grid_blocks), dim3(NTHREADS), args, DYN_LDS, stream);
    if (e != hipSuccess) fprintf(stderr, "cooperative launch failed: %s (grid %d)\n", hipGetErrorString(e), grid_blocks);
}
```

```cpp
#include <hip/hip_runtime.h>
#include <hip/hip_cooperative_groups.h>
#include <cstdint>
#include <cstdio>
namespace cg = cooperative_groups;

typedef unsigned short bf16_t;
typedef short bf16x8 __attribute__((ext_vector_type(8)));
typedef float f32x4 __attribute__((ext_vector_type(4)));
typedef float f32x16 __attribute__((ext_vector_type(16)));
typedef unsigned u32x4_t __attribute__((ext_vector_type(4)));
typedef unsigned u32x2_t __attribute__((ext_vector_type(2)));
typedef __bf16 bf16x2_t __attribute__((ext_vector_type(2)));
typedef float f32x2_t __attribute__((ext_vector_type(2)));
#define LDSP __attribute__((address_space(3)))

constexpr int NB = 8, SEQ = 4096, DM = 1024, MROWS = NB * SEQ;
constexpr int DIN = 4104, NPK = 4096;
constexpr int ATH = 8;
constexpr float EPS = 1e-6f;
constexpr size_t MiB = (size_t)1 << 20;

constexpr size_t OFF_R0 = 0;
constexpr size_t OFF_XN = OFF_R0, OFF_DNQ = OFF_R0, OFF_DNK = OFF_R0 + 32 * MiB;
constexpr size_t OFF_WTIN = 64 * MiB;
constexpr size_t OFF_WTOUT = 72 * MiB;
constexpr size_t OFF_BETA = 74 * MiB;
constexpr size_t OFF_G = OFF_BETA + MiB / 2;
constexpr size_t OFF_GCUM = 75 * MiB;
constexpr size_t OFF_BAR = 75 * MiB + MiB / 2;
constexpr size_t OFF_R3 = 76 * MiB;
constexpr size_t OFF_PROJDN = OFF_R3, OFF_ATTP = OFF_R3  , OFF_LSE = OFF_R3 + 96 * MiB  ;
constexpr size_t OFF_Z = 176 * MiB;
constexpr size_t OFF_MIXED = 208 * MiB;
constexpr size_t OFF_AQ = 208 * MiB;
constexpr size_t OFF_AK = 240 * MiB;
constexpr size_t OFF_AV = 272 * MiB;
constexpr size_t OFF_GATE = 304 * MiB;
constexpr size_t OFF_KNT = 336 * MiB;
constexpr size_t OFF_VIMG = 368 * MiB;
constexpr size_t OFF_T = 400 * MiB;
constexpr size_t OFF_ATTN = 416 * MiB;
constexpr size_t OFF_SCT = 464 * MiB;
constexpr size_t OFF_ODN = 432 * MiB;
constexpr size_t OFF_CONVP = 466 * MiB;
constexpr size_t WS_NEED = 467 * MiB;

__device__ __forceinline__ bf16_t f2bf(float f) { unsigned u = __float_as_uint(f); u += 0x7FFFu + ((u >> 16) & 1u); return (bf16_t)(u >> 16); }
__device__ __forceinline__ float bf2f(bf16_t b) { return __uint_as_float(((unsigned)b) << 16); }
__device__ __forceinline__ float wave_sum(float v) {
#pragma unroll
    for (int o = 32; o >= 1; o >>= 1) v += __shfl_xor(v, o);
    return v;
}
template <int CTRL> __device__ __forceinline__ float dpp_get(float v) { return __builtin_bit_cast(float, __builtin_amdgcn_update_dpp(0, __builtin_bit_cast(int, v), CTRL, 0xF, 0xF, true)); }
__device__ __forceinline__ float wave_sum_dpp(float v) {
    v += dpp_get<0xB1>(v); v += dpp_get<0x4E>(v); v += dpp_get<0x141>(v); v += dpp_get<0x140>(v);
    v += __builtin_bit_cast(float, __builtin_amdgcn_update_dpp(0, __builtin_bit_cast(int, v), 0x142, 0xA, 0xF, false));
    v += __builtin_bit_cast(float, __builtin_amdgcn_update_dpp(0, __builtin_bit_cast(int, v), 0x143, 0xC, 0xF, false));
    return __builtin_bit_cast(float, __builtin_amdgcn_readlane(__builtin_bit_cast(int, v), 63));
}
__device__ __forceinline__ float wave_max(float v) {
#pragma unroll
    for (int o = 32; o >= 1; o >>= 1) v = fmaxf(v, __shfl_xor(v, o));
    return v;
}
__device__ __forceinline__ float silu_f(float y) { return y * __builtin_amdgcn_rcpf(1.0f + __expf(-y)); }
__device__ __forceinline__ unsigned pk_bf16(float lo, float hi) { f32x2_t v = {lo, hi}; return __builtin_bit_cast(unsigned, __builtin_convertvector(v, bf16x2_t)); }
__device__ __forceinline__ float bflo(unsigned u) { return __uint_as_float(u << 16); }
__device__ __forceinline__ float bfhi(unsigned u) { return __uint_as_float(u & 0xFFFF0000u); }
__device__ __forceinline__ void unpack8(const u32x4_t v, float (&f)[8]) { f[0] = bflo(v.x); f[1] = bfhi(v.x); f[2] = bflo(v.y); f[3] = bfhi(v.y); f[4] = bflo(v.z); f[5] = bfhi(v.z); f[6] = bflo(v.w); f[7] = bfhi(v.w); }
__host__ __device__ __forceinline__ int crow(int i, int hh) { return (i & 3) + 8 * (i >> 2) + 4 * hh; }
__host__ __device__ __forceinline__ int perm16(int x) { return (x & ~12) | ((x & 4) << 1) | ((x & 8) >> 1); }
#define MFMA32(a, b, c) __builtin_amdgcn_mfma_f32_32x32x16_bf16((a), (b), (c), 0, 0, 0)
__host__ __device__ __forceinline__ size_t vimg_index(int chunk, int pos, int dv) {
    const int wsl = dv >> 5, cl = dv & 31, pt = pos >> 5, pr = pos & 31, i = 4 * (pr >> 3) + (pr & 3), hs = (pr >> 2) & 1;
    return (((((size_t)chunk * 4 + wsl) * 2 + pt) * 2 + (i >> 3)) * 64 + cl + 32 * hs) * 8 + (i & 7);
}

__device__ __forceinline__ int opaque_tid() { int t = threadIdx.x; asm volatile("" : "+v"(t)); return t & 511; }
__device__ __forceinline__ unsigned char* opaque_ptr(unsigned char* q) { asm volatile("" : "+s"(q)); return q; }
struct Params {
    const float* x; const float* norm_w; const float* w_in; const float* conv_w; const float* a_log; const float* dt_bias;
    const float* dn_norm_w; const float* q_norm_w; const float* k_norm_w; const float* rel_bias; const float* w_out;
    float* out; unsigned char* ws;
};

namespace pg8 {
#define PG8_LAS __attribute__((address_space(3)))
typedef unsigned short bf16_t;
typedef short bf16x8 __attribute__((ext_vector_type(8)));
typedef float f32x4 __attribute__((ext_vector_type(4)));
typedef unsigned u32x4 __attribute__((ext_vector_type(4)));
constexpr int BM = 256, BK = 64, HALF = 128, HTB = HALF * BK * 2  , STAGE_BYTES = 8 * HTB, NXCD = 8, WGM = 8;

__host__ __device__ __forceinline__ int lds_byte(int r, int c) { const int st = (r >> 4) * 2 + (c >> 5), rr = r & 15, cc = c & 31, ob = rr * 64 + cc * 2; return st * 1024 + (ob ^ (((ob >> 9) & 1) << 5)); }
__host__ __device__ __forceinline__ void stage_rc(int b, int& R, int& C) { const int st = b / 1024, sb = b % 1024, swz = sb ^ (((sb >> 9) & 1) << 5); R = (st >> 1) * 16 + swz / 64; C = (st & 1) * 32 + (swz % 64) / 2; }
__host__ __device__ __forceinline__ int perm32(int rho) { const int n = rho >> 4, i = rho & 15; return 8 * (i >> 2) + 4 * n + (i & 3); }

struct Unit { int pm, pn; };
struct Gemm { const bf16_t* A; const bf16_t* Bt; int M, N, K; };

struct StaticOrder {
    int nM, nN, nwg, G, c;
    __host__ __device__ void init(int M, int N, int G_, int c_) { nM = M / BM; nN = N / BM; nwg = nM * nN; G = G_; c = c_; }
    __host__ __device__ bool next(int i, Unit& u) const {
        const long L = (long)i * G + c; if (L >= nwg) return false;
        int wgid = (int)L; { const int q = nwg / NXCD, r = nwg % NXCD, xcd = wgid % NXCD, off = wgid / NXCD; wgid = (xcd < r ? xcd * (q + 1) : r * (q + 1) + (xcd - r) * q) + off; }
        const int nig = WGM * nN, gid = wgid / nig, fm = gid * WGM, gsz = (nM - fm) < WGM ? (nM - fm) : WGM;
        u.pm = fm + ((wgid % nig) % gsz); u.pn = (wgid % nig) / gsz; return true;
    }
    __device__ __forceinline__ void a_ready(const Unit&) const {}
    __device__ __forceinline__ void done(const Unit&) const {}
};

__device__ __forceinline__ unsigned cvt_pk_bf16(float lo, float hi) { unsigned r; asm volatile("v_cvt_pk_bf16_f32 %0, %1, %2" : "=v"(r) : "v"(lo), "v"(hi)); return r; }
typedef float f32x2 __attribute__((ext_vector_type(2)));
template <class Epi, class Sched, bool ALIGN_EPI = false, bool SP2 = false>
__device__ __forceinline__ void gemm_phase(PG8_LAS unsigned char* lds, const Gemm g, const Sched& S, const Epi& E) {
    const int tid = opaque_tid(), wid = __builtin_amdgcn_readfirstlane(tid >> 6), lane = tid & 63, wr = wid >> 2, wc = wid & 3, fr = lane & 15, fq = lane >> 4;
    const int K = g.K, nt = K / BK;
    unsigned voffA[2], voffB[2];
#pragma unroll
    for (int i = 0; i < 2; ++i) { int R, C; stage_rc(tid * 16 + i * 8192, R, C); const int Rb = Epi::PERM ? ((R & ~31) + perm32(R & 31)) : R;
        voffA[i] = (unsigned)(R * K + C) * 2u; voffB[i] = (unsigned)(Rb * K + C) * 2u; }
    const size_t kstep = (size_t)(BK * 2);
    const size_t hstep = (size_t)HALF * K * 2;
    const size_t tstep = 2 * hstep;
    const unsigned ldsw = (unsigned)wid * 1024u;
    const int aoff = lds_byte(wr * 64 + fr, fq * 8), boff = lds_byte(wc * 32 + fr, fq * 8);
#define PG8_SA(b, h) (((b) * 2 + (h)) * HTB)
#define PG8_SB(b, h) ((4 + (b) * 2 + (h)) * HTB)
#define PG8_STAGE(bufoff, gbase, voff) do { _Pragma("unroll") for (int _i = 0; _i < 2; ++_i) \
        __builtin_amdgcn_global_load_lds((const unsigned*)((const char*)(gbase) + (voff)[_i]), (PG8_LAS unsigned*)(lds + (bufoff) + ldsw + _i * 8192), 16, 0, 0); } while (0)
#define PG8_LDA(dst, b, h) do { _Pragma("unroll") for (int m = 0; m < 4; ++m) _Pragma("unroll") for (int k = 0; k < 2; ++k) dst[m][k] = *(const PG8_LAS bf16x8*)(lds + PG8_SA(b, h) + aoff + m * 2048 + k * 1024); } while (0)
#define PG8_LDB(dst, b, h) do { _Pragma("unroll") for (int n = 0; n < 2; ++n) _Pragma("unroll") for (int k = 0; k < 2; ++k) dst[n][k] = *(const PG8_LAS bf16x8*)(lds + PG8_SB(b, h) + boff + n * 2048 + k * 1024); } while (0)
#define PG8_MMA(ai, bj, At, Bt) do { __builtin_amdgcn_s_setprio(1); _Pragma("unroll") for (int m = 0; m < 4; ++m) _Pragma("unroll") for (int n = 0; n < 2; ++n) _Pragma("unroll") for (int k = 0; k < 2; ++k) \
        acc[ai][bj][m][n] = __builtin_amdgcn_mfma_f32_16x16x32_bf16(Bt[n][k], At[m][k], acc[ai][bj][m][n], 0, 0, 0); __builtin_amdgcn_s_setprio(0); } while (0)
#define PG8_WAIT_V(n) asm volatile("s_waitcnt vmcnt(" #n ")" ::: "memory")
#define PG8_WAIT_L(n) asm volatile("s_waitcnt lgkmcnt(" #n ")" ::: "memory")
#define PG8_WAIT_V_SEAM(seam_) do { if constexpr (Epi::NST == 16) asm volatile("s_cmp_eq_u32 %0, 0\n\ts_cbranch_scc1 1f\n\ts_waitcnt vmcnt(24)\n\ts_branch 2f\n1:\n\ts_waitcnt vmcnt(8)\n2:" :: "s"(seam_) : "memory", "scc"); \
        else if constexpr (Epi::NST == 32) asm volatile("s_cmp_eq_u32 %0, 0\n\ts_cbranch_scc1 1f\n\ts_waitcnt vmcnt(40)\n\ts_branch 2f\n1:\n\ts_waitcnt vmcnt(8)\n2:" :: "s"(seam_) : "memory", "scc"); \
        else asm volatile("s_waitcnt vmcnt(8)" ::: "memory"); } while (0)
#define PG8_BAR __builtin_amdgcn_s_barrier()
#define PG8_SCHED __builtin_amdgcn_sched_barrier(0)
    Unit cur, nxt; int ui = 0;
    if (!S.next(0, cur)) return;
    f32x4 acc[2][2][4][2];
#pragma unroll
    for (int a = 0; a < 2; ++a)
#pragma unroll
        for (int b = 0; b < 2; ++b)
#pragma unroll
            for (int m = 0; m < 4; ++m)
#pragma unroll
                for (int n = 0; n < 2; ++n) acc[a][b][m][n] = (f32x4){0.f, 0.f, 0.f, 0.f};
    bf16x8 At[4][2], B0[2][2], B1[2][2];
    const char* cA = (const char*)g.A + (size_t)cur.pm * tstep; const char* cB = (const char*)g.Bt + (size_t)cur.pn * tstep;
    S.a_ready(cur);
    if constexpr (SP2) {
        PG8_STAGE(PG8_SB(0, 0), cB, voffB); PG8_STAGE(PG8_SB(0, 1), cB + hstep, voffB); PG8_STAGE(PG8_SA(0, 0), cA, voffA); PG8_STAGE(PG8_SA(0, 1), cA + hstep, voffA);
        if (wr == 1) PG8_BAR;
        PG8_WAIT_V(2); PG8_BAR;
        PG8_STAGE(PG8_SB(1, 0), cB + kstep, voffB); PG8_STAGE(PG8_SA(1, 0), cA + kstep, voffA); PG8_STAGE(PG8_SB(1, 1), cB + hstep + kstep, voffB); PG8_STAGE(PG8_SA(1, 1), cA + hstep + kstep, voffA);
        PG8_WAIT_V(8); PG8_BAR;
    } else {
        PG8_STAGE(PG8_SB(0, 0), cB, voffB); PG8_STAGE(PG8_SA(0, 0), cA, voffA); PG8_STAGE(PG8_SB(0, 1), cB + hstep, voffB); PG8_STAGE(PG8_SA(0, 1), cA + hstep, voffA);
        if (wr == 1) PG8_BAR;
        PG8_WAIT_V(4); PG8_BAR;
        PG8_STAGE(PG8_SB(1, 0), cB + kstep, voffB); PG8_STAGE(PG8_SA(1, 0), cA + kstep, voffA); PG8_STAGE(PG8_SB(1, 1), cB + hstep + kstep, voffB);
        PG8_WAIT_V(6); PG8_BAR;
    }
    for (;;) {
        const bool has_next = S.next(ui + 1, nxt);
        const char* nA = has_next ? (const char*)g.A + (size_t)nxt.pm * tstep : cA; const char* nB = has_next ? (const char*)g.Bt + (size_t)nxt.pn * tstep : cB;
        for (int t = 0; t < nt; t += 2) {
            const bool last = (t == nt - 2);
            const char* a1 = cA + (size_t)(t + 1) * kstep;
            const char* a2 = last ? nA : cA + (size_t)(t + 2) * kstep; const char* b2 = last ? nB : cB + (size_t)(t + 2) * kstep;
            const char* a3 = a2 + kstep; const char* b3 = b2 + kstep;
            if (last && has_next) S.a_ready(nxt);
            if constexpr (SP2) {
            const int seam = __builtin_amdgcn_readfirstlane(((t == 0) && (ui > 0)) ? 1 : 0);
            PG8_LDB(B0, 0, 0); PG8_LDB(B1, 0, 1); PG8_SCHED; PG8_LDA(At, 0, 0);
            PG8_WAIT_V_SEAM(seam);
            PG8_WAIT_L(0); PG8_BAR; PG8_MMA(0, 0, At, B0); PG8_MMA(0, 1, At, B1); PG8_BAR; PG8_SCHED;
            PG8_LDA(At, 0, 1); PG8_STAGE(PG8_SB(0, 0), b2, voffB); PG8_STAGE(PG8_SB(0, 1), b2 + hstep, voffB); PG8_STAGE(PG8_SA(0, 0), a2, voffA);
            PG8_WAIT_V_SEAM(seam);
            PG8_WAIT_L(0); PG8_BAR; PG8_MMA(1, 0, At, B0); PG8_MMA(1, 1, At, B1); PG8_BAR; PG8_SCHED;
            PG8_LDB(B0, 1, 0); PG8_LDB(B1, 1, 1); PG8_SCHED; PG8_LDA(At, 1, 0); PG8_STAGE(PG8_SA(0, 1), a2 + hstep, voffA);
            PG8_WAIT_V_SEAM(seam); PG8_WAIT_L(0); PG8_BAR; PG8_MMA(0, 0, At, B0); PG8_MMA(0, 1, At, B1); PG8_BAR; PG8_SCHED;
            PG8_LDA(At, 1, 1); PG8_STAGE(PG8_SB(1, 0), b3, voffB); PG8_STAGE(PG8_SB(1, 1), b3 + hstep, voffB); PG8_STAGE(PG8_SA(1, 0), a3, voffA);
            PG8_WAIT_V(8); PG8_WAIT_L(0); PG8_BAR; PG8_MMA(1, 0, At, B0); PG8_MMA(1, 1, At, B1); PG8_BAR; PG8_SCHED;
            PG8_STAGE(PG8_SA(1, 1), a3 + hstep, voffA);
            } else {
            PG8_LDB(B0, 0, 0); PG8_SCHED; PG8_LDA(At, 0, 0); PG8_STAGE(PG8_SA(1, 1), a1 + hstep, voffA);
            PG8_WAIT_L(8); PG8_BAR; PG8_WAIT_L(0); PG8_MMA(0, 0, At, B0); PG8_BAR; PG8_SCHED;
            PG8_LDB(B1, 0, 1); PG8_STAGE(PG8_SB(0, 0), b2, voffB);
            PG8_BAR; PG8_WAIT_L(0); PG8_MMA(0, 1, At, B1); PG8_BAR;
            PG8_LDA(At, 0, 1); PG8_STAGE(PG8_SA(0, 0), a2, voffA);
            PG8_BAR; PG8_WAIT_L(0); PG8_MMA(1, 0, At, B0); PG8_BAR; PG8_SCHED;
            PG8_STAGE(PG8_SB(0, 1), b2 + hstep, voffB);
            PG8_WAIT_V(6); PG8_BAR; PG8_MMA(1, 1, At, B1); PG8_BAR;
            PG8_LDB(B0, 1, 0); PG8_SCHED; PG8_LDA(At, 1, 0); PG8_STAGE(PG8_SA(0, 1), a2 + hstep, voffA);
            PG8_WAIT_L(8); PG8_BAR; PG8_WAIT_L(0); PG8_MMA(0, 0, At, B0); PG8_BAR; PG8_SCHED;
            PG8_LDB(B1, 1, 1); PG8_STAGE(PG8_SB(1, 0), b3, voffB);
            PG8_BAR; PG8_WAIT_L(0); PG8_MMA(0, 1, At, B1); PG8_BAR;
            PG8_LDA(At, 1, 1); PG8_STAGE(PG8_SA(1, 0), a3, voffA);
            PG8_BAR; PG8_WAIT_L(0); PG8_MMA(1, 0, At, B0); PG8_BAR; PG8_SCHED;
            PG8_STAGE(PG8_SB(1, 1), b3 + hstep, voffB);
            PG8_WAIT_V(6); PG8_BAR; PG8_MMA(1, 1, At, B1); PG8_BAR;
            }
        }
        if constexpr (ALIGN_EPI) { if (wr == 0) PG8_BAR; }
        if constexpr (!Epi::AFTER_DRAIN) { E(acc, cur, wr, wc, fr, fq); S.done(cur); }
        if (!has_next) break;
#pragma unroll
        for (int a = 0; a < 2; ++a)
#pragma unroll
            for (int b = 0; b < 2; ++b)
#pragma unroll
                for (int m = 0; m < 4; ++m)
#pragma unroll
                    for (int n = 0; n < 2; ++n) acc[a][b][m][n] = (f32x4){0.f, 0.f, 0.f, 0.f};
        cur = nxt; cA = nA; cB = nB; ++ui;
        if constexpr (ALIGN_EPI) { if (wr == 1) PG8_BAR; }
    }
    PG8_WAIT_V(0);
    if constexpr (!ALIGN_EPI) { if (wr == 0) PG8_BAR; }
    PG8_BAR;
    if constexpr (Epi::AFTER_DRAIN) { E.fused(acc, cur, wr, wc, fr, fq, lds, wid, lane); S.done(cur); }
#undef PG8_SA
#undef PG8_SB
#undef PG8_STAGE
#undef PG8_LDA
#undef PG8_LDB
#undef PG8_MMA
#undef PG8_WAIT_V
#undef PG8_WAIT_L
#undef PG8_WAIT_V_SEAM
#undef PG8_BAR
#undef PG8_SCHED
}
}

__host__ __device__ __forceinline__ int wt_src_col(int n) {
    if (n >= 1024 && n < 1536) return (n & ~127) + ((n & 127) >> 3) + 16 * (n & 7);
    if (n < 2048) return n;
    if (n >= 3584) return n + 8;
    const int pn = n >> 8, vc = n & 255, bj = vc >> 7, wc = (vc >> 5) & 3, i = vc & 31;
    return 2056 + ((pn - 8) >> 1) * 512 + (4 * (pn & 1) + wc) * 64 + 32 * bj + i;
}
__host__ __device__ __forceinline__ int att_perm(int t) { return ((t & 15) << 8) | (t >> 4); }
struct EpiProjSplit {
    static constexpr bool PERM = true, AFTER_DRAIN = false;
    static constexpr int NST = 16;
    unsigned char* ws; const float *qw, *kw;
    __device__ __forceinline__ static pg8::u32x4 pack8(const f32x4 v0, const f32x4 v1) { pg8::u32x4 w;
        w.x = pg8::cvt_pk_bf16(v0[0], v0[1]); w.y = pg8::cvt_pk_bf16(v0[2], v0[3]); w.z = pg8::cvt_pk_bf16(v1[0], v1[1]); w.w = pg8::cvt_pk_bf16(v1[2], v1[3]); return w; }
    __device__ __forceinline__ void operator()(const f32x4 (&acc)[2][2][4][2], const pg8::Unit& u, int wr, int wc, int fr, int fq) const {
        const int pn = u.pn, row0 = u.pm * 256 + wr * 64 + fr;
        if (pn < 8 || pn >= 14) {
            const size_t boff = pn < 6 ? OFF_PROJDN : (pn < 8 ? OFF_Z : OFF_GATE);
            const int ld = pn < 6 ? 1536 : 512, colt = pn < 6 ? pn * 256 : (pn & 1) * 256; const bool act = pn >= 6;
            bf16_t* base = (bf16_t*)(ws + boff);
            const int col0 = colt + wc * 32 + 8 * fq;
#pragma unroll
            for (int ai = 0; ai < 2; ++ai)
#pragma unroll
                for (int m = 0; m < 4; ++m) { bf16_t* rowp = base + (size_t)(row0 + ai * 128 + m * 16) * ld + col0;
#pragma unroll
                    for (int bj = 0; bj < 2; ++bj) { f32x4 v0 = acc[ai][bj][m][0], v1 = acc[ai][bj][m][1];
                        if (act) {
#pragma unroll
                            for (int e = 0; e < 4; ++e) { v0[e] = silu_f(v0[e]); v1[e] = silu_f(v1[e]); } }
                        *(pg8::u32x4*)(rowp + bj * 128) = pack8(v0, v1); } }
        } else {
            const int grp = (pn - 8) >> 1, head = 4 * (pn & 1) + wc;
            bf16_t* base = (bf16_t*)(ws + OFF_AQ + (size_t)grp * (32 * MiB));
            f32x4 wv[2][2];
            if (grp < 2) { const float* w = grp == 0 ? qw : kw; const float sc = grp == 0 ? 0.125f * 1.4426950408889634f : 1.0f;
#pragma unroll
                for (int bj = 0; bj < 2; ++bj)
#pragma unroll
                    for (int n = 0; n < 2; ++n) wv[bj][n] = *(const f32x4*)(w + 32 * bj + 8 * fq + 4 * n) * sc; }
#pragma unroll
            for (int ai = 0; ai < 2; ++ai)
#pragma unroll
                for (int m = 0; m < 4; ++m) {
                    const int r = row0 + ai * 128 + m * 16, b = r >> 12, t = r & 4095;
                    f32x4 v[2][2];
#pragma unroll
                    for (int bj = 0; bj < 2; ++bj)
#pragma unroll
                        for (int n = 0; n < 2; ++n) v[bj][n] = acc[ai][bj][m][n];
                    if (grp < 2) {
                        float ss = 0.f;
#pragma unroll
                        for (int bj = 0; bj < 2; ++bj)
#pragma unroll
                            for (int n = 0; n < 2; ++n) ss += v[bj][n][0] * v[bj][n][0] + v[bj][n][1] * v[bj][n][1] + v[bj][n][2] * v[bj][n][2] + v[bj][n][3] * v[bj][n][3];
                        ss += __shfl_xor(ss, 16); ss += __shfl_xor(ss, 32);
                        const float rstd = rsqrtf(ss * (1.0f / 64.f) + EPS);
#pragma unroll
                        for (int bj = 0; bj < 2; ++bj)
#pragma unroll
                            for (int n = 0; n < 2; ++n) v[bj][n] = v[bj][n] * rstd * wv[bj][n];
                    }
                    bf16_t* dst = base + ((size_t)(b * 8 + head) * SEQ + att_perm(t)) * 64 + 8 * fq;
                    *(pg8::u32x4*)(dst) = pack8(v[0][0], v[0][1]);
                    *(pg8::u32x4*)(dst + 32) = pack8(v[1][0], v[1][1]);
                }
        }
    }
};
struct EpiOutRes {
    static constexpr bool PERM = false, AFTER_DRAIN = false;
    static constexpr int NST = 32;
    const float* X; float* C;
    __device__ __forceinline__ void operator()(const f32x4 (&acc)[2][2][4][2], const pg8::Unit& u, int wr, int wc, int fr, int fq) const {
        const int row0 = u.pm * 256 + wr * 64 + fr, col0 = u.pn * 256 + wc * 32 + 4 * fq;
#pragma unroll
        for (int ai = 0; ai < 2; ++ai)
#pragma unroll
            for (int m = 0; m < 4; ++m) { const size_t off = (size_t)(row0 + ai * 128 + m * 16) * DM + col0;
#pragma unroll
                for (int bj = 0; bj < 2; ++bj)
#pragma unroll
                    for (int n = 0; n < 2; ++n) { const size_t o = off + bj * 128 + n * 16; *(f32x4*)(C + o) = *(const f32x4*)(X + o) + acc[ai][bj][m][n]; } }
    }
};

__device__ void phase_weights(const Params& p, float* tile  ) {
    bf16_t* wt_in = (bf16_t*)(p.ws + OFF_WTIN); bf16_t* wt_out = (bf16_t*)(p.ws + OFF_WTOUT);
    const int tid = opaque_tid();
    constexpr int T_IN = (DM / 64) * (NPK / 64), T_OUT = (DM / 64) * (DM / 64);
    for (int i = blockIdx.x * 512 + tid; i < 4 * 1536; i += gridDim.x * 512) { const int tap = i / 1536, c = i - tap * 1536; ((float*)(p.ws + OFF_CONVP))[i] = p.conv_w[tap * 1536 + wt_src_col(c)]; }
    constexpr int NT = T_IN + T_OUT;
    const int G = (int)gridDim.x, n = tid & 63;
    float va[8], vb[8];
    auto ld = [&](int t, float (&v)[8]) __attribute__((always_inline)) {
        const bool is_in = t < T_IN; const int tt = is_in ? t : t - T_IN, ntn = is_in ? NPK / 64 : DM / 64, k0 = (tt / ntn) * 64, n0 = (tt % ntn) * 64;
        const float* src = is_in ? p.w_in : p.w_out; const int ldw = is_in ? DIN : DM; const int col = is_in ? wt_src_col(n0 + n) : n0 + n;
#pragma unroll
        for (int rep = 0; rep < 8; ++rep) { const int k = rep * 8 + (tid >> 6); v[rep] = src[(size_t)(k0 + k) * ldw + col]; }
    };
    auto proc = [&](int t, float (&v)[8]) __attribute__((always_inline)) {
        const bool is_in = t < T_IN; const int tt = is_in ? t : t - T_IN, ntn = is_in ? NPK / 64 : DM / 64, k0 = (tt / ntn) * 64, n0 = (tt % ntn) * 64;
        __syncthreads();
#pragma unroll
        for (int rep = 0; rep < 8; ++rep) { const int k = rep * 8 + (tid >> 6); tile[k * 65 + n] = v[rep]; }
        if (t + 2 * G < NT) ld(t + 2 * G, v);
        __syncthreads();
        const int nn = tid >> 3, k8 = (tid & 7) * 8;
        u32x4_t o;
        o.x = pk_bf16(tile[(k8 + 0) * 65 + nn], tile[(k8 + 1) * 65 + nn]); o.y = pk_bf16(tile[(k8 + 2) * 65 + nn], tile[(k8 + 3) * 65 + nn]);
        o.z = pk_bf16(tile[(k8 + 4) * 65 + nn], tile[(k8 + 5) * 65 + nn]); o.w = pk_bf16(tile[(k8 + 6) * 65 + nn], tile[(k8 + 7) * 65 + nn]);
        *(u32x4_t*)((is_in ? wt_in : wt_out) + (size_t)(n0 + nn) * DM + k0 + k8) = o;
    };
    int t = blockIdx.x;
    if (t < NT) ld(t, va);
    if (t + G < NT) ld(t + G, vb);
    for (; t < NT; t += 2 * G) { proc(t, va); if (t + G < NT) proc(t + G, vb); }
}

__device__ void phase_norm(const Params& p, float* lds_w8  ) {
    bf16_t* xn = (bf16_t*)(p.ws + OFF_XN); float* beta = (float*)(p.ws + OFF_BETA); float* gdec = (float*)(p.ws + OFF_G);
    const int tid = opaque_tid();
    const int lane = tid & 63, wpb = blockDim.x >> 6, gw = blockIdx.x * wpb + (tid >> 6), nw = gridDim.x * wpb;
    f32x4 xa_[4], xb_[4];
#define NORM_LD(dst, row_) do { _Pragma("unroll") for (int i = 0; i < 4; ++i) dst[i] = *(const f32x4*)(p.x + (size_t)(row_) * DM + i * 256 + lane * 4); } while (0)
    if (gw < MROWS) NORM_LD(xa_, gw);
    if (gw + nw < MROWS) NORM_LD(xb_, gw + nw);
    for (int i = tid; i < 1024 * 8; i += blockDim.x) { const int k = i >> 3, j = i & 7; lds_w8[j * 1024 + k] = p.w_in[(size_t)k * DIN + 2048 + j]; }
    __syncthreads();
    f32x4 nw4[4];
#pragma unroll
    for (int i = 0; i < 4; ++i) nw4[i] = *(const f32x4*)(p.norm_w + i * 256 + lane * 4);
    float pend = 0.f; int slot = 0, base_row = 0;
    auto flush = [&](const int nslots) __attribute__((always_inline)) {
        const int sidx = lane >> 3, j8 = lane & 7, j = j8 & 3, row = base_row + sidx * nw, b = row / SEQ, sq = row % SEQ;
        if (sidx < nslots) {
            const float v = pend;
            if (j8 < 4) beta[((size_t)b * 4 + j) * SEQ + sq] = 1.0f / (1.0f + expf(-v));
            else { const float xx = v + p.dt_bias[j]; const float sp = xx > 20.f ? xx : log1pf(expf(xx)); gdec[((size_t)b * 4 + j) * SEQ + sq] = -expf(p.a_log[j]) * sp; }
        }
    };
    auto process = [&](f32x4 (&xv)[4], const int row) __attribute__((always_inline)) {
        typedef float nf32x2 __attribute__((ext_vector_type(2)));
        float acc[8]; nf32x2 accp[8], ssp = {0.f, 0.f};
#pragma unroll
        for (int j = 0; j < 8; ++j) accp[j] = (nf32x2){0.f, 0.f};
        f32x4 hu[4];
#pragma unroll
        for (int i = 0; i < 4; ++i) {
            const nf32x2 x01 = {xv[i][0], xv[i][1]}, x23 = {xv[i][2], xv[i][3]};
            ssp = __builtin_elementwise_fma(x01, x01, ssp); ssp = __builtin_elementwise_fma(x23, x23, ssp);
            hu[i] = xv[i] * nw4[i];
            const nf32x2 h01 = {hu[i][0], hu[i][1]}, h23 = {hu[i][2], hu[i][3]};
#pragma unroll
            for (int j = 0; j < 8; ++j) { const f32x4 wj = *(const f32x4*)(lds_w8 + j * 1024 + i * 256 + lane * 4); const nf32x2 w01 = {wj[0], wj[1]}, w23 = {wj[2], wj[3]};
                accp[j] = __builtin_elementwise_fma(h01, w01, accp[j]); accp[j] = __builtin_elementwise_fma(h23, w23, accp[j]); }
        }
        float ss = ssp[0] + ssp[1];
#pragma unroll
        for (int j = 0; j < 8; ++j) acc[j] = accp[j][0] + accp[j][1];
        if (row + 2 * nw < MROWS) NORM_LD(xv, row + 2 * nw);
        ss = wave_sum_dpp(ss);
        const float rstd = rsqrtf(ss * (1.0f / DM) + EPS);
#pragma unroll
        for (int i = 0; i < 4; ++i) { const f32x4 h = hu[i] * rstd; uint2 pk; pk.x = pk_bf16(h[0], h[1]); pk.y = pk_bf16(h[2], h[3]); *(uint2*)(xn + (size_t)row * DM + i * 256 + lane * 4) = pk; }
        float a1[4], a2[2], a3;
#pragma unroll
        for (int j = 0; j < 4; ++j) { const bool hi = lane & 1; const float keep = hi ? acc[2 * j + 1] : acc[2 * j], send = hi ? acc[2 * j] : acc[2 * j + 1]; a1[j] = keep + dpp_get<0xB1>(send); }
#pragma unroll
        for (int j = 0; j < 2; ++j) { const bool hi = lane & 2; const float keep = hi ? a1[2 * j + 1] : a1[2 * j], send = hi ? a1[2 * j] : a1[2 * j + 1]; a2[j] = keep + dpp_get<0x4E>(send); }
        { const bool hi = lane & 4; const float keep = hi ? a2[1] : a2[0], send = hi ? a2[0] : a2[1]; a3 = keep + dpp_get<0x124>(send); }
        a3 += dpp_get<0x128>(a3); a3 += __shfl_xor(a3, 16); a3 += __shfl_xor(a3, 32);
        pend = ((lane >> 3) == slot) ? a3 * rstd : pend;
        if (slot == 0) base_row = row;
        if (++slot == 8) { flush(8); slot = 0; }
    };
    for (int row = gw; row < MROWS; row += 2 * nw) { process(xa_, row); if (row + nw < MROWS) process(xb_, row + nw); }
    if (slot > 0) flush(slot);
#undef NORM_LD
}

__device__ void phase_dn_prep(const Params& p, unsigned char* smem) {
    const bf16_t* proj = (const bf16_t*)(p.ws + OFF_PROJDN);
    bf16_t* qn = (bf16_t*)(p.ws + OFF_DNQ); bf16_t* kn = (bf16_t*)(p.ws + OFF_DNK); bf16_t* vimg = (bf16_t*)(p.ws + OFF_VIMG);
    const float* gdec = (const float*)(p.ws + OFF_G); float* gcum = (float*)(p.ws + OFF_GCUM); const float* convp = (const float*)(p.ws + OFF_CONVP);
    const int tid = opaque_tid(), lane = tid & 63, w = tid >> 6, h = lane >> 4, d8 = (lane & 15) * 8;
    constexpr int NIT = NB * 64 * 3;
    u32x4_t rawn[11];
#define PREP_LD(it_) do { const int u_ = (it_) / 3, g_ = (it_) - 3 * u_, b_ = u_ >> 6, t0_ = (u_ & 63) * 64; \
        _Pragma("unroll") for (int rr = 0; rr < 11; ++rr) { const int tt = t0_ + 8 * w - 3 + rr; rawn[rr] = tt >= 0 ? *(const u32x4_t*)(proj + (size_t)(b_ * SEQ + tt) * 1536 + g_ * 512 + 8 * lane) : (u32x4_t){0u, 0u, 0u, 0u}; } } while (0)
    int it = blockIdx.x * 3, vpar = 0;
    if (it < NIT) PREP_LD(it);
    for (; it < NIT; it = ((it % 3) == 2) ? it - 2 + 3 * (int)gridDim.x : it + 1) {
        const int unit = it / 3, g = it - 3 * unit, b = unit >> 6, n = unit & 63, t0 = n * 64, chunk = (b * 4 + h) * 64 + n;
        u32x4_t raw[11];
#pragma unroll
        for (int rr = 0; rr < 11; ++rr) raw[rr] = rawn[rr];
        { const int itn = (g == 2) ? it - 2 + 3 * (int)gridDim.x : it + 1; if (itn < NIT) PREP_LD(itn); }
        const float* bsrc_ = (const float*)(p.ws + OFF_BETA) + (size_t)(b * 4 + h) * SEQ + t0 + 8 * w;
        const f32x4 bt4a = *(const f32x4*)bsrc_, bt4b = *(const f32x4*)(bsrc_ + 4);
        f32x4 cw[4][2];
#pragma unroll
        for (int i = 0; i < 4; ++i) { cw[i][0] = *(const f32x4*)(convp + i * 1536 + g * 512 + 8 * lane); cw[i][1] = *(const f32x4*)(convp + i * 1536 + g * 512 + 8 * lane + 4); }
        float y[8][8];
#pragma unroll
        for (int pp = 0; pp < 8; ++pp) {
            float a[8];
#pragma unroll
            for (int e = 0; e < 8; ++e) a[e] = 0.f;
#pragma unroll
            for (int i = 0; i < 4; ++i) { float x[8]; unpack8(raw[pp + i], x);
#pragma unroll
                for (int e = 0; e < 8; ++e) a[e] += cw[i][e >> 2][e & 3] * x[e]; }
#pragma unroll
            for (int e = 0; e < 8; ++e) y[pp][e] = silu_f(a[e]);
        }
        if (g < 2) {
            bf16_t* dst = g == 0 ? qn : kn; const float sc = g == 0 ? 0.08838834764831845f : 1.0f;
#pragma unroll
            for (int pp = 0; pp < 8; ++pp) {
                float ss = 0.f;
#pragma unroll
                for (int e = 0; e < 8; ++e) ss += y[pp][e] * y[pp][e];
                ss += __shfl_xor(ss, 1); ss += __shfl_xor(ss, 2); ss += __shfl_xor(ss, 4); ss += __shfl_xor(ss, 8);
                const float rs = rsqrtf(ss + EPS) * sc;
                u32x4_t o; o.x = pk_bf16(y[pp][0] * rs, y[pp][1] * rs); o.y = pk_bf16(y[pp][2] * rs, y[pp][3] * rs); o.z = pk_bf16(y[pp][4] * rs, y[pp][5] * rs); o.w = pk_bf16(y[pp][6] * rs, y[pp][7] * rs);
                *(u32x4_t*)(dst + ((size_t)chunk * 64 + 8 * w + pp) * 128 + d8) = o;
            }
        } else {
            LDSP u32x2_t* xch = (LDSP u32x2_t*)smem + (size_t)(vpar & 1) * 4096;
            const int odd = w & 1;
            u32x2_t own[8];
#pragma unroll
            for (int pp = 0; pp < 8; ++pp) { const float bt_ = pp < 4 ? bt4a[pp & 3] : bt4b[pp & 3];
#pragma unroll
                for (int e = 0; e < 8; ++e) y[pp][e] *= bt_; }
#pragma unroll
            for (int e = 0; e < 8; ++e) { u32x2_t p0, p1; p0.x = pk_bf16(y[0][e], y[1][e]); p0.y = pk_bf16(y[2][e], y[3][e]); p1.x = pk_bf16(y[4][e], y[5][e]); p1.y = pk_bf16(y[6][e], y[7][e]);
                u32x2_t give; give.x = odd ? p0.x : p1.x; give.y = odd ? p0.y : p1.y; own[e].x = odd ? p1.x : p0.x; own[e].y = odd ? p1.y : p0.y;
                xch[(w * 8 + e) * 64 + lane] = give; }
            __syncthreads();
#pragma unroll
            for (int e = 0; e < 8; ++e) { const u32x2_t got = xch[((w ^ 1) * 8 + e) * 64 + lane];
                u32x4_t o; o.x = odd ? got.x : own[e].x; o.y = odd ? got.y : own[e].y; o.z = odd ? own[e].x : got.x; o.w = odd ? own[e].y : got.y;
                *(u32x4_t*)(vimg + vimg_index(chunk, 16 * (w >> 1) + 4 * odd, (lane & 15) + 16 * e)) = o; }
            ++vpar;
        }
        if (g == 0 && w < 4) {
            const int bh = b * 4 + w, c2 = bh * 64 + n;
            float v = gdec[(size_t)bh * SEQ + t0 + lane];
#pragma unroll
            for (int o = 1; o < 64; o <<= 1) { const float t = __shfl_up(v, o); if (lane >= o) v += t; }
            gcum[(size_t)c2 * 64 + lane] = v;
            const float glast = __shfl(v, 63), bt = ((const float*)(p.ws + OFF_BETA))[(size_t)bh * SEQ + t0 + lane], eg = __expf(v);
            float* sct = (float*)(p.ws + OFF_SCT) + (size_t)c2 * 256;
            sct[lane] = eg; sct[64 + lane] = bt * eg; sct[128 + lane] = __expf(glast - v); sct[192 + lane] = bt;
        }
    }
#undef PREP_LD
}

constexpr int D1B_LDS_PER_WAVE = 512;
__device__ void phase_dn_chunk(const Params& p, unsigned char* smem) {
    const bf16_t* qn = (const bf16_t*)(p.ws + OFF_DNQ); const bf16_t* kn = (const bf16_t*)(p.ws + OFF_DNK);
    const float* beta = (const float*)(p.ws + OFF_BETA); const float* gcum = (const float*)(p.ws + OFF_GCUM);
    bf16_t* Tm = (bf16_t*)(p.ws + OFF_T); bf16_t* attn = (bf16_t*)(p.ws + OFF_ATTN);
    const int tid0 = opaque_tid(), w = tid0 >> 6, lane = tid0 & 63, r = lane & 31, hh = lane >> 5;
    LDSP float* tg = (LDSP float*)((LDSP unsigned char*)smem + w * D1B_LDS_PER_WAVE); LDSP float* tb = tg + 64;
    for (int u = blockIdx.x + (w >> 2) * (int)gridDim.x; u < NB * 64; u += 2 * (int)gridDim.x) {
        const int c = (((u >> 6) * 4 + (w & 3)) << 6) + (u & 63);
        const int bh = c >> 6, n = c & 63;
        tg[lane] = gcum[(size_t)c * 64 + lane]; tb[lane] = beta[(size_t)bh * SEQ + n * 64 + lane];
        const bf16_t* kp = kn + ((size_t)c * 64 + r) * 128 + 8 * hh; const bf16_t* qp = qn + ((size_t)c * 64 + r) * 128 + 8 * hh;
        bf16x8 kf[2][8], qf[2][8];
#pragma unroll
        for (int rt = 0; rt < 2; ++rt)
#pragma unroll
            for (int s = 0; s < 8; ++s) kf[rt][s] = *(const bf16x8*)(kp + rt * 32 * 128 + 16 * s);
        f32x16 A00, A10, A11;
#define D1B_TILE_A(tile, rt, ct) do { _Pragma("unroll") for (int i = 0; i < 16; ++i) tile[i] = 0.f; \
        _Pragma("unroll") for (int s = 0; s < 8; ++s) tile = MFMA32(kf[rt][s], kf[ct][s], tile); \
        const float gcc = tg[32 * (ct) + r]; \
        _Pragma("unroll") for (int g4 = 0; g4 < 4; ++g4) { const int j0 = 32 * (rt) + 8 * g4 + 4 * hh; const f32x4 gj = *(const LDSP f32x4*)(tg + j0), bj = *(const LDSP f32x4*)(tb + j0); \
            _Pragma("unroll") for (int e = 0; e < 4; ++e) tile[4 * g4 + e] *= bj[e] * __expf(fminf(gj[e] - gcc, 0.f)); } } while (0)
        D1B_TILE_A(A00, 0, 0); D1B_TILE_A(A10, 1, 0); D1B_TILE_A(A11, 1, 1);
#undef D1B_TILE_A
#pragma unroll
        for (int it = 0; it < 2; ++it)
#pragma unroll
            for (int s = 0; s < 8; ++s) qf[it][s] = *(const bf16x8*)(qp + it * 32 * 128 + 16 * s);
        LDSP float* ATl = (LDSP float*)((LDSP unsigned char*)smem + 8192 + w * (64 * 68 * 4));
#define D1B_PUT(tile, rt, ct) do { _Pragma("unroll") for (int g4 = 0; g4 < 4; ++g4) { const f32x4 v4 = {tile[4 * g4], tile[4 * g4 + 1], tile[4 * g4 + 2], tile[4 * g4 + 3]}; \
            *(LDSP f32x4*)(ATl + (32 * (ct) + r) * 68 + 32 * (rt) + 8 * g4 + 4 * hh) = v4; } } while (0)
        D1B_PUT(A00, 0, 0); D1B_PUT(A10, 1, 0); D1B_PUT(A11, 1, 1);
#undef D1B_PUT
        typedef float tf32x2 __attribute__((ext_vector_type(2)));
        tf32x2 Tr2[32];
        int lane_o = lane; asm volatile("" : "+v"(lane_o));
#pragma unroll
        for (int m = 0; m < 32; ++m) Tr2[m] = (tf32x2){0.f, 0.f};
#pragma unroll
        for (int cc = 63; cc >= 0; --cc) if (lane_o >= cc) {
            tf32x2 acc0 = {(lane_o == cc) ? 1.f : 0.f, 0.f}, acc1 = {0.f, 0.f};
            int zv = 0;
            if (cc < 61) asm volatile("" : "+v"(zv) : "v"(Tr2[(cc + 3) >> 1]));
#pragma unroll
            for (int jb = (cc + 1) >> 2; jb < 16; ++jb) {
                const f32x4 a4 = *(const LDSP f32x4*)(ATl + cc * 68 + 4 * jb + zv);
                const int j0 = 4 * jb;
                if (j0 > cc) { const tf32x2 a01 = {a4[0], a4[1]}; acc0 = __builtin_elementwise_fma(-Tr2[2 * jb], a01, acc0); }
                else if (j0 + 1 > cc) acc0[1] = __builtin_fmaf(-Tr2[2 * jb][1], a4[1], acc0[1]);
                if (j0 + 2 > cc) { const tf32x2 a23 = {a4[2], a4[3]}; acc1 = __builtin_elementwise_fma(-Tr2[2 * jb + 1], a23, acc1); }
                else if (j0 + 3 > cc) acc1[1] = __builtin_fmaf(-Tr2[2 * jb + 1][1], a4[3], acc1[1]);
            }
            const float tv = (acc0[0] + acc0[1]) + (acc1[0] + acc1[1]);
            if (cc & 1) Tr2[cc >> 1][1] = tv; else Tr2[cc >> 1][0] = tv;
        }
        float Tr[64];
#pragma unroll
        for (int k = 0; k < 64; ++k) Tr[k] = Tr2[k >> 1][k & 1];
#pragma unroll
        for (int q = 0; q < 4; ++q)
#pragma unroll
            for (int half = 0; half < 2; ++half) { u32x4_t o;
                const int s0 = 8 * half;
                o.x = pk_bf16(Tr[16 * q + perm16(s0 + 0)], Tr[16 * q + perm16(s0 + 0) + 1]); o.y = pk_bf16(Tr[16 * q + perm16(s0 + 2)], Tr[16 * q + perm16(s0 + 2) + 1]);
                o.z = pk_bf16(Tr[16 * q + perm16(s0 + 4)], Tr[16 * q + perm16(s0 + 4) + 1]); o.w = pk_bf16(Tr[16 * q + perm16(s0 + 6)], Tr[16 * q + perm16(s0 + 6) + 1]);
                *(u32x4_t*)(Tm + ((size_t)c * 64 + lane) * 64 + 16 * q + s0) = o; }
        bf16x8 kf2[2][8];
        { const bf16_t* kp2 = kp; asm volatile("" : "+v"(kp2));
#pragma unroll
          for (int rt = 0; rt < 2; ++rt)
#pragma unroll
            for (int s = 0; s < 8; ++s) kf2[rt][s] = *(const bf16x8*)(kp2 + rt * 32 * 128 + 16 * s); }
#define D1B_TILE_ATT(jt, it) do { f32x16 tile; _Pragma("unroll") for (int i = 0; i < 16; ++i) tile[i] = 0.f; \
        _Pragma("unroll") for (int s = 0; s < 8; ++s) tile = MFMA32(kf2[jt][s], qf[it][s], tile); \
        const int qi = 32 * (it) + r; const float gi = tg[qi]; \
        _Pragma("unroll") for (int s2 = 0; s2 < 2; ++s2) { float v[8]; \
            _Pragma("unroll") for (int a = 0; a < 2; ++a) { const int j0 = 32 * (jt) + 16 * s2 + 8 * a + 4 * hh; const f32x4 gj = *(const LDSP f32x4*)(tg + j0); \
                _Pragma("unroll") for (int e = 0; e < 4; ++e) v[4 * a + e] = (qi >= j0 + e) ? __expf(fminf(gi - gj[e], 0.f)) * tile[8 * s2 + 4 * a + e] : 0.f; } \
            u32x4_t o; o.x = pk_bf16(v[0], v[1]); o.y = pk_bf16(v[2], v[3]); o.z = pk_bf16(v[4], v[5]); o.w = pk_bf16(v[6], v[7]); \
            *(u32x4_t*)(attn + ((size_t)c * 64 + qi) * 64 + 32 * (jt) + 16 * s2 + 8 * hh) = o; } \
        asm volatile("" ::: "memory"); } while (0)
        D1B_TILE_ATT(0, 0); D1B_TILE_ATT(0, 1); D1B_TILE_ATT(1, 1);
#undef D1B_TILE_ATT
    }
}

typedef short s16x4_tt __attribute__((ext_vector_type(4)));
constexpr int SCAN_BUF = 49152, SCAN_TBL = 3 * SCAN_BUF;
__device__ __forceinline__ int swz256(int row, int ch) { return (row * 16 + (ch ^ (((row & 3) << 2) | ((row >> 2) & 3)))) * 16; }
__device__ __forceinline__ int swz128(int row, int ch) { const int sr = row >> 1; return (sr * 16 + ((((row & 1) << 3) | ch) ^ (sr & 7))) * 16; }
__device__ void phase_dn_scan(const Params& p, unsigned char* smem, int bh) {
    const unsigned char* qnb = p.ws + OFF_DNQ; const unsigned char* knb = p.ws + OFF_DNK;
    const unsigned char* tb_ = p.ws + OFF_T; const unsigned char* atb = p.ws + OFF_ATTN;
    const bf16_t* vimg = (const bf16_t*)(p.ws + OFF_VIMG); bf16_t* orm = (bf16_t*)(p.ws + OFF_ODN);
    const int tid = opaque_tid(), lane = tid & 63, w = __builtin_amdgcn_readfirstlane(tid >> 6), r = lane & 31, hh = lane >> 5;
    LDSP unsigned char* lds = (LDSP unsigned char*)smem;
    auto stage = [&](int n, int bsel) {
        const size_t chunk = (size_t)bh * 64 + n;
        int ln = lane; asm volatile("" : "+v"(ln)); ln &= 63;
#pragma unroll
        for (int i = 0; i < 12; ++i) {
            const int k = (w - 4) * 12 + i; const unsigned char* src;
            if (k < 32) { const int sl = (k & 15) * 64 + ln, row = sl >> 4, ch = (sl & 15) ^ (((row & 3) << 2) | ((row >> 2) & 3)); src = (k < 16 ? knb : qnb) + chunk * 16384 + row * 256 + ch * 16; }
            else { const int sl = (k < 40 ? (k - 32) : (k - 40)) * 64 + ln, sr = sl >> 4, lp = (sl & 15) ^ (sr & 7), row = sr * 2 + (lp >> 3), ch = lp & 7;
                   src = (k < 40 ? tb_ : atb) + chunk * 8192 + row * 128 + ch * 16; }
            __builtin_amdgcn_global_load_lds((const unsigned*)src, (LDSP unsigned*)(lds + bsel * SCAN_BUF + k * 1024), 16, 0, 0);
        }
        if (w == 7) __builtin_amdgcn_global_load_lds((const unsigned*)(p.ws + OFF_SCT + chunk * 1024 + ln * 16), (LDSP unsigned*)(lds + SCAN_TBL + bsel * 1024), 16, 0, 0);
    };
#define SCAN_WAIT_STAGE() do { if (w == 7) asm volatile("s_waitcnt vmcnt(13)" ::: "memory"); else asm volatile("s_waitcnt vmcnt(12)" ::: "memory"); } while (0)
#define SCAN_BAR() do { asm volatile("" ::: "memory"); __builtin_amdgcn_s_barrier(); asm volatile("" ::: "memory"); } while (0)
    f32x16 S[4];
#pragma unroll
    for (int dt = 0; dt < 4; ++dt)
#pragma unroll
        for (int i = 0; i < 16; ++i) S[dt][i] = 0.f;
#define SCAN_SB(kc) __builtin_bit_cast(bf16x8, (u32x4_t){pk_bf16(S[(kc) >> 1][8 * ((kc) & 1)], S[(kc) >> 1][8 * ((kc) & 1) + 1]), pk_bf16(S[(kc) >> 1][8 * ((kc) & 1) + 2], S[(kc) >> 1][8 * ((kc) & 1) + 3]), \
                                                     pk_bf16(S[(kc) >> 1][8 * ((kc) & 1) + 4], S[(kc) >> 1][8 * ((kc) & 1) + 5]), pk_bf16(S[(kc) >> 1][8 * ((kc) & 1) + 6], S[(kc) >> 1][8 * ((kc) & 1) + 7])})
#define SCAN_LDV(dst, ch_) do { _Pragma("unroll") for (int pt = 0; pt < 2; ++pt) _Pragma("unroll") for (int g = 0; g < 2; ++g) dst[pt][g] = *(const u32x4_t*)(vimg + ((((((size_t)bh * 64 + (ch_)) * 4 + w) * 2 + pt) * 2 + g) * 64 + lane) * 8); } while (0)
    u32x4_t vr[2][2], vrn[2][2];
    if (w >= 4) {
        stage(0, 0); stage(1, 1); SCAN_WAIT_STAGE();
        SCAN_BAR();
        int bnx = 2;
        for (int n = 0; n < 64; ++n) {
            if (n + 2 < 64) { stage(n + 2, bnx); SCAN_WAIT_STAGE(); } else asm volatile("s_waitcnt vmcnt(0)" ::: "memory");
            SCAN_BAR();
            bnx = bnx + 1 >= 3 ? 0 : bnx + 1;
        }
    } else {
    SCAN_LDV(vrn, 0);
    SCAN_BAR();
    int bsel = 0;
    for (int n = 0; n < 64; ++n) {
        {
            const size_t chunk = (size_t)bh * 64 + n;
#pragma unroll
            for (int pt = 0; pt < 2; ++pt)
#pragma unroll
                for (int g = 0; g < 2; ++g) vr[pt][g] = vrn[pt][g];
            if (n + 1 < 64) SCAN_LDV(vrn, n + 1);
            LDSP unsigned char* B = lds + bsel * SCAN_BUF; LDSP float* teg = (LDSP float*)(lds + SCAN_TBL + bsel * 1024); LDSP float* tbeg = teg + 64; LDSP float* tet = teg + 128; LDSP float* tbt = teg + 192;
            LDSP unsigned char* Bkn = B, *Bqn = B + 16384, *BT = B + 32768, *Bat = B + 40960;
            f32x16 X[2], O[2];
#pragma unroll
            for (int i = 0; i < 16; ++i) { X[0][i] = 0.f; X[1][i] = 0.f; O[0][i] = 0.f; O[1][i] = 0.f; }
#define SCAN_RD2(dst, base_, kc_) do { const unsigned ak_ = (unsigned)(size_t)(base_) + (unsigned)swz256(r, 2 * (kc_) + hh); \
                asm volatile("ds_read_b128 %0, %2\n\tds_read_b128 %1, %2 offset:8192" : "=&v"(dst[0]), "=&v"(dst[1]) : "v"(ak_)); } while (0)
#define SCAN_WT2(dst, N) asm volatile("s_waitcnt lgkmcnt(" #N ")" : "+v"(dst[0]), "+v"(dst[1]))
            asm volatile("s_waitcnt lgkmcnt(0)" ::: "memory");
            { bf16x8 kr[4][2];
              SCAN_RD2(kr[0], Bkn, 0); SCAN_RD2(kr[1], Bkn, 1); SCAN_RD2(kr[2], Bkn, 2);
#pragma unroll
              for (int kc = 0; kc < 8; ++kc) {
                  if (kc + 3 < 8) SCAN_RD2(kr[(kc + 3) & 3], Bkn, kc + 3);
                  const bf16x8 sb = SCAN_SB(kc);
                  if (kc <= 4) SCAN_WT2(kr[kc & 3], 6); else if (kc == 5) SCAN_WT2(kr[kc & 3], 4); else if (kc == 6) SCAN_WT2(kr[kc & 3], 2); else SCAN_WT2(kr[kc & 3], 0);
                  X[0] = MFMA32(kr[kc & 3][0], sb, X[0]); X[1] = MFMA32(kr[kc & 3][1], sb, X[1]);
              } }
            bf16x8 Yb[2][2];
            f32x4 bgA[4];
#pragma unroll
            for (int g4 = 0; g4 < 4; ++g4) bgA[g4] = *(const LDSP f32x4*)(tbeg + 8 * g4 + 4 * hh);
            unsigned yp[2][8];
            bf16x8 qr[2][2];
            SCAN_RD2(qr[0], Bqn, 0);
#pragma unroll
            for (int kc = 0; kc < 8; ++kc) {
                if (kc + 1 < 8) SCAN_RD2(qr[(kc + 1) & 1], Bqn, kc + 1);
                if (kc + 1 < 8) SCAN_WT2(qr[kc & 1], 2); else SCAN_WT2(qr[kc & 1], 0);
                const bf16x8 q0 = qr[kc & 1][0], q1 = qr[kc & 1][1];
                if (kc == 4) {
#pragma unroll
                    for (int g4 = 0; g4 < 4; ++g4) bgA[g4] = *(const LDSP f32x4*)(tbeg + 32 + 8 * g4 + 4 * hh); }
                const bf16x8 sb = SCAN_SB(kc); O[0] = MFMA32(q0, sb, O[0]); O[1] = MFMA32(q1, sb, O[1]);
                { const int pt = kc >> 2, g4 = kc & 3; const f32x4 bg = bgA[g4];
                    float yv[4];
#pragma unroll
                    for (int e = 0; e < 4; ++e) { const int i = 4 * g4 + e;
                        const unsigned vw = vr[pt][i >> 3][(i & 7) >> 1]; const float vv = (i & 1) ? bfhi(vw) : bflo(vw);
                        yv[e] = __builtin_fmaf(-bg[e], X[pt][i], vv); }
                    yp[pt][2 * g4] = pk_bf16(yv[0], yv[1]); yp[pt][2 * g4 + 1] = pk_bf16(yv[2], yv[3]); }
            }
#undef SCAN_RD2
#undef SCAN_WT2
            { const float glf = teg[63];
#pragma unroll
              for (int dt = 0; dt < 4; ++dt)
#pragma unroll
                for (int i = 0; i < 16; ++i) S[dt][i] *= glf; }
            bf16x8 tfr[6];
#pragma unroll
            for (int kc = 0; kc < 4; ++kc) { if (kc < 2) tfr[kc] = *(const LDSP bf16x8*)(BT + swz128(r, 2 * kc + hh)); tfr[2 + kc] = *(const LDSP bf16x8*)(BT + swz128(32 + r, 2 * kc + hh)); }
#pragma unroll
            for (int pt = 0; pt < 2; ++pt)
#pragma unroll
                for (int s2 = 0; s2 < 2; ++s2) { u32x4_t t4; t4.x = yp[pt][4 * s2]; t4.y = yp[pt][4 * s2 + 1]; t4.z = yp[pt][4 * s2 + 2]; t4.w = yp[pt][4 * s2 + 3]; Yb[pt][s2] = __builtin_bit_cast(bf16x8, t4); }
            asm volatile("" ::: "memory");
            f32x16 Vn[2];
#pragma unroll
            for (int i = 0; i < 16; ++i) { Vn[0][i] = 0.f; Vn[1][i] = 0.f; }
            asm volatile("" :: "v"(tfr[0]), "v"(tfr[1]), "v"(tfr[2]), "v"(tfr[3]), "v"(tfr[4]), "v"(tfr[5]));
#pragma unroll
            for (int kc = 0; kc < 4; ++kc) {
                if (kc < 2) Vn[0] = MFMA32(tfr[kc], Yb[kc >> 1][kc & 1], Vn[0]);
                Vn[1] = MFMA32(tfr[2 + kc], Yb[kc >> 1][kc & 1], Vn[1]);
            }
            asm volatile("" ::: "memory");
            bf16x8 Vnb[2][2], Vsb[2][2];
            f32x4 et8[2][4];
#pragma unroll
            for (int pt = 0; pt < 2; ++pt)
#pragma unroll
                for (int g4 = 0; g4 < 4; ++g4) et8[pt][g4] = *(const LDSP f32x4*)(tet + 32 * pt + 8 * g4 + 4 * hh);
            asm volatile("" :: "v"(et8[0][0]), "v"(et8[0][1]), "v"(et8[0][2]), "v"(et8[0][3]), "v"(et8[1][0]), "v"(et8[1][1]), "v"(et8[1][2]), "v"(et8[1][3]));
#pragma unroll
            for (int pt = 0; pt < 2; ++pt) {
                unsigned np[8], sp[8];
#pragma unroll
                for (int g4 = 0; g4 < 4; ++g4) { const f32x4 et = et8[pt][g4];
                    np[2 * g4] = pk_bf16(Vn[pt][4 * g4], Vn[pt][4 * g4 + 1]); np[2 * g4 + 1] = pk_bf16(Vn[pt][4 * g4 + 2], Vn[pt][4 * g4 + 3]);
                    sp[2 * g4] = pk_bf16(Vn[pt][4 * g4] * et[0], Vn[pt][4 * g4 + 1] * et[1]); sp[2 * g4 + 1] = pk_bf16(Vn[pt][4 * g4 + 2] * et[2], Vn[pt][4 * g4 + 3] * et[3]); }
#pragma unroll
                for (int s = 0; s < 2; ++s) { u32x4_t a4, b4; a4.x = np[4 * s]; a4.y = np[4 * s + 1]; a4.z = np[4 * s + 2]; a4.w = np[4 * s + 3]; b4.x = sp[4 * s]; b4.y = sp[4 * s + 1]; b4.z = sp[4 * s + 2]; b4.w = sp[4 * s + 3];
                    Vnb[pt][s] = __builtin_bit_cast(bf16x8, a4); Vsb[pt][s] = __builtin_bit_cast(bf16x8, b4); }
            }
            asm volatile("" ::: "memory");
            bf16x8 afr[6];
#pragma unroll
            for (int kc = 0; kc < 4; ++kc) { if (kc < 2) afr[kc] = *(const LDSP bf16x8*)(Bat + swz128(r, 2 * kc + hh)); afr[2 + kc] = *(const LDSP bf16x8*)(Bat + swz128(32 + r, 2 * kc + hh)); }
#pragma unroll
            for (int pt = 0; pt < 2; ++pt)
#pragma unroll
                for (int g4 = 0; g4 < 4; ++g4) { const int j0 = 32 * pt + 8 * g4 + 4 * hh; const f32x4 eg = *(const LDSP f32x4*)(teg + j0);
#pragma unroll
                    for (int e = 0; e < 4; ++e) O[pt][4 * g4 + e] *= eg[e]; }
            asm volatile("" :: "v"(afr[0]), "v"(afr[1]), "v"(afr[2]), "v"(afr[3]), "v"(afr[4]), "v"(afr[5]));
#pragma unroll
            for (int kc = 0; kc < 4; ++kc) {
                if (kc < 2) O[0] = MFMA32(afr[kc], Vnb[kc >> 1][kc & 1], O[0]);
                O[1] = MFMA32(afr[2 + kc], Vnb[kc >> 1][kc & 1], O[1]);
            }
#pragma unroll
            for (int pt = 0; pt < 2; ++pt)
#pragma unroll
                for (int g = 0; g < 2; ++g) { u32x4_t o; o.x = pk_bf16(O[pt][8 * g], O[pt][8 * g + 1]); o.y = pk_bf16(O[pt][8 * g + 2], O[pt][8 * g + 3]); o.z = pk_bf16(O[pt][8 * g + 4], O[pt][8 * g + 5]); o.w = pk_bf16(O[pt][8 * g + 6], O[pt][8 * g + 7]);
                    *(u32x4_t*)(orm + (((((size_t)chunk * 4 + w) * 2 + pt) * 2 + g) * 64 + lane) * 8) = o; }
            const int blk16 = (lane >> 4) & 1, q4 = (lane & 15) >> 2, pp = lane & 3;
#pragma unroll
            for (int d2 = 0; d2 < 2; ++d2) {
                s16x4_tt trl[2][4], trh[2][4];
#pragma unroll
                for (int dd = 0; dd < 2; ++dd)
#pragma unroll
                    for (int kc = 0; kc < 4; ++kc) { const int dt = 2 * d2 + dd, row0 = 16 * kc + 4 * hh + q4, ch = 4 * dt + 2 * blk16 + (pp & 1), sub = 8 * (pp >> 1);
                        trl[dd][kc] = __builtin_amdgcn_ds_read_tr16_b64_v4i16((LDSP s16x4_tt*)(Bkn + swz256(row0, ch) + sub)); trh[dd][kc] = __builtin_amdgcn_ds_read_tr16_b64_v4i16((LDSP s16x4_tt*)(Bkn + swz256(row0 + 8, ch) + sub)); }
#pragma unroll
                for (int dd = 0; dd < 2; ++dd) asm volatile("" :: "v"(trl[dd][0]), "v"(trl[dd][1]), "v"(trl[dd][2]), "v"(trl[dd][3]), "v"(trh[dd][0]), "v"(trh[dd][1]), "v"(trh[dd][2]), "v"(trh[dd][3]));
#pragma unroll
                for (int kc = 0; kc < 4; ++kc)
#pragma unroll
                    for (int dd = 0; dd < 2; ++dd) S[2 * d2 + dd] = MFMA32(__builtin_shufflevector(trl[dd][kc], trh[dd][kc], 0, 1, 2, 3, 4, 5, 6, 7), Vsb[kc >> 1][kc & 1], S[2 * d2 + dd]);
            }

            asm volatile("s_waitcnt lgkmcnt(0)" ::: "memory");
        }
        SCAN_BAR();
        bsel = bsel + 1 >= 3 ? 0 : bsel + 1;
    }
    }
#undef SCAN_WAIT_STAGE
#undef SCAN_BAR
#undef SCAN_LDV
}

__device__ void phase_mix(const Params& p, unsigned char* smem) {
    const bf16_t* odn = (const bf16_t*)(p.ws + OFF_ODN); const bf16_t* zs = (const bf16_t*)(p.ws + OFF_Z);
    bf16_t* mixed = (bf16_t*)(p.ws + OFF_MIXED);
    const int tid = opaque_tid(), lane = tid & 63, w8 = tid >> 6;
    LDSP bf16_t* ot = (LDSP bf16_t*)smem;
    constexpr int OTS = 136;
    const int prow = tid >> 3, d16 = (tid & 7) * 16;
    f32x4 wv[4];
#pragma unroll
    for (int i = 0; i < 4; ++i) wv[i] = *(const f32x4*)(p.dn_norm_w + d16 + 4 * i);
    u32x4_t im[2], zn[2];
#define MIXD_LD(c_) do { const int bh_ = (c_) >> 6, n_ = (c_) & 63; const size_t row_ = (size_t)(bh_ >> 2) * SEQ + n_ * 64 + prow; \
        im[0] = *(const u32x4_t*)(odn + (size_t)(c_) * 8192 + (size_t)tid * 8); im[1] = *(const u32x4_t*)(odn + (size_t)(c_) * 8192 + (size_t)(tid + 512) * 8); \
        zn[0] = *(const u32x4_t*)(zs + row_ * 512 + (bh_ & 3) * 128 + d16); zn[1] = *(const u32x4_t*)(zs + row_ * 512 + (bh_ & 3) * 128 + d16 + 8); } while (0)
    int c = blockIdx.x;
    if (c < NB * 4 * 64) MIXD_LD(c);
    for (; c < NB * 4 * 64; c += gridDim.x) {
        const int bh = c >> 6, n = c & 63, h = bh & 3; const size_t row = (size_t)(bh >> 2) * SEQ + n * 64 + prow;
        __syncthreads();
#pragma unroll
        for (int q = 0; q < 2; ++q) { const int pc = tid + 512 * q, lp = pc & 63, g = (pc >> 6) & 1, pt = (pc >> 7) & 1, ws_ = pc >> 8, dv = 32 * ws_ + (lp & 31), p0 = 32 * pt + 16 * g + 4 * (lp >> 5);
            const unsigned vv[4] = {im[q].x, im[q].y, im[q].z, im[q].w};
#pragma unroll
            for (int jj = 0; jj < 8; ++jj) ot[(p0 + 8 * (jj >> 2) + (jj & 3)) * OTS + dv] = (bf16_t)((jj & 1) ? (vv[jj >> 1] >> 16) : (vv[jj >> 1] & 0xFFFFu)); }
        float z[16]; { float t8[8]; unpack8(zn[0], t8);
#pragma unroll
            for (int e = 0; e < 8; ++e) z[e] = t8[e];
            unpack8(zn[1], t8);
#pragma unroll
            for (int e = 0; e < 8; ++e) z[8 + e] = t8[e]; }
        if (c + (int)gridDim.x < NB * 4 * 64) MIXD_LD(c + (int)gridDim.x);
        __syncthreads();
        float o[16]; { float t8[8]; unpack8(*(const LDSP u32x4_t*)(ot + prow * OTS + d16), t8);
#pragma unroll
            for (int e = 0; e < 8; ++e) o[e] = t8[e];
            unpack8(*(const LDSP u32x4_t*)(ot + prow * OTS + d16 + 8), t8);
#pragma unroll
            for (int e = 0; e < 8; ++e) o[8 + e] = t8[e]; }
        float ss = 0.f;
#pragma unroll
        for (int e = 0; e < 16; ++e) ss += o[e] * o[e];
        ss += __shfl_xor(ss, 1); ss += __shfl_xor(ss, 2); ss += __shfl_xor(ss, 4);
        const float rstd = rsqrtf(ss * (1.0f / 128.f) + EPS);
        u32x4_t r4[2];
#pragma unroll
        for (int q = 0; q < 2; ++q) {
            r4[q].x = pk_bf16(o[8 * q + 0] * rstd * wv[2 * q][0] * z[8 * q + 0], o[8 * q + 1] * rstd * wv[2 * q][1] * z[8 * q + 1]); r4[q].y = pk_bf16(o[8 * q + 2] * rstd * wv[2 * q][2] * z[8 * q + 2], o[8 * q + 3] * rstd * wv[2 * q][3] * z[8 * q + 3]);
            r4[q].z = pk_bf16(o[8 * q + 4] * rstd * wv[2 * q + 1][0] * z[8 * q + 4], o[8 * q + 5] * rstd * wv[2 * q + 1][1] * z[8 * q + 5]); r4[q].w = pk_bf16(o[8 * q + 6] * rstd * wv[2 * q + 1][2] * z[8 * q + 6], o[8 * q + 7] * rstd * wv[2 * q + 1][3] * z[8 * q + 7]);
            *(u32x4_t*)(mixed + row * DM + h * 128 + d16 + 8 * q) = r4[q];
        }
    }
#undef MIXD_LD
    (void)lane; (void)w8;
}

__device__ void phase_att_combine(const Params& p, int vb, int vg) {
    const bf16_t* gate = (const bf16_t*)(p.ws + OFF_GATE); const bf16_t* attp = (const bf16_t*)(p.ws + OFF_ATTP); const float* lse = (const float*)(p.ws + OFF_LSE);
    bf16_t* mixed = (bf16_t*)(p.ws + OFF_MIXED);
    const int tid = opaque_tid(), lane = tid & 63, wpb = blockDim.x >> 6, gw = vb * wpb + (tid >> 6), nw = vg * wpb;
    {
        const int d8 = (lane & 7) * 8; const size_t PS = (size_t)MROWS * 8;
        u32x4_t a0A = {0, 0, 0, 0}, a1A = a0A, a2A = a0A, gtA = a0A, a0B = a0A, a1B = a0A, a2B = a0A, gtB = a0A; float l0A = 0.f, l1A = 0.f, l2A = 0.f, l0B = 0.f, l1B = 0.f, l2B = 0.f;
#define MIX_LD_AT(S, g_) do { const int bh_ = (g_) >> 9, t_ = ((g_) & 511) * 8 + (lane >> 3); const size_t q_ = (size_t)bh_ * SEQ + t_, row_ = (size_t)(bh_ >> 3) * SEQ + t_; \
        l0##S = lse[q_]; l1##S = lse[PS + q_]; l2##S = lse[2 * PS + q_]; a0##S = *(const u32x4_t*)(attp + q_ * 64 + d8); a1##S = *(const u32x4_t*)(attp + (PS + q_) * 64 + d8); a2##S = *(const u32x4_t*)(attp + (2 * PS + q_) * 64 + d8); \
        gt##S = *(const u32x4_t*)(gate + row_ * 512 + (bh_ & 7) * 64 + d8); } while (0)
#define MIX_DO(S, g_) do { const int gg_ = (g_); const int bh = gg_ >> 9, t = (gg_ & 511) * 8 + (lane >> 3), b = bh >> 3, h = bh & 7; const size_t row = (size_t)b * SEQ + t; \
            const float l0 = l0##S, l1 = l1##S, l2 = l2##S; \
            float a0[8], a1[8], a2[8], gt[8]; \
            unpack8(a0##S, a0); unpack8(a1##S, a1); unpack8(a2##S, a2); unpack8(gt##S, gt); \
            if (gg_ + 2 * nw < MROWS) MIX_LD_AT(S, gg_ + 2 * nw); \
            const float mx = fmaxf(l0, fmaxf(l1, l2)); \
            float w0 = __builtin_amdgcn_exp2f(l0 - mx), w1 = __builtin_amdgcn_exp2f(l1 - mx), w2 = __builtin_amdgcn_exp2f(l2 - mx); const float inv = 1.0f / (w0 + w1 + w2); w0 *= inv; w1 *= inv; w2 *= inv;     \
            float o[8]; \
            _Pragma("unroll") for (int e = 0; e < 8; ++e) o[e] = (w0 * a0[e] + w1 * a1[e] + w2 * a2[e]) * gt[e]; \
            u32x4_t r4; r4.x = pk_bf16(o[0], o[1]); r4.y = pk_bf16(o[2], o[3]); r4.z = pk_bf16(o[4], o[5]); r4.w = pk_bf16(o[6], o[7]); \
            *(u32x4_t*)(mixed + row * DM + 512 + h * 64 + d8) = r4; } while (0)
        if (gw < MROWS) MIX_LD_AT(A, gw);
        if (gw + nw < MROWS) MIX_LD_AT(B, gw + nw);
        for (int g = gw; g < MROWS; g += 2 * nw) {
            MIX_DO(A, g);
            if (g + nw < MROWS) MIX_DO(B, g + nw);
        }
#undef MIX_DO
#undef MIX_LD_AT
    }
}

__device__ __forceinline__ int t5_bucket_dev(int d) {
    if (d < 16) return d;
    int bkt = 16;
    const int bnd[15] = {22, 30, 40, 54, 73, 99, 134, 182, 246, 332, 450, 609, 825, 1117, 1513};
#pragma unroll
    for (int i = 0; i < 15; ++i) bkt += (d >= bnd[i]) ? 1 : 0;
    return bkt;
}
constexpr int ATT_UNITS = NB * 8 * 48;
constexpr int ATT_K = 0, ATT_V = 49152, ATT_Q = 98304, ATT_RB = 131072, ATT_TAB = ATT_RB + 1024 + 1024;
typedef short s16x4_t __attribute__((ext_vector_type(4)));
struct AttUnit { int pat, rd, res, M0, h; size_t hb; };
__device__ __forceinline__ AttUnit att_decode(int unit) {
    AttUnit a; const int bh = unit / 48, u = unit % 48, v = u & 15; a.pat = u >> 4; a.h = bh & 7; a.hb = (size_t)bh * SEQ;
    a.rd = a.pat == 0 ? 1 : (a.pat == 1 ? 4 : 16); a.res = a.pat == 0 ? 0 : (a.pat == 1 ? (v >> 2) : v); a.M0 = (a.pat == 0 ? v : (a.pat == 1 ? (v & 3) : 0)) * 256; return a;
}
#define ATT_WAITV(n) asm volatile("s_waitcnt vmcnt(" #n ")" ::: "memory")
#define ATT_WAITL() asm volatile("s_waitcnt lgkmcnt(0)" ::: "memory")
#define ATT_BAR() do { asm volatile("" ::: "memory"); __builtin_amdgcn_s_barrier(); asm volatile("" ::: "memory"); } while (0)
#define LDS_RD128(dst, addr) asm volatile("ds_read_b128 %0, %1" : "=v"(dst) : "v"(addr))
#define LDS_RDTR(dst, addr, off) asm volatile("ds_read_b64_tr_b16 %0, %1 offset:%2" : "=v"(dst) : "v"(addr), "i"(off))
#define LDS_RD32(dst, addr) asm volatile("ds_read_b32 %0, %1" : "=v"(dst) : "v"(addr))
#define LDS_WR32(addr, val) asm volatile("ds_write_b32 %0, %1" :: "v"(addr), "v"(val) : "memory")
#define LDS_WAIT4(n, a, b, c, d) asm volatile("s_waitcnt lgkmcnt(" #n ")" : "+v"(a), "+v"(b), "+v"(c), "+v"(d))
__device__ void phase_attn(const Params& p, unsigned char* smem, int vb, int vg) {
    const unsigned char* aqb = p.ws + OFF_AQ; const unsigned char* akb = p.ws + OFF_AK; const unsigned char* avb = p.ws + OFF_AV;
    const int tid = opaque_tid(), w = __builtin_amdgcn_readfirstlane(tid >> 6);
    LDSP unsigned char* lds = (LDSP unsigned char*)smem; const unsigned ldsb = (unsigned)(size_t)lds;
    const bool xcd_map = (vg % 8 == 0) && ((NB * 8) % 8 == 0);
    const int cls = vb & 7, rank = vb >> 3, per_cls = vg >> 3, n_cls_units = (NB * 8 / 8) * 48;
    auto unit_of = [&](int j) -> int { return xcd_map ? ((cls + 8 * (j / 48)) * 48 + (j % 48)) : j; };
    int jj = xcd_map ? rank : vb; const int jstep = xcd_map ? per_cls : vg, jend = xcd_map ? n_cls_units : ATT_UNITS;
    if (jj >= jend) return;
    int unit = unit_of(jj);
    if (tid < 256) ((LDSP float*)(lds + ATT_RB))[tid] = p.rel_bias[tid];
    asm volatile("s_waitcnt vmcnt(0) lgkmcnt(0)" ::: "memory");
    auto issue_kq = [&](const AttUnit& a) {
        int ln = tid; asm volatile("" : "+v"(ln)); ln &= 63;
#pragma unroll
        for (int i = 0; i < 6; ++i) { const int k = w * 6 + i, sl = k * 64 + ln, row = sl >> 3, ch = (sl & 7) ^ ((row >> 1) & 7); int mk = a.M0 - 128 + row; mk = mk < 0 ? 0 : mk;
            __builtin_amdgcn_global_load_lds((const unsigned*)(akb + (a.hb + (size_t)att_perm(mk * a.rd + a.res)) * 128 + ch * 16), (LDSP unsigned*)(lds + ATT_K + k * 1024), 16, 0, 0); }
#pragma unroll
        for (int i = 0; i < 4; ++i) { const int k = w * 4 + i, sl = k * 64 + ln, row = sl >> 3, ch = (sl & 7) ^ ((row >> 1) & 7);
            __builtin_amdgcn_global_load_lds((const unsigned*)(aqb + (a.hb + (size_t)att_perm((a.M0 + row) * a.rd + a.res)) * 128 + ch * 16), (LDSP unsigned*)(lds + ATT_Q + k * 1024), 16, 0, 0); }
    };
    auto issue_v = [&](const AttUnit& a) {
        int ln = tid; asm volatile("" : "+v"(ln)); ln &= 63;
#pragma unroll
        for (int i = 0; i < 6; ++i) { const int k = w * 6 + i, sl = k * 64 + ln, row = sl >> 3, ch = (sl & 7) ^ (((row >> 1) & 1) << 2); int mk = a.M0 - 128 + row; mk = mk < 0 ? 0 : mk;
            __builtin_amdgcn_global_load_lds((const unsigned*)(avb + (a.hb + (size_t)att_perm(mk * a.rd + a.res)) * 128 + ch * 16), (LDSP unsigned*)(lds + ATT_V + k * 1024), 16, 0, 0); }
    };
    AttUnit cur = att_decode(unit);
    issue_kq(cur); issue_v(cur);
    ATT_WAITV(6);
    for (;;) {
        const int jn = jj + jstep; const bool has_next = jn < jend; const int nxt = has_next ? unit_of(jn) : unit;
        int lane = tid; asm volatile("" : "+v"(lane)); lane &= 63;
        const int r = lane & 31, hh = lane >> 5, blk16 = (lane >> 4) & 1, q4 = (lane & 15) >> 2, pp = lane & 3;
        if (tid < 129) { float bv; LDS_RD32(bv, ldsb + ATT_RB + (cur.h * 32 + t5_bucket_dev(tid * cur.rd)) * 4); asm volatile("s_waitcnt lgkmcnt(0)" : "+v"(bv)); bv *= 1.4426950408889634f; LDS_WR32(ldsb + ATT_TAB + tid * 4, bv); }
        ATT_WAITV(14); ATT_WAITL(); ATT_BAR();
        const int M0 = cur.M0;
        f32x16 Sc[5];
        {
            const int qrow = 32 * w + r, qsw = (qrow >> 1) & 7;
            bf16x8 qf[4], kf[2][4];
#pragma unroll
            for (int s = 0; s < 4; ++s) LDS_RD128(qf[s], ldsb + ATT_Q + qrow * 128 + (((2 * s + hh) ^ qsw) << 4));
#define ATT_RDK(kt_, dst) do { const int krow_ = 32 * w + 32 * (kt_) + r, ksw_ = (krow_ >> 1) & 7; \
            _Pragma("unroll") for (int s = 0; s < 4; ++s) LDS_RD128(dst[s], ldsb + ATT_K + krow_ * 128 + (((2 * s + hh) ^ ksw_) << 4)); } while (0)
            ATT_RDK(0, kf[0]);
#pragma unroll
            for (int kt = 0; kt < 5; ++kt) {
                if (kt < 4) { ATT_RDK(kt + 1, kf[(kt + 1) & 1]); LDS_WAIT4(4, kf[kt & 1][0], kf[kt & 1][1], kf[kt & 1][2], kf[kt & 1][3]); }
                else LDS_WAIT4(0, kf[kt & 1][0], kf[kt & 1][1], kf[kt & 1][2], kf[kt & 1][3]);
                if (kt == 0) asm volatile("" : "+v"(qf[0]), "+v"(qf[1]), "+v"(qf[2]), "+v"(qf[3]));
#pragma unroll
                for (int i = 0; i < 16; ++i) Sc[kt][i] = 0.f;
                if (kt == 4 || M0 > 0 || w + kt >= 4) {
#pragma unroll
                    for (int s = 0; s < 4; ++s) Sc[kt] = MFMA32(kf[kt & 1][s], qf[s], Sc[kt]);
                }
            }
#undef ATT_RDK
        }
        ATT_WAITL(); ATT_BAR();
        AttUnit nx = cur;
        if (has_next) { nx = att_decode(nxt); issue_kq(nx); }
        const int rr = r - 4 * hh;
        const unsigned bta = ldsb + ATT_TAB + (128 + rr - 159) * 4;
        float mx = -INFINITY;
#pragma unroll
        for (int kt = 0; kt < 5; ++kt) {
            if (kt == 4 || M0 > 0 || w + kt >= 4) {
                float bb[16];
#pragma unroll
                for (int i = 0; i < 16; ++i) asm volatile("ds_read_b32 %0, %1 offset:%2" : "=v"(bb[i]) : "v"(bta), "i"((159 - (32 * kt + 8 * (i >> 2) + (i & 3))) * 4));
                asm volatile("s_waitcnt lgkmcnt(0)" : "+v"(bb[0]), "+v"(bb[1]), "+v"(bb[2]), "+v"(bb[3]), "+v"(bb[4]), "+v"(bb[5]), "+v"(bb[6]), "+v"(bb[7]), "+v"(bb[8]), "+v"(bb[9]), "+v"(bb[10]), "+v"(bb[11]), "+v"(bb[12]), "+v"(bb[13]), "+v"(bb[14]), "+v"(bb[15]));
#pragma unroll
                for (int i = 0; i < 16; ++i) { const int cr = 8 * (i >> 2) + (i & 3);
                    float sc = Sc[kt][i] + bb[i];
                    if (kt == 0) sc = (rr <= cr) ? sc : -INFINITY;
                    if (kt == 4) sc = (rr >= cr) ? sc : -INFINITY;
                    Sc[kt][i] = sc; mx = fmaxf(mx, sc); }
            } else {
#pragma unroll
                for (int i = 0; i < 16; ++i) Sc[kt][i] = -INFINITY;
            }
        }
        mx = fmaxf(mx, __shfl_xor(mx, 32));
        float lsum = 0.f;
#pragma unroll
        for (int kt = 0; kt < 5; ++kt)
#pragma unroll
            for (int i = 0; i < 16; ++i) { const float e = __builtin_amdgcn_exp2f(Sc[kt][i] - mx); Sc[kt][i] = e; lsum += e; }
        lsum += __shfl_xor(lsum, 32);
        if (has_next) ATT_WAITV(10); else ATT_WAITV(0);
        ATT_WAITL(); ATT_BAR();
        f32x16 O[2];
#pragma unroll
        for (int i = 0; i < 16; ++i) { O[0][i] = 0.f; O[1][i] = 0.f; }
        const int xb = (q4 >> 1) & 1;
        const unsigned vl0 = ldsb + ATT_V + (32 * w + 4 * hh + q4) * 128 + ((2 * blk16 + (pp >> 1)) + 4 * xb) * 16 + 8 * (pp & 1);
        const unsigned vl1 = ldsb + ATT_V + (32 * w + 4 * hh + q4) * 128 + ((2 * blk16 + (pp >> 1)) + 4 * (xb ^ 1)) * 16 + 8 * (pp & 1);
        s16x4_t va[2][4];
#define ATT_RDV(it_, dst) do { LDS_RDTR(dst[0], vl0, (it_) * 2048); LDS_RDTR(dst[1], vl0, (it_) * 2048 + 1024); LDS_RDTR(dst[2], vl1, (it_) * 2048); LDS_RDTR(dst[3], vl1, (it_) * 2048 + 1024); } while (0)
        ATT_RDV(0, va[0]);
#pragma unroll
        for (int it = 0; it < 10; ++it) {
            const int kt = it >> 1, s2 = it & 1;
            u32x4_t pk; pk.x = pk_bf16(Sc[kt][8 * s2], Sc[kt][8 * s2 + 1]); pk.y = pk_bf16(Sc[kt][8 * s2 + 2], Sc[kt][8 * s2 + 3]); pk.z = pk_bf16(Sc[kt][8 * s2 + 4], Sc[kt][8 * s2 + 5]); pk.w = pk_bf16(Sc[kt][8 * s2 + 6], Sc[kt][8 * s2 + 7]);
            const bf16x8 pb = __builtin_bit_cast(bf16x8, pk);
            if (it < 9) { ATT_RDV(it + 1, va[(it + 1) & 1]); LDS_WAIT4(4, va[it & 1][0], va[it & 1][1], va[it & 1][2], va[it & 1][3]); }
            else LDS_WAIT4(0, va[it & 1][0], va[it & 1][1], va[it & 1][2], va[it & 1][3]);
            O[0] = MFMA32(__builtin_shufflevector(va[it & 1][0], va[it & 1][1], 0, 1, 2, 3, 4, 5, 6, 7), pb, O[0]);
            O[1] = MFMA32(__builtin_shufflevector(va[it & 1][2], va[it & 1][3], 0, 1, 2, 3, 4, 5, 6, 7), pb, O[1]);
        }
#undef ATT_RDV
        ATT_WAITL(); ATT_BAR();
        if (has_next) issue_v(nx);
        const int mq = M0 + 32 * w + r; const size_t tq = cur.hb + (size_t)(mq * cur.rd + cur.res);
        const float inv = 1.0f / lsum;
        bf16_t* op = (bf16_t*)(p.ws + OFF_ATTP) + ((size_t)cur.pat * MROWS * 8 + tq) * 64;
#pragma unroll
        for (int dt = 0; dt < 2; ++dt)
#pragma unroll
            for (int g4 = 0; g4 < 4; ++g4) { u32x2_t o; o.x = pk_bf16(O[dt][4 * g4] * inv, O[dt][4 * g4 + 1] * inv); o.y = pk_bf16(O[dt][4 * g4 + 2] * inv, O[dt][4 * g4 + 3] * inv);
                *(u32x2_t*)(op + 32 * dt + 8 * g4 + 4 * hh) = o; }
        if (hh == 0) ((float*)(p.ws + OFF_LSE))[(size_t)cur.pat * MROWS * 8 + tq] = mx + __log2f(lsum);
        if (!has_next) break;
        cur = nx; unit = nxt; jj = jn;
    }
    asm volatile("s_waitcnt vmcnt(0)" ::: "memory");
}
#undef ATT_WAITV
#undef ATT_WAITL
#undef ATT_BAR
#undef LDS_RD128
#undef LDS_RDTR
#undef LDS_RD32
#undef LDS_WR32
#undef LDS_WAIT4

#define XB_TMO      128
#define XB_XCNT(j)  (256  + 64 * (j))
#define XB_XSUB(j)  (1280 + 64 * (j))
#define XB_XGEN(j)  (2304 + 64 * (j))
#define XB_TOP      3328
#define XB_TOPGEN   3392
#define XCD_BAR_WORDS 3456
#define XB_SPIN_CAP (1u << 18)
#define LAS __attribute__((address_space(3)))

__device__ __forceinline__ unsigned xb_ld(unsigned* p)              { return __hip_atomic_load(p, __ATOMIC_RELAXED, __HIP_MEMORY_SCOPE_AGENT); }
__device__ __forceinline__ unsigned xb_add(unsigned* p, unsigned v) { return __hip_atomic_fetch_add(p, v, __ATOMIC_RELAXED, __HIP_MEMORY_SCOPE_AGENT); }
__device__ __forceinline__ unsigned xb_xcc_id() { return (unsigned)__builtin_amdgcn_s_getreg((3 << 11) | 20) & 0xFu; }
#define XB_SPIN(cond, bar) do { unsigned _sp = 0; while (cond) { __builtin_amdgcn_s_sleep(1); \
    if ((++_sp & 255u) == 0u) { if (xb_ld(&(bar)[XB_TMO])) break; if (_sp > XB_SPIN_CAP) { atomicAdd(&(bar)[XB_TMO], 1u); break; } } } } while (0)

struct XcdBarrier {
    unsigned* bar; unsigned x;
    volatile LAS unsigned* st;
};

__device__ __forceinline__ XcdBarrier xcd_barrier_post(unsigned* bar, volatile LAS unsigned* st) {
    XcdBarrier b; b.bar = bar; b.x = xb_xcc_id(); b.st = st;
    if (threadIdx.x == 0) (void)xb_add(&bar[XB_XCNT(b.x)], 1u);
    return b;
}
__device__ __forceinline__ void xcd_barrier_complete(unsigned* bar, unsigned x, unsigned& nloc, unsigned& nx) {
    const unsigned G = gridDim.x * gridDim.y * gridDim.z;
    unsigned sum, cnt, mine, sp = 0u;
    for (;;) {
        sum = 0u; cnt = 0u; mine = 0u;
#pragma unroll
        for (unsigned j = 0; j < 16; ++j) { const unsigned c = xb_ld(&bar[XB_XCNT(j)]); sum += c; cnt += (c > 0u) ? 1u : 0u; mine = (j == x) ? c : mine; }
        if (sum == G) break;
        __builtin_amdgcn_s_sleep(1);
        if ((++sp & 255u) == 0u) { if (xb_ld(&bar[XB_TMO])) break; if (sp > XB_SPIN_CAP) { atomicAdd(&bar[XB_TMO], 1u); break; } }
    }
    nloc = mine > 0u ? mine : 1u; nx = cnt > 0u ? cnt : 1u;
}

__device__ __forceinline__ void xcd_barrier(const XcdBarrier& b) {
    asm volatile("s_waitcnt vmcnt(0)" ::: "memory");
    __syncthreads();
    if (threadIdx.x == 0) {
        unsigned* bar = b.bar;
        __builtin_amdgcn_s_waitcnt(0);
        unsigned nloc = b.st[0], nx = b.st[1];
        if (nloc == 0u) { xcd_barrier_complete(bar, b.x, nloc, nx); b.st[0] = nloc; b.st[1] = nx; }
        const unsigned old = xb_add(&bar[XB_XSUB(b.x)], 1u);
        const unsigned gen = old / nloc;
        if (old + 1u == (gen + 1u) * nloc) {
            __builtin_amdgcn_fence(__ATOMIC_RELEASE, "agent");
            asm volatile("s_waitcnt vmcnt(0)" ::: "memory");
            const unsigned og = xb_add(&bar[XB_TOP], 1u);
            const unsigned tg = og / nx;
            if (og + 1u == (tg + 1u) * nx) xb_add(&bar[XB_TOPGEN], 1u);
            else XB_SPIN(xb_ld(&bar[XB_TOPGEN]) == tg, bar);
            __builtin_amdgcn_fence(__ATOMIC_ACQUIRE, "agent");
            xb_add(&bar[XB_XGEN(b.x)], 1u);
            asm volatile("s_waitcnt vmcnt(0)" ::: "memory");
        } else {
            XB_SPIN(xb_ld(&bar[XB_XGEN(b.x)]) == gen, bar);
            __builtin_amdgcn_fence(__ATOMIC_ACQUIRE, "agent");
            asm volatile("s_waitcnt vmcnt(0)" ::: "memory");
        }
    }
    __syncthreads();
}

constexpr int NTHREADS = 512;
constexpr size_t DYN_LDS = 155648;
constexpr int SCAN_BLOCKS = 32;
__global__ void __launch_bounds__(NTHREADS, 2) fwd_mega(Params p) {
    cg::grid_group grid = cg::this_grid();
    extern __shared__ __attribute__((aligned(16))) unsigned char smem[];
    float* smf = (float*)smem;
    volatile LAS unsigned* xbst = (volatile LAS unsigned*)((LAS unsigned char*)smem + DYN_LDS - 16);
    if (threadIdx.x < 4) xbst[threadIdx.x] = 0u;
    __syncthreads();
    const XcdBarrier xbar = xcd_barrier_post((unsigned*)(p.ws + OFF_BAR), xbst);
    if (p.ws == nullptr) grid.sync();
#define GRID_SYNC() xcd_barrier(xbar)
#ifndef PROBE_SPIN
#define PROBE_SPIN -1
#endif
    unsigned long long ts_[9];
#define STAMP(i) do { if (PROBE_SPIN >= 0) ts_[i] = __builtin_amdgcn_s_memrealtime(); } while (0)
    STAMP(0);
#ifndef PROBE_DUP
#define PROBE_DUP 0
#endif
#define PH_P0()    do { phase_weights(p, smf + 8192); phase_norm(p, smf); GRID_SYNC(); } while (0)
#define PH_GEMM1() do { pg8::Gemm g{(const bf16_t*)(p.ws + OFF_XN), (const bf16_t*)(p.ws + OFF_WTIN), MROWS, NPK, DM}; pg8::StaticOrder S; S.init(MROWS, NPK, (int)gridDim.x, (int)blockIdx.x); \
      EpiProjSplit E{p.ws, p.q_norm_w, p.k_norm_w}; pg8::gemm_phase<EpiProjSplit, pg8::StaticOrder, true, true>((PG8_LAS unsigned char*)smem, g, S, E); GRID_SYNC(); } while (0)
#define PH_PREP()  do { phase_dn_prep(p, smem);   \
        __syncthreads(); } while (0)
#define PH_CHUNK() do { phase_dn_chunk(p, smem); GRID_SYNC(); } while (0)
#define PH_SCAN()  do { if ((int)blockIdx.x < SCAN_BLOCKS) phase_dn_scan(p, smem, blockIdx.x); else { const int na_ = (int)gridDim.x - SCAN_BLOCKS; phase_attn(p, smem, blockIdx.x - SCAN_BLOCKS, na_); \
          \
        asm volatile("s_waitcnt vmcnt(0)" ::: "memory"); __syncthreads(); \
        if (threadIdx.x == 0) { unsigned* cnt_ = (unsigned*)(p.ws + OFF_BAR); __builtin_amdgcn_fence(__ATOMIC_RELEASE, "agent"); asm volatile("s_waitcnt vmcnt(0)" ::: "memory"); \
            __hip_atomic_fetch_add(cnt_, 1u, __ATOMIC_RELAXED, __HIP_MEMORY_SCOPE_AGENT); unsigned spins_ = 0; \
            while (__hip_atomic_load(cnt_, __ATOMIC_RELAXED, __HIP_MEMORY_SCOPE_AGENT) < (unsigned)na_) { __builtin_amdgcn_s_sleep(8); if (++spins_ > (1u << 22)) break; } \
            __builtin_amdgcn_fence(__ATOMIC_ACQUIRE, "agent"); asm volatile("s_waitcnt vmcnt(0)" ::: "memory"); } \
        __syncthreads(); phase_att_combine(p, blockIdx.x - SCAN_BLOCKS, na_); } GRID_SYNC(); } while (0)
#define PH_MIX()   do { phase_mix(p, smem); GRID_SYNC(); } while (0)
#define PH_GEMM2() do { pg8::Gemm g{(const bf16_t*)(p.ws + OFF_MIXED), (const bf16_t*)(p.ws + OFF_WTOUT), MROWS, DM, DM}; pg8::StaticOrder S; S.init(MROWS, DM, (int)gridDim.x, (int)blockIdx.x); \
      EpiOutRes E{p.x, p.out}; pg8::gemm_phase<EpiOutRes, pg8::StaticOrder, true, true>((PG8_LAS unsigned char*)smem, g, S, E); } while (0)
    PH_P0();    STAMP(1);
    PH_GEMM1(); STAMP(2);
    PH_PREP();  STAMP(3);
    PH_CHUNK(); STAMP(4);
    PH_SCAN();  STAMP(5);
    PH_MIX();   STAMP(6);
    PH_GEMM2(); STAMP(7);
    if (PROBE_SPIN >= 0 && blockIdx.x == 0 && threadIdx.x == 0) {
        const unsigned long long d = ts_[PROBE_SPIN + 1 > 7 ? 7 : PROBE_SPIN + 1] - ts_[PROBE_SPIN > 7 ? 7 : (PROBE_SPIN < 0 ? 0 : PROBE_SPIN)], t0 = __builtin_amdgcn_s_memrealtime();
        while (__builtin_amdgcn_s_memrealtime() - t0 < d) __builtin_amdgcn_s_sleep(4);
    }
}

extern "C" void kernel_launch(void* const* d_in, const int* in_sizes, int n_in, void* d_out, int out_size, void* d_ws, size_t ws_size, hipStream_t stream) {
    (void)in_sizes; (void)n_in; (void)out_size;
    if (ws_size < WS_NEED) { fprintf(stderr, "workspace too small: %zu < %zu\n", ws_size, (size_t)WS_NEED); return; }
    static int grid_blocks = 0;
    if (!grid_blocks) {
        int dev = 0, cus = 0, per_cu = 0;
        (void)hipGetDevice(&dev);
        (void)hipDeviceGetAttribute(&cus, hipDeviceAttributeMultiprocessorCount, dev);
        (void)hipFuncSetAttribute((const void*)fwd_mega, hipFuncAttributeMaxDynamicSharedMemorySize, (int)DYN_LDS);
        (void)hipOccupancyMaxActiveBlocksPerMultiprocessor(&per_cu, fwd_mega, NTHREADS, DYN_LDS);
        if (per_cu > 1) per_cu = 1;
        grid_blocks = cus * per_cu;
        if (grid_blocks <= SCAN_BLOCKS) fprintf(stderr, "grid too small: %d\n", grid_blocks);
    }
    Params p{};
    p.x = (const float*)d_in[0]; p.norm_w = (const float*)d_in[1]; p.w_in = (const float*)d_in[2]; p.conv_w = (const float*)d_in[3]; p.a_log = (const float*)d_in[4];
    p.dt_bias = (const float*)d_in[5]; p.dn_norm_w = (const float*)d_in[6]; p.q_norm_w = (const float*)d_in[7]; p.k_norm_w = (const float*)d_in[8]; p.rel_bias = (const float*)d_in[9];
    p.w_out = (const float*)d_in[10]; p.out = (float*)d_out; p.ws = (unsigned char*)d_ws;
    (void)hipMemsetAsync((unsigned char*)d_ws + OFF_BAR, 0, XCD_BAR_WORDS * 4, stream);
    void* args[] = {&p};
    hipError_t e = hipLaunchCooperativeKernel((const void*)fwd_mega, dim3(grid_blocks), dim3(NTHREADS), args, DYN_LDS, stream);
    if (e != hipSuccess) fprintf(stderr, "cooperative launch failed: %s (grid %d)\n", hipGetErrorString(e), grid_blocks);
}
```
